# Optimizing an MI355X kernel written in HIP

```python
import jax, jax.numpy as jnp
from jax import lax
import numpy as np

D_MODEL = 1024
BATCH = 8
SEQ = 4096
DEPTH = 1
DEC_BATCH = 128
DEC_SEQ = 4
PAST_LEN = 8192
PAGE_SIZE = 128

D_MIX = D_MODEL
D_LRU = D_MIX // 2
N_LRU_BLOCKS = 8
LRU_BLOCK = D_LRU // N_LRU_BLOCKS
LRU_C = 8.0
CONV_A = 4
D_ATT = D_MIX - D_LRU
N_HEADS = 8
HEAD_DIM = D_ATT // N_HEADS
ROT_DIM = HEAD_DIM // 4
ROPE_THETA = 500000.0
DILATED_PATTERNS = ((128, 1), (512, 4), (2048, 16))
MAX_WINDOW = 2048
ATTN_SCALE = HEAD_DIM ** -0.5
NEG_INF = -1e30
D_IN = 2 * D_LRU + 3 * D_ATT
D_FF = 3 * D_MODEL
CONV_F = 3
EPS = 1e-6

kernel_name = 'hymba_rglru_dilated_swa_convffn_step'


def rmsnorm(x, g):
    xf = x.astype(jnp.float32)
    y = xf * lax.rsqrt(jnp.mean(xf * xf, axis=-1, keepdims=True) + EPS)
    return (y * g.astype(jnp.float32)).astype(x.dtype)


def causal_dwconv(x_ext, w, b):
    width = w.shape[0]
    length = x_ext.shape[1] - width + 1
    out = b + x_ext[:, 0:length] * w[0]
    for j in range(1, width):
        out = out + x_ext[:, j:j + length] * w[j]
    return out


def partial_rope(x, pos):
    half = ROT_DIM // 2
    inv_freq = ROPE_THETA ** (-2.0 * jnp.arange(half, dtype=jnp.float32) / ROT_DIM)
    ang = pos[:, None] * inv_freq[None, :]
    cos = jnp.cos(ang)[None, :, None, :]
    sin = jnp.sin(ang)[None, :, None, :]
    xf = x.astype(jnp.float32)
    x1, x2, rest = xf[..., :half], xf[..., half:ROT_DIM], xf[..., ROT_DIM:]
    out = jnp.concatenate([x1 * cos - x2 * sin, x2 * cos + x1 * sin, rest], axis=-1)
    return out.astype(x.dtype)


def block_diag(x, w, b):
    n, l, _ = x.shape
    xb = x.reshape(n, l, N_LRU_BLOCKS, LRU_BLOCK)
    return jnp.einsum('nlgi,gij->nlgj', xb, w).reshape(n, l, D_LRU) + b


def rg_lru(x, h0, w_r, b_r, w_i, b_i, lam):
    r = jax.nn.sigmoid(block_diag(x, w_r, b_r).astype(jnp.float32))
    gi = jax.nn.sigmoid(block_diag(x, w_i, b_i).astype(jnp.float32))
    log_a = -LRU_C * r * jax.nn.softplus(-lam.astype(jnp.float32))
    a = jnp.exp(log_a)
    u = jnp.sqrt(-jnp.expm1(2.0 * log_a)) * (gi * x.astype(jnp.float32))
    u = u.at[:, 0].add(a[:, 0] * h0.astype(jnp.float32))

    def combine(c1, c2):
        a1, b1 = c1
        a2, b2 = c2
        return a1 * a2, a2 * b1 + b2

    _, h = lax.associative_scan(combine, (a, u), axis=1)
    return h


def dilated_attention_banded(q, k, v, window, dilation):
    n, t_len, h, dh = q.shape
    band = window // dilation
    span = band * dilation
    lp = -(-t_len // span) * span
    nb = lp // span
    pad = ((0, 0), (0, lp - t_len), (0, 0), (0, 0))

    def split(x):
        x = jnp.pad(x, pad).reshape(n, lp // dilation, dilation, h, dh).transpose(0, 2, 1, 3, 4)
        return x.reshape(n, dilation, nb, band, h, dh)

    def with_prev(x):
        prev = jnp.pad(x, ((0, 0), (0, 0), (1, 0), (0, 0), (0, 0), (0, 0)))[:, :, :-1]
        return jnp.concatenate([prev, x], axis=3)

    qs = split(q).astype(jnp.float32)
    kb = with_prev(split(k)).astype(jnp.float32)
    vb = with_prev(split(v)).astype(jnp.float32)
    s = jnp.einsum('nrbqhc,nrbkhc->nrbhqk', qs, kb) * ATTN_SCALE
    qi = jnp.arange(band)[:, None]
    kk = jnp.arange(2 * band)[None, :]
    rel = qi + band - kk
    blk = jnp.arange(nb)[:, None, None]
    ok = (rel >= 0) & (rel <= band) & ((blk > 0) | (kk >= band))
    s = jnp.where(ok[None, None, :, None], s, NEG_INF)
    lse = jax.nn.logsumexp(s, axis=-1)
    pr = jnp.exp(s - lse[..., None])
    o = jnp.einsum('nrbhqk,nrbkhc->nrbqhc', pr, vb)
    o = o.reshape(n, dilation, lp // dilation, h, dh).transpose(0, 2, 1, 3, 4).reshape(n, lp, h, dh)[:, :t_len]
    lse = lse.transpose(0, 1, 2, 4, 3).reshape(n, dilation, lp // dilation, h)
    lse = lse.transpose(0, 2, 1, 3).reshape(n, lp, h)[:, :t_len]
    return lse, o


def dilated_attention_gathered(q, kc, vc, n_hist, window, dilation):
    band = window // dilation
    s_len = q.shape[1]
    idx = n_hist + jnp.arange(s_len)[:, None] - dilation * jnp.arange(band + 1)[None, :]
    valid = idx >= 0
    idx = jnp.maximum(idx, 0)
    kg = kc[:, idx].astype(jnp.float32)
    vg = vc[:, idx].astype(jnp.float32)
    s = jnp.einsum('nshc,nskhc->nshk', q.astype(jnp.float32), kg) * ATTN_SCALE
    s = jnp.where(valid[None, :, None, :], s, NEG_INF)
    lse = jax.nn.logsumexp(s, axis=-1)
    pr = jnp.exp(s - lse[..., None])
    o = jnp.einsum('nshk,nskhc->nshc', pr, vg)
    return lse, o


def combine_dilations(parts):
    lse = jnp.stack([p[0] for p in parts], axis=0)
    o = jnp.stack([p[1] for p in parts], axis=0)
    w = jax.nn.softmax(lse, axis=0)
    return jnp.einsum('pnlh,pnlhc->nlhc', w, o)


def attend_prompt(q, k, v):
    return combine_dilations([dilated_attention_banded(q, k, v, w, d) for w, d in DILATED_PATTERNS])


def make_attend_sample(k_hist, v_hist):
    n_hist = k_hist.shape[1]

    def attend(q, k, v):
        kc = jnp.concatenate([k_hist.astype(k.dtype), k], axis=1)
        vc = jnp.concatenate([v_hist.astype(v.dtype), v], axis=1)
        return combine_dilations([dilated_attention_gathered(q, kc, vc, n_hist, w, d) for w, d in DILATED_PATTERNS])

    return attend


def decoder_layer(x, pos, conv_a_hist, lru_h0, ffn_hist, attend, p):
    n, l, _ = x.shape
    h = rmsnorm(x, p['g_mix'])
    z = h @ p['w_in']
    xa, ga, q, k, v = jnp.split(z, [D_LRU, 2 * D_LRU, 2 * D_LRU + D_ATT, 2 * D_LRU + 2 * D_ATT], axis=-1)
    xa_ext = jnp.concatenate([conv_a_hist.astype(x.dtype), xa], axis=1)
    xa_c = causal_dwconv(xa_ext, p['conv_a_w'], p['conv_a_b'])
    hs = rg_lru(xa_c, lru_h0, p['lru_w_r'], p['lru_b_r'], p['lru_w_i'], p['lru_b_i'], p['lru_lambda'])
    ya = hs.astype(x.dtype) * jax.nn.gelu(ga)
    q = partial_rope(q.reshape(n, l, N_HEADS, HEAD_DIM), pos)
    k = partial_rope(k.reshape(n, l, N_HEADS, HEAD_DIM), pos)
    v = v.reshape(n, l, N_HEADS, HEAD_DIM)
    yb = attend(q, k, v).astype(x.dtype).reshape(n, l, D_ATT)
    x = x + jnp.concatenate([ya, yb], axis=-1) @ p['w_out']
    h = rmsnorm(x, p['g_ffn'])
    uf = h @ p['w_ffn_gate']
    uf_ext = jnp.concatenate([ffn_hist.astype(x.dtype), uf], axis=1)
    uc = causal_dwconv(uf_ext, p['conv_f_w'], p['conv_f_b'])
    x = x + (jax.nn.gelu(uc) * (h @ p['w_ffn_up'])) @ p['w_ffn_down']
    new_state = (xa_ext[:, -(CONV_A - 1):], hs[:, -1].astype(x.dtype), k, v, uf_ext[:, -(CONV_F - 1):])
    return x, new_state


def setup_inputs(seed: int = 0) -> dict:
    key = jax.random.key(seed)
    ks = jax.random.split(key, 26)
    f32 = jnp.float32
    win = min(MAX_WINDOW, PAST_LEN)

    def normal(kk, shape, scale):
        return jax.random.normal(kk, shape, f32) * scale

    def gain(kk, shape):
        return 1.0 + 0.02 * jax.random.normal(kk, shape, f32)

    a_c = jax.random.uniform(ks[13], (DEPTH, D_LRU), f32, 0.9, 0.999)
    a_base = a_c ** (1.0 / LRU_C)
    lru_lambda = jnp.log(a_base) - jnp.log1p(-a_base)
    return {
        'x_prompt': normal(ks[0], (BATCH, SEQ, D_MODEL), 1.0),
        'x_sample': normal(ks[1], (DEC_BATCH, DEC_SEQ, D_MODEL), 1.0),
        'state_conv_a': normal(ks[2], (DEPTH, DEC_BATCH, CONV_A - 1, D_LRU), 1.0),
        'state_lru_h': normal(ks[3], (DEPTH, DEC_BATCH, D_LRU), 0.5),
        'cache_win_k': normal(ks[4], (DEPTH, DEC_BATCH, win, N_HEADS, HEAD_DIM), 1.0),
        'cache_win_v': normal(ks[5], (DEPTH, DEC_BATCH, win, N_HEADS, HEAD_DIM), 1.0),
        'state_conv_ffn': normal(ks[6], (DEPTH, DEC_BATCH, CONV_F - 1, D_FF), 1.0),
        'g_mix': gain(ks[7], (DEPTH, D_MODEL)),
        'w_in': normal(ks[8], (DEPTH, D_MODEL, D_IN), D_MODEL ** -0.5),
        'conv_a_w': normal(ks[9], (DEPTH, CONV_A, D_LRU), CONV_A ** -0.5),
        'conv_a_b': normal(ks[10], (DEPTH, D_LRU), 0.01),
        'lru_w_r': normal(ks[11], (DEPTH, N_LRU_BLOCKS, LRU_BLOCK, LRU_BLOCK), LRU_BLOCK ** -0.5),
        'lru_b_r': normal(ks[12], (DEPTH, D_LRU), 0.01),
        'lru_w_i': normal(ks[14], (DEPTH, N_LRU_BLOCKS, LRU_BLOCK, LRU_BLOCK), LRU_BLOCK ** -0.5),
        'lru_b_i': normal(ks[15], (DEPTH, D_LRU), 0.01),
        'lru_lambda': lru_lambda,
        'w_out': normal(ks[16], (DEPTH, D_MIX, D_MODEL), D_MIX ** -0.5),
        'g_ffn': gain(ks[17], (DEPTH, D_MODEL)),
        'w_ffn_gate': normal(ks[18], (DEPTH, D_MODEL, D_FF), D_MODEL ** -0.5),
        'conv_f_w': normal(ks[19], (DEPTH, CONV_F, D_FF), CONV_F ** -0.5),
        'conv_f_b': normal(ks[20], (DEPTH, D_FF), 0.01),
        'w_ffn_up': normal(ks[21], (DEPTH, D_MODEL, D_FF), D_MODEL ** -0.5),
        'w_ffn_down': normal(ks[22], (DEPTH, D_FF, D_MODEL), D_FF ** -0.5),
        'g_final': gain(ks[23], (D_MODEL,)),
    }


def reference(x_prompt, x_sample, state_conv_a, state_lru_h, cache_win_k, cache_win_v, state_conv_ffn,
              g_mix, w_in, conv_a_w, conv_a_b, lru_w_r, lru_b_r, lru_w_i, lru_b_i, lru_lambda, w_out,
              g_ffn, w_ffn_gate, conv_f_w, conv_f_b, w_ffn_up, w_ffn_down, g_final):
    n_p, seq_p, _ = x_prompt.shape
    n_s, seq_s, _ = x_sample.shape
    pos_p = jnp.arange(seq_p, dtype=jnp.float32)
    pos_s = PAST_LEN + jnp.arange(seq_s, dtype=jnp.float32)
    keep_p = min(MAX_WINDOW, seq_p)
    xp, xs = x_prompt, x_sample
    new_p, new_s = [], []
    for layer in range(DEPTH):
        p = {
            'g_mix': g_mix[layer], 'w_in': w_in[layer], 'conv_a_w': conv_a_w[layer], 'conv_a_b': conv_a_b[layer],
            'lru_w_r': lru_w_r[layer], 'lru_b_r': lru_b_r[layer], 'lru_w_i': lru_w_i[layer], 'lru_b_i': lru_b_i[layer],
            'lru_lambda': lru_lambda[layer], 'w_out': w_out[layer], 'g_ffn': g_ffn[layer],
            'w_ffn_gate': w_ffn_gate[layer], 'conv_f_w': conv_f_w[layer], 'conv_f_b': conv_f_b[layer],
            'w_ffn_up': w_ffn_up[layer], 'w_ffn_down': w_ffn_down[layer],
        }
        xp, st_p = decoder_layer(
            xp, pos_p,
            jnp.zeros((n_p, CONV_A - 1, D_LRU), xp.dtype),
            jnp.zeros((n_p, D_LRU), jnp.float32),
            jnp.zeros((n_p, CONV_F - 1, D_FF), xp.dtype),
            attend_prompt, p)
        xs, st_s = decoder_layer(
            xs, pos_s, state_conv_a[layer], state_lru_h[layer], state_conv_ffn[layer],
            make_attend_sample(cache_win_k[layer], cache_win_v[layer]), p)
        new_p.append((st_p[0], st_p[1], st_p[2][:, -keep_p:], st_p[3][:, -keep_p:], st_p[4]))
        new_s.append(st_s)
    y_prompt = rmsnorm(xp, g_final)
    y_sample = rmsnorm(xs, g_final)
    prompt_conv_a = jnp.stack([s[0] for s in new_p], axis=0)
    prompt_lru_h = jnp.stack([s[1] for s in new_p], axis=0)
    prompt_win_k = jnp.stack([s[2] for s in new_p], axis=0)
    prompt_win_v = jnp.stack([s[3] for s in new_p], axis=0)
    prompt_conv_ffn = jnp.stack([s[4] for s in new_p], axis=0)
    sample_conv_a = jnp.stack([s[0] for s in new_s], axis=0)
    sample_lru_h = jnp.stack([s[1] for s in new_s], axis=0)
    sample_win_k = jnp.stack([s[2] for s in new_s], axis=0)
    sample_win_v = jnp.stack([s[3] for s in new_s], axis=0)
    sample_conv_ffn = jnp.stack([s[4] for s in new_s], axis=0)
    return (y_prompt, y_sample, prompt_conv_a, prompt_lru_h, prompt_win_k, prompt_win_v, prompt_conv_ffn,
            sample_conv_a, sample_lru_h, sample_win_k, sample_win_v, sample_conv_ffn)
```

```cpp
#include <hip/hip_runtime.h>
#include <cstdio>
#include <cstdint>
#include <cmath>
namespace pg8 {
#define PG8_LAS __attribute__((address_space(3)))
typedef unsigned short bf16_t;
typedef short bf16x8 __attribute__((ext_vector_type(8)));
typedef float f32x4 __attribute__((ext_vector_type(4)));
typedef unsigned u32x4 __attribute__((ext_vector_type(4)));
constexpr int BM = 256, BK = 64, HALF = 128, HTB = HALF * BK * 2  , STAGE_BYTES = 8 * HTB, NXCD = 8, WGM = 8;

__host__ __device__ __forceinline__ int lds_byte(int r, int c) { const int st = (r >> 4) * 2 + (c >> 5), rr = r & 15, cc = c & 31, ob = rr * 64 + cc * 2; return st * 1024 + (ob ^ (((ob >> 9) & 1) << 5)); }
__host__ __device__ __forceinline__ void stage_rc(int b, int& R, int& C) { const int st = b / 1024, sb = b % 1024, swz = sb ^ (((sb >> 9) & 1) << 5); R = (st >> 1) * 16 + swz / 64; C = (st & 1) * 32 + (swz % 64) / 2; }
__host__ __device__ __forceinline__ int perm32(int rho) { const int n = rho >> 4, i = rho & 15; return 8 * (i >> 2) + 4 * n + (i & 3); }

struct Unit { int pm, pn; };
struct Gemm { const bf16_t* A; const bf16_t* Bt; int M, N, K; };

struct StaticOrder {
    int nM, nN, nwg, G, c;
    __host__ __device__ void init(int M, int N, int G_, int c_) { nM = M / BM; nN = N / BM; nwg = nM * nN; G = G_; c = c_; }
    __host__ __device__ bool next(int i, Unit& u) const {
        const long L = (long)i * G + c; if (L >= nwg) return false;
        int wgid = (int)L; { const int q = nwg / NXCD, r = nwg % NXCD, xcd = wgid % NXCD, off = wgid / NXCD; wgid = (xcd < r ? xcd * (q + 1) : r * (q + 1) + (xcd - r) * q) + off; }
        const int nig = WGM * nN, gid = wgid / nig, fm = gid * WGM, gsz = (nM - fm) < WGM ? (nM - fm) : WGM;
        u.pm = fm + ((wgid % nig) % gsz); u.pn = (wgid % nig) / gsz; return true;
    }
    __device__ __forceinline__ void a_ready(const Unit&) const {}
    __device__ __forceinline__ void done(const Unit&) const {}
};

__device__ __forceinline__ unsigned cvt_pk_bf16(float lo, float hi) { unsigned r; asm volatile("v_cvt_pk_bf16_f32 %0, %1, %2" : "=v"(r) : "v"(lo), "v"(hi)); return r; }
template <class Epi, class Sched, bool ALIGN_EPI = false, bool SP2 = false>
__device__ __forceinline__ void gemm_phase(PG8_LAS unsigned char* lds, const Gemm g, const Sched& S, const Epi& E) {
    const int tid = threadIdx.x, wid = __builtin_amdgcn_readfirstlane(tid >> 6), lane = tid & 63, wr = wid >> 2, wc = wid & 3, fr = lane & 15, fq = lane >> 4;
    const int K = g.K, nt = K / BK;
    unsigned voffA[2], voffB[2];
#pragma unroll
    for (int i = 0; i < 2; ++i) { int R, C; stage_rc(tid * 16 + i * 8192, R, C); const int Rb = Epi::PERM ? ((R & ~31) + perm32(R & 31)) : R;
        voffA[i] = (unsigned)(R * K + C) * 2u; voffB[i] = (unsigned)(Rb * K + C) * 2u; }
    const size_t kstep = (size_t)(BK * 2);
    const size_t hstep = (size_t)HALF * K * 2;
    const size_t tstep = 2 * hstep;
    const unsigned ldsw = (unsigned)wid * 1024u;
    const int aoff = lds_byte(wr * 64 + fr, fq * 8), boff = lds_byte(wc * 32 + fr, fq * 8);
#define PG8_SA(b, h) (((b) * 2 + (h)) * HTB)
#define PG8_SB(b, h) ((4 + (b) * 2 + (h)) * HTB)
#define PG8_STAGE(bufoff, gbase, voff) do { _Pragma("unroll") for (int _i = 0; _i < 2; ++_i) \
        __builtin_amdgcn_global_load_lds((const unsigned*)((const char*)(gbase) + (voff)[_i]), (PG8_LAS unsigned*)(lds + (bufoff) + ldsw + _i * 8192), 16, 0, 0); } while (0)
#define PG8_LDA(dst, b, h) do { _Pragma("unroll") for (int m = 0; m < 4; ++m) _Pragma("unroll") for (int k = 0; k < 2; ++k) dst[m][k] = *(const PG8_LAS bf16x8*)(lds + PG8_SA(b, h) + aoff + m * 2048 + k * 1024); } while (0)
#define PG8_LDB(dst, b, h) do { _Pragma("unroll") for (int n = 0; n < 2; ++n) _Pragma("unroll") for (int k = 0; k < 2; ++k) dst[n][k] = *(const PG8_LAS bf16x8*)(lds + PG8_SB(b, h) + boff + n * 2048 + k * 1024); } while (0)
#define PG8_MMA(ai, bj, At, Bt) do { __builtin_amdgcn_s_setprio(1); _Pragma("unroll") for (int m = 0; m < 4; ++m) _Pragma("unroll") for (int n = 0; n < 2; ++n) _Pragma("unroll") for (int k = 0; k < 2; ++k) \
        acc[ai][bj][m][n] = __builtin_amdgcn_mfma_f32_16x16x32_bf16(Bt[n][k], At[m][k], acc[ai][bj][m][n], 0, 0, 0); __builtin_amdgcn_s_setprio(0); } while (0)
#define PG8_WAIT_V(n) asm volatile("s_waitcnt vmcnt(" #n ")" ::: "memory")
#define PG8_WAIT_L(n) asm volatile("s_waitcnt lgkmcnt(" #n ")" ::: "memory")
#define PG8_BAR __builtin_amdgcn_s_barrier()
#define PG8_SCHED __builtin_amdgcn_sched_barrier(0)
    Unit cur, nxt; int ui = 0;
    if (!S.next(0, cur)) return;
    f32x4 acc[2][2][4][2];
#pragma unroll
    for (int a = 0; a < 2; ++a)
#pragma unroll
        for (int b = 0; b < 2; ++b)
#pragma unroll
            for (int m = 0; m < 4; ++m)
#pragma unroll
                for (int n = 0; n < 2; ++n) acc[a][b][m][n] = (f32x4){0.f, 0.f, 0.f, 0.f};
    bf16x8 At[4][2], B0[2][2], B1[2][2];
    const char* cA = (const char*)g.A + (size_t)cur.pm * tstep; const char* cB = (const char*)g.Bt + (size_t)cur.pn * tstep;
    S.a_ready(cur);
    if constexpr (SP2) {
        PG8_STAGE(PG8_SB(0, 0), cB, voffB); PG8_STAGE(PG8_SB(0, 1), cB + hstep, voffB); PG8_STAGE(PG8_SA(0, 0), cA, voffA); PG8_STAGE(PG8_SA(0, 1), cA + hstep, voffA);
        if (wr == 1) PG8_BAR;
        PG8_WAIT_V(2); PG8_BAR;
        PG8_STAGE(PG8_SB(1, 0), cB + kstep, voffB); PG8_STAGE(PG8_SA(1, 0), cA + kstep, voffA); PG8_STAGE(PG8_SB(1, 1), cB + hstep + kstep, voffB);
        PG8_WAIT_V(6); PG8_BAR;
    } else {
        PG8_STAGE(PG8_SB(0, 0), cB, voffB); PG8_STAGE(PG8_SA(0, 0), cA, voffA); PG8_STAGE(PG8_SB(0, 1), cB + hstep, voffB); PG8_STAGE(PG8_SA(0, 1), cA + hstep, voffA);
        if (wr == 1) PG8_BAR;
        PG8_WAIT_V(4); PG8_BAR;
        PG8_STAGE(PG8_SB(1, 0), cB + kstep, voffB); PG8_STAGE(PG8_SA(1, 0), cA + kstep, voffA); PG8_STAGE(PG8_SB(1, 1), cB + hstep + kstep, voffB);
        PG8_WAIT_V(6); PG8_BAR;
    }
    for (;;) {
        const bool has_next = S.next(ui + 1, nxt);
        const char* nA = has_next ? (const char*)g.A + (size_t)nxt.pm * tstep : cA; const char* nB = has_next ? (const char*)g.Bt + (size_t)nxt.pn * tstep : cB;
        for (int t = 0; t < nt; t += 2) {
            const bool last = (t == nt - 2);
            const char* a1 = cA + (size_t)(t + 1) * kstep;
            const char* a2 = last ? nA : cA + (size_t)(t + 2) * kstep; const char* b2 = last ? nB : cB + (size_t)(t + 2) * kstep;
            const char* a3 = a2 + kstep; const char* b3 = b2 + kstep;
            if (last && has_next) S.a_ready(nxt);
            if constexpr (SP2) {
            PG8_LDB(B0, 0, 0); PG8_LDB(B1, 0, 1); PG8_SCHED; PG8_LDA(At, 0, 0); PG8_STAGE(PG8_SA(1, 1), a1 + hstep, voffA);
            PG8_WAIT_V(8); PG8_WAIT_L(0); PG8_BAR; PG8_MMA(0, 0, At, B0); PG8_MMA(0, 1, At, B1); PG8_BAR; PG8_SCHED;
            PG8_LDA(At, 0, 1); PG8_STAGE(PG8_SB(0, 0), b2, voffB); PG8_STAGE(PG8_SB(0, 1), b2 + hstep, voffB); PG8_STAGE(PG8_SA(0, 0), a2, voffA);
            PG8_WAIT_V(8); PG8_WAIT_L(0); PG8_BAR; PG8_MMA(1, 0, At, B0); PG8_MMA(1, 1, At, B1); PG8_BAR; PG8_SCHED;
            PG8_LDB(B0, 1, 0); PG8_LDB(B1, 1, 1); PG8_SCHED; PG8_LDA(At, 1, 0); PG8_STAGE(PG8_SA(0, 1), a2 + hstep, voffA);
            PG8_WAIT_V(8); PG8_WAIT_L(0); PG8_BAR; PG8_MMA(0, 0, At, B0); PG8_MMA(0, 1, At, B1); PG8_BAR; PG8_SCHED;
            PG8_LDA(At, 1, 1); PG8_STAGE(PG8_SB(1, 0), b3, voffB); PG8_STAGE(PG8_SB(1, 1), b3 + hstep, voffB); PG8_STAGE(PG8_SA(1, 0), a3, voffA);
            PG8_WAIT_V(8); PG8_WAIT_L(0); PG8_BAR; PG8_MMA(1, 0, At, B0); PG8_MMA(1, 1, At, B1); PG8_BAR; PG8_SCHED;
            } else {
            PG8_LDB(B0, 0, 0); PG8_SCHED; PG8_LDA(At, 0, 0); PG8_STAGE(PG8_SA(1, 1), a1 + hstep, voffA);
            PG8_WAIT_L(8); PG8_BAR; PG8_WAIT_L(0); PG8_MMA(0, 0, At, B0); PG8_BAR; PG8_SCHED;
            PG8_LDB(B1, 0, 1); PG8_STAGE(PG8_SB(0, 0), b2, voffB);
            PG8_BAR; PG8_WAIT_L(0); PG8_MMA(0, 1, At, B1); PG8_BAR;
            PG8_LDA(At, 0, 1); PG8_STAGE(PG8_SA(0, 0), a2, voffA);
            PG8_BAR; PG8_WAIT_L(0); PG8_MMA(1, 0, At, B0); PG8_BAR; PG8_SCHED;
            PG8_STAGE(PG8_SB(0, 1), b2 + hstep, voffB);
            PG8_WAIT_V(6); PG8_BAR; PG8_MMA(1, 1, At, B1); PG8_BAR;
            PG8_LDB(B0, 1, 0); PG8_SCHED; PG8_LDA(At, 1, 0); PG8_STAGE(PG8_SA(0, 1), a2 + hstep, voffA);
            PG8_WAIT_L(8); PG8_BAR; PG8_WAIT_L(0); PG8_MMA(0, 0, At, B0); PG8_BAR; PG8_SCHED;
            PG8_LDB(B1, 1, 1); PG8_STAGE(PG8_SB(1, 0), b3, voffB);
            PG8_BAR; PG8_WAIT_L(0); PG8_MMA(0, 1, At, B1); PG8_BAR;
            PG8_LDA(At, 1, 1); PG8_STAGE(PG8_SA(1, 0), a3, voffA);
            PG8_BAR; PG8_WAIT_L(0); PG8_MMA(1, 0, At, B0); PG8_BAR; PG8_SCHED;
            PG8_STAGE(PG8_SB(1, 1), b3 + hstep, voffB);
            PG8_WAIT_V(6); PG8_BAR; PG8_MMA(1, 1, At, B1); PG8_BAR;
            }
        }
        if constexpr (ALIGN_EPI) { if (wr == 0) PG8_BAR; }
        if constexpr (!Epi::AFTER_DRAIN) { E(acc, cur, wr, wc, fr, fq); S.done(cur); }
        if (!has_next) break;
#pragma unroll
        for (int a = 0; a < 2; ++a)
#pragma unroll
            for (int b = 0; b < 2; ++b)
#pragma unroll
                for (int m = 0; m < 4; ++m)
#pragma unroll
                    for (int n = 0; n < 2; ++n) acc[a][b][m][n] = (f32x4){0.f, 0.f, 0.f, 0.f};
        cur = nxt; cA = nA; cB = nB; ++ui;
        if constexpr (ALIGN_EPI) { if (wr == 1) PG8_BAR; }
    }
    PG8_WAIT_V(0);
    if constexpr (!ALIGN_EPI) { if (wr == 0) PG8_BAR; }
    PG8_BAR;
    if constexpr (Epi::AFTER_DRAIN) { E.fused(acc, cur, wr, wc, fr, fq, lds, wid, lane); S.done(cur); }
#undef PG8_SA
#undef PG8_SB
#undef PG8_STAGE
#undef PG8_LDA
#undef PG8_LDB
#undef PG8_MMA
#undef PG8_WAIT_V
#undef PG8_WAIT_L
#undef PG8_BAR
#undef PG8_SCHED
}
}
#define GAS __attribute__((address_space(1)))
#define LAS __attribute__((address_space(3)))
typedef unsigned short bf16;
typedef unsigned v4u __attribute__((ext_vector_type(4)));
typedef float f32x4 __attribute__((ext_vector_type(4)));
typedef short bf16x8 __attribute__((ext_vector_type(8)));
typedef GAS unsigned gu32;
typedef GAS unsigned long long gu64;
#define RLX_AGENT __ATOMIC_RELAXED, __HIP_MEMORY_SCOPE_AGENT
#define LDS_WAIT() asm volatile("s_waitcnt lgkmcnt(0)" ::: "memory")
#define VM_WAIT() asm volatile("s_waitcnt vmcnt(0)" ::: "memory")
__device__ __forceinline__ unsigned long long rt() { return __builtin_amdgcn_s_memrealtime(); }
__device__ __forceinline__ unsigned f2bf(float f) { unsigned u = __builtin_bit_cast(unsigned, f); return (u + 0x7fffu + ((u >> 16) & 1u)) >> 16; }
__device__ __forceinline__ unsigned pk2(float lo, float hi) { return f2bf(lo) | (f2bf(hi) << 16); }

#define XB_TMO      128
#define XB_XCNT(j)  (256  + 64 * (j))
#define XB_XSUB(j)  (1280 + 64 * (j))
#define XB_XGEN(j)  (2304 + 64 * (j))
#define XB_TOP      3328
#define XB_TOPGEN   3392
#define XCD_BAR_WORDS 3456
#define XB_SPIN_CAP (1u << 18)

__device__ __forceinline__ unsigned xb_ld(unsigned* p)              { return __hip_atomic_load(p, __ATOMIC_RELAXED, __HIP_MEMORY_SCOPE_AGENT); }
__device__ __forceinline__ unsigned xb_add(unsigned* p, unsigned v) { return __hip_atomic_fetch_add(p, v, __ATOMIC_RELAXED, __HIP_MEMORY_SCOPE_AGENT); }
__device__ __forceinline__ unsigned xb_xcc_id() { return (unsigned)__builtin_amdgcn_s_getreg((3 << 11) | 20) & 0xFu; }
#define XB_SPIN(cond, bar) do { unsigned _sp = 0; while (cond) { __builtin_amdgcn_s_sleep(1); \
    if ((++_sp & 255u) == 0u) { if (xb_ld(&(bar)[XB_TMO])) break; if (_sp > XB_SPIN_CAP) { atomicAdd(&(bar)[XB_TMO], 1u); break; } } } } while (0)

struct XcdBarrier {
    unsigned* bar; unsigned x;
    volatile LAS unsigned* st;
};

__device__ __forceinline__ XcdBarrier xcd_barrier_post(unsigned* bar, volatile LAS unsigned* st) {
    XcdBarrier b; b.bar = bar; b.x = xb_xcc_id(); b.st = st;
    if (threadIdx.x == 0) (void)xb_add(&bar[XB_XCNT(b.x)], 1u);
    return b;
}
__device__ __forceinline__ void xcd_barrier_complete(unsigned* bar, unsigned x, unsigned& nloc, unsigned& nx) {
    const unsigned G = gridDim.x * gridDim.y * gridDim.z;
    unsigned sum, cnt, mine, sp = 0u;
    for (;;) {
        sum = 0u; cnt = 0u; mine = 0u;
#pragma unroll
        for (unsigned j = 0; j < 16; ++j) { const unsigned c = xb_ld(&bar[XB_XCNT(j)]); sum += c; cnt += (c > 0u) ? 1u : 0u; mine = (j == x) ? c : mine; }
        if (sum == G) break;
        __builtin_amdgcn_s_sleep(1);
        if ((++sp & 255u) == 0u) { if (xb_ld(&bar[XB_TMO])) break; if (sp > XB_SPIN_CAP) { atomicAdd(&bar[XB_TMO], 1u); break; } }
    }
    nloc = mine > 0u ? mine : 1u; nx = cnt > 0u ? cnt : 1u;
}

__device__ __forceinline__ void xcd_barrier(const XcdBarrier& b) {
    asm volatile("s_waitcnt vmcnt(0)" ::: "memory");
    __syncthreads();
    if (threadIdx.x == 0) {
        unsigned* bar = b.bar;
        __builtin_amdgcn_s_waitcnt(0);
        unsigned nloc = b.st[0], nx = b.st[1];
        if (nloc == 0u) { xcd_barrier_complete(bar, b.x, nloc, nx); b.st[0] = nloc; b.st[1] = nx; }
        const unsigned old = xb_add(&bar[XB_XSUB(b.x)], 1u);
        const unsigned gen = old / nloc;
        if (old + 1u == (gen + 1u) * nloc) {
            __builtin_amdgcn_fence(__ATOMIC_RELEASE, "agent");
            asm volatile("s_waitcnt vmcnt(0)" ::: "memory");
            const unsigned og = xb_add(&bar[XB_TOP], 1u);
            const unsigned tg = og / nx;
            if (og + 1u == (tg + 1u) * nx) xb_add(&bar[XB_TOPGEN], 1u);
            else XB_SPIN(xb_ld(&bar[XB_TOPGEN]) == tg, bar);
            __builtin_amdgcn_fence(__ATOMIC_ACQUIRE, "agent");
            xb_add(&bar[XB_XGEN(b.x)], 1u);
            asm volatile("s_waitcnt vmcnt(0)" ::: "memory");
        } else {
            XB_SPIN(xb_ld(&bar[XB_XGEN(b.x)]) == gen, bar);
            __builtin_amdgcn_fence(__ATOMIC_ACQUIRE, "agent");
            asm volatile("s_waitcnt vmcnt(0)" ::: "memory");
        }
    }
    __syncthreads();
}
constexpr int DM = 1024, NB = 8, SEQ = 4096, NS = 128, SSQ = 4;
constexpr int DL = 512, NH = 8, HD = 64, DIN = 2560, DFF = 3072;
constexpr int MP = NB * SEQ, MS = NS * SSQ, M = MP + MS;
constexpr float EPS = 1e-6f;
constexpr float C2 = 0.125f * 1.4426950408889634f;
constexpr int NWAVES = 8, NTHR = 512;
#ifndef N_LAUNCH
#define N_LAUNCH 9
#endif
constexpr int NPH = 9;

constexpr size_t O_Y = 0;
constexpr size_t O_PCA = (size_t)M * DM;
constexpr size_t O_PLH = O_PCA + (size_t)NB * 3 * DL;
constexpr size_t O_PWK = O_PLH + (size_t)NB * DL;
constexpr size_t O_PWV = O_PWK + (size_t)NB * 2048 * 512;
constexpr size_t O_PCF = O_PWV + (size_t)NB * 2048 * 512;
constexpr size_t O_SCA = O_PCF + (size_t)NB * 2 * DFF;
constexpr size_t O_SLH = O_SCA + (size_t)NS * 3 * DL;
constexpr size_t O_SWK = O_SLH + (size_t)NS * DL;
constexpr size_t O_SWV = O_SWK + (size_t)NS * 4 * 512;
constexpr size_t O_SCF = O_SWV + (size_t)NS * 4 * 512;
constexpr size_t O_END = O_SCF + (size_t)NS * 2 * DFF;
static_assert(O_END == 52494336, "output size");

constexpr size_t MiB = 1u << 20;
constexpr size_t WS_CTL = 0, CTL_ZERO_BYTES = 1 * MiB;
constexpr size_t WS_WIN = 2 * MiB, WS_WOUT = 7 * MiB, WS_WGU = 9 * MiB, WS_WDN = 21 * MiB, WS_WL = 27 * MiB;
constexpr size_t WS_C8 = 28 * MiB, WS_ROPE = 28 * MiB + 65536, WS_RS1 = 29 * MiB, WS_SSP = 30 * MiB, WS_SSP2 = 33 * MiB;
constexpr size_t WS_AGGA = 36 * MiB, WS_AGGB = 37 * MiB, WS_QS = 38 * MiB, WS_LSE = 40 * MiB;
constexpr size_t WS_XN = 48 * MiB, WS_XA = 116 * MiB, WS_GA = 150 * MiB, WS_Q = 184 * MiB, WS_K = 218 * MiB, WS_V = 252 * MiB;
constexpr size_t WS_OP = 288 * MiB, WS_MIX = 384 * MiB, WS_X1B = 450 * MiB, WS_UFU = 516 * MiB, WS_H = 908 * MiB, WS_END = 1104 * MiB;
constexpr int CW_BAR = 4096;

constexpr int RING_BYTES = 131072, LDSCTL_OFF = RING_BYTES, MISC_OFF = LDSCTL_OFF + 320, LDS_BYTES = 147456;

typedef float f32x16 __attribute__((ext_vector_type(16)));
typedef short s16x4 __attribute__((ext_vector_type(4)));
typedef unsigned u32x2 __attribute__((ext_vector_type(2)));

__device__ __forceinline__ float bflo(unsigned w) { return __uint_as_float(w << 16); }
__device__ __forceinline__ float bfhi(unsigned w) { return __uint_as_float(w & 0xffff0000u); }
__device__ __forceinline__ float bf2f(bf16 h) { return __uint_as_float((unsigned)h << 16); }
__device__ __forceinline__ void unpack8(const v4u w, float (&x)[8]) { x[0] = bflo(w.x); x[1] = bfhi(w.x); x[2] = bflo(w.y); x[3] = bfhi(w.y); x[4] = bflo(w.z); x[5] = bfhi(w.z); x[6] = bflo(w.w); x[7] = bfhi(w.w); }
__device__ __forceinline__ v4u pack8(const float (&x)[8]) { v4u w; w.x = pk2(x[0], x[1]); w.y = pk2(x[2], x[3]); w.z = pk2(x[4], x[5]); w.w = pk2(x[6], x[7]); return w; }
__device__ __forceinline__ int crow(int r, int hi) { return (r & 3) + 8 * (r >> 2) + 4 * hi; }
__device__ __forceinline__ float wave_sum(float v) {
#pragma unroll
    for (int o = 1; o < 64; o <<= 1) v += __shfl_xor(v, o);
    return v;
}
__device__ __forceinline__ float sigmoidf_(float x) { return __builtin_amdgcn_rcpf(1.f + __expf(-x)); }
__device__ __forceinline__ float one_minus_exp(float x) {
    float p = 1.f / 720.f; p = p * x + 1.f / 120.f; p = p * x + 1.f / 24.f; p = p * x + 1.f / 6.f; p = p * x + 0.5f; p = p * x + 1.f;
    const float e = 1.f - __expf(x); return x > -0.35f ? -x * p : e; }
__device__ __forceinline__ float gelu_tanh(float x) { const float y = 0.7978845608028654f * (x + 0.044715f * x * x * x); const float t = 1.f - 2.f * __builtin_amdgcn_rcpf(1.f + __expf(2.f * y)); return 0.5f * x * (1.f + t); }

struct Args { const float* in[24]; float* out; unsigned char* ws; int ph_lo, ph_hi; };
enum { I_XP = 0, I_XS, I_SCA, I_SLH, I_CK, I_CV, I_SCF, I_GMIX, I_WIN, I_CAW, I_CAB, I_WR, I_BR, I_WI, I_BI, I_LAM, I_WOUT, I_GFFN, I_WG, I_CFW, I_CFB, I_WU, I_WD, I_GFIN };

__device__ __forceinline__ const float* xrow(const Args& a, int m) { return m < MP ? a.in[I_XP] + (size_t)m * DM : a.in[I_XS] + (size_t)(m - MP) * DM; }

__device__ __forceinline__ void p0_transpose_item(const float* W, const float* gk, int K, int N, bf16* WT, int row_off, LAS float* scr, int item, int lane) {
    const int nblk = N / 32, kb = item / nblk, nb = item % nblk, k0 = 64 * kb, n0 = 32 * nb;
#pragma unroll 8
    for (int i = 0; i < 32; ++i) { const int kk = 2 * i + (lane >> 5); const float g = gk ? gk[k0 + kk] : 1.f; scr[kk * 33 + (lane & 31)] = W[(size_t)(k0 + kk) * N + n0 + (lane & 31)] * g; }
    LDS_WAIT(); asm volatile("" ::: "memory");
    const int c = lane & 7;
#pragma unroll
    for (int j = 0; j < 4; ++j) { const int n = (lane >> 3) + 8 * j; const LAS float* s = scr + (8 * c) * 33 + n;
        v4u o; o.x = pk2(s[0 * 33], s[1 * 33]); o.y = pk2(s[2 * 33], s[3 * 33]); o.z = pk2(s[4 * 33], s[5 * 33]); o.w = pk2(s[6 * 33], s[7 * 33]);
        *(GAS v4u*)(WT + (size_t)(row_off + n0 + n) * K + k0 + 8 * c) = o; }
    LDS_WAIT(); asm volatile("" ::: "memory");
}

__device__ __forceinline__ void p0_prologue(const Args& a, LAS unsigned char* lds, int tid, int wave, int lane, int vcu, int G) {
    unsigned char* ws = a.ws;
    LAS float* scr = (LAS float*)(lds + wave * 16384);
    const int gw = vcu * NWAVES + wave, NGW = G * NWAVES;
    constexpr int I_A = (DM / 64) * (DIN / 32), I_B = (DM / 64) * (DM / 32), I_C = (DM / 64) * (DFF / 32), I_D = (DFF / 64) * (DM / 32);
    constexpr int NITEMS = I_A + I_B + 2 * I_C + I_D;
    for (int it = gw; it < NITEMS; it += NGW) {
        int r = it;
        if (r < I_A) { p0_transpose_item(a.in[I_WIN], a.in[I_GMIX], DM, DIN, (bf16*)(ws + WS_WIN), 0, scr, r, lane); continue; } r -= I_A;
        if (r < I_B) { p0_transpose_item(a.in[I_WOUT], nullptr, DM, DM, (bf16*)(ws + WS_WOUT), 0, scr, r, lane); continue; } r -= I_B;
        if (r < I_C) { p0_transpose_item(a.in[I_WG], a.in[I_GFFN], DM, DFF, (bf16*)(ws + WS_WGU), 0, scr, r, lane); continue; } r -= I_C;
        if (r < I_C) { p0_transpose_item(a.in[I_WU], a.in[I_GFFN], DM, DFF, (bf16*)(ws + WS_WGU), DFF, scr, r, lane); continue; } r -= I_C;
        p0_transpose_item(a.in[I_WD], nullptr, DFF, DM, (bf16*)(ws + WS_WDN), 0, scr, r, lane);
    }
    const int gt = vcu * NTHR + tid, NGT = G * NTHR;
    { bf16* WL = (bf16*)(ws + WS_WL);
      for (int e = gt; e < 8 * 192 * 64; e += NGT) { const int i = e & 63, o = (e >> 6) % 192, g = e / (192 * 64); float v;
          if (o < 64) v = a.in[I_WR][(g * 64 + i) * 64 + o]; else if (o < 128) v = a.in[I_WI][(g * 64 + i) * 64 + (o - 64)]; else v = (i == o - 128) ? 1.f : 0.f;
          WL[e] = (bf16)f2bf(v); } }
    { float* c8 = (float*)(ws + WS_C8);
      for (int e = gt; e < DL; e += NGT) { const float lam = a.in[I_LAM][e]; const float sp = (lam < -20.f) ? -lam : log1pf(expf(-lam)); c8[e] = 8.f * sp; } }
    { float* rope = (float*)(ws + WS_ROPE);
      for (int e = gt; e < 4100 * 8; e += NGT) { const int pi = e >> 3, i = e & 7; const double pos = pi < 4096 ? (double)pi : (double)(8192 + (pi - 4096));
          const double inv = pow(500000.0, -(double)i / 8.0), ang = pos * inv; rope[pi * 16 + i] = (float)cos(ang); rope[pi * 16 + 8 + i] = (float)sin(ang); } }
    { bf16* XN = (bf16*)(ws + WS_XN); float* RS1 = (float*)(ws + WS_RS1);
      for (int m = gw; m < M; m += NGW) { const GAS f32x4* xr = (const GAS f32x4*)xrow(a, m) + lane; f32x4 v[4]; float s = 0.f;
#pragma unroll
          for (int j = 0; j < 4; ++j) { v[j] = xr[64 * j]; s += (v[j].x * v[j].x + v[j].y * v[j].y) + (v[j].z * v[j].z + v[j].w * v[j].w); }
          s = wave_sum(s); if (lane == 0) RS1[m] = 1.f / sqrtf(s * (1.f / DM) + EPS);
          GAS unsigned long long* o8 = (GAS unsigned long long*)(XN + (size_t)m * DM) + lane;
#pragma unroll
          for (int j = 0; j < 4; ++j) o8[64 * j] = (unsigned long long)pk2(v[j].x, v[j].y) | ((unsigned long long)pk2(v[j].z, v[j].w) << 32); } }
}

struct EpiZ {
    static constexpr bool PERM = true, AFTER_DRAIN = false;
    const float* rs1; const float* rope; bf16 *XA, *GA, *Q, *K, *V; float* QS; float* out;
    __device__ __forceinline__ void operator()(const pg8::f32x4 (&acc)[2][2][4][2], const pg8::Unit& u, int wr, int wc, int fr, int fq) const {
        const int type = u.pn >> 1;
        const int cbase = (u.pn & 1) * 256 + wc * 32 + 8 * fq;
#pragma unroll
        for (int ai = 0; ai < 2; ++ai)
#pragma unroll
            for (int m = 0; m < 4; ++m) {
                const int row = u.pm * 256 + ai * 128 + wr * 64 + m * 16 + fr;
                const float rs = rs1[row];
                const bool samp = row >= MP;
                const int b = samp ? ((row - MP) >> 2) : (row >> 12), t = samp ? (row & 3) : (row & 4095);
#pragma unroll
                for (int bj = 0; bj < 2; ++bj) {
                    const int ct = cbase + 128 * bj;
                    float v[8];
#pragma unroll
                    for (int i = 0; i < 4; ++i) { v[i] = acc[ai][bj][m][0][i] * rs; v[4 + i] = acc[ai][bj][m][1][i] * rs; }
                    if (type == 2 || type == 3) {
                        if ((wc & 1) == 0) {
                            float pv[8];
#pragma unroll
                            for (int i = 0; i < 8; ++i) pv[i] = __shfl_xor(v[i], 16);
                            if (fq < 2) { const float* rp = rope + (size_t)(samp ? 4096 + t : t) * 16; const float sg = fq == 0 ? -1.f : 1.f;
                                const f32x4 c0 = *(const f32x4*)rp, c1 = *(const f32x4*)(rp + 4), s0 = *(const f32x4*)(rp + 8), s1 = *(const f32x4*)(rp + 12);
#pragma unroll
                                for (int i = 0; i < 4; ++i) { v[i] = v[i] * c0[i] + sg * pv[i] * s0[i]; v[4 + i] = v[4 + i] * c1[i] + sg * pv[4 + i] * s1[i]; } }
                        }
                    }
                    float* so = nullptr;
                    bf16* dst;
                    if (type == 0) { dst = XA; if (!samp) { if (t >= SEQ - 3) so = out + O_PCA + (size_t)(b * 3 + (t - (SEQ - 3))) * DL + ct; } else if (t >= 1) so = out + O_SCA + (size_t)(b * 3 + t - 1) * DL + ct; }
                    else if (type == 1) dst = GA;
                    else if (type == 2) { dst = Q;
#pragma unroll
                        for (int i = 0; i < 8; ++i) v[i] *= C2;
                        if (samp) so = QS + (size_t)(row - MP) * 512 + ct; }
                    else if (type == 3) { dst = K; if (!samp) { if (t >= 2048) so = out + O_PWK + (size_t)(b * 2048 + t - 2048) * 512 + ct; } else so = out + O_SWK + (size_t)(b * 4 + t) * 512 + ct; }
                    else { dst = V; if (!samp) { if (t >= 2048) so = out + O_PWV + (size_t)(b * 2048 + t - 2048) * 512 + ct; } else so = out + O_SWV + (size_t)(b * 4 + t) * 512 + ct; }
                    *(v4u*)(dst + (size_t)row * 512 + ct) = pack8(v);
                    if (so) { *(f32x4*)so = (f32x4){v[0], v[1], v[2], v[3]}; *(f32x4*)(so + 4) = (f32x4){v[4], v[5], v[6], v[7]}; }
                }
            }
    }
};
struct EpiX1 {
    static constexpr bool PERM = true, AFTER_DRAIN = false;
    const float* xp; const float* xs; float* Y; bf16* X1B; float* SSP;
    __device__ __forceinline__ void operator()(const pg8::f32x4 (&acc)[2][2][4][2], const pg8::Unit& u, int wr, int wc, int fr, int fq) const {
        const int cbase = u.pn * 256 + wc * 32 + 8 * fq;
#pragma unroll
        for (int ai = 0; ai < 2; ++ai)
#pragma unroll
            for (int m = 0; m < 4; ++m) {
                const int row = u.pm * 256 + ai * 128 + wr * 64 + m * 16 + fr;
                const float* xr = row < MP ? xp + (size_t)row * DM : xs + (size_t)(row - MP) * DM;
                float ss = 0.f;
#pragma unroll
                for (int bj = 0; bj < 2; ++bj) {
                    const int ct = cbase + 128 * bj;
                    const f32x4 x0 = *(const f32x4*)(xr + ct), x1 = *(const f32x4*)(xr + ct + 4);
                    const f32x4 o0 = x0 + acc[ai][bj][m][0], o1 = x1 + acc[ai][bj][m][1];
                    *(f32x4*)(Y + (size_t)row * DM + ct) = o0; *(f32x4*)(Y + (size_t)row * DM + ct + 4) = o1;
                    const float v[8] = {o0[0], o0[1], o0[2], o0[3], o1[0], o1[1], o1[2], o1[3]};
                    *(v4u*)(X1B + (size_t)row * DM + ct) = pack8(v);
#pragma unroll
                    for (int i = 0; i < 8; ++i) ss += v[i] * v[i];
                }
                ss += __shfl_xor(ss, 16); ss += __shfl_xor(ss, 32);
                if (fq == 0) SSP[(size_t)row * 16 + u.pn * 4 + wc] = ss;
            }
    }
};
__device__ __forceinline__ float row_rs(const float* SSP, int row) {
    const f32x4* p = (const f32x4*)(SSP + (size_t)row * 16); const f32x4 a = p[0], b = p[1], c = p[2], d = p[3];
    const float s = ((a[0] + a[1]) + (a[2] + a[3])) + ((b[0] + b[1]) + (b[2] + b[3])) + ((c[0] + c[1]) + (c[2] + c[3])) + ((d[0] + d[1]) + (d[2] + d[3]));
    return 1.f / sqrtf(s * (1.f / DM) + EPS);
}
struct EpiGU {
    static constexpr bool PERM = true, AFTER_DRAIN = false;
    const float* SSP; bf16* UFU;
    __device__ __forceinline__ void operator()(const pg8::f32x4 (&acc)[2][2][4][2], const pg8::Unit& u, int wr, int wc, int fr, int fq) const {
        const int cbase = u.pn * 256 + wc * 32 + 8 * fq;
#pragma unroll
        for (int ai = 0; ai < 2; ++ai)
#pragma unroll
            for (int m = 0; m < 4; ++m) {
                const int row = u.pm * 256 + ai * 128 + wr * 64 + m * 16 + fr;
                const float rs = row_rs(SSP, row);
#pragma unroll
                for (int bj = 0; bj < 2; ++bj) {
                    const int ct = cbase + 128 * bj; float v[8];
#pragma unroll
                    for (int i = 0; i < 4; ++i) { v[i] = acc[ai][bj][m][0][i] * rs; v[4 + i] = acc[ai][bj][m][1][i] * rs; }
                    *(v4u*)(UFU + (size_t)row * (2 * DFF) + ct) = pack8(v);
                }
            }
    }
};
struct EpiX2 {
    static constexpr bool PERM = true, AFTER_DRAIN = false;
    float* Y; float* SSP;
    __device__ __forceinline__ void operator()(const pg8::f32x4 (&acc)[2][2][4][2], const pg8::Unit& u, int wr, int wc, int fr, int fq) const {
        const int cbase = u.pn * 256 + wc * 32 + 8 * fq;
#pragma unroll
        for (int ai = 0; ai < 2; ++ai)
#pragma unroll
            for (int m = 0; m < 4; ++m) {
                const int row = u.pm * 256 + ai * 128 + wr * 64 + m * 16 + fr;
                float ss = 0.f;
#pragma unroll
                for (int bj = 0; bj < 2; ++bj) {
                    const int ct = cbase + 128 * bj; float* yp = Y + (size_t)row * DM + ct;
                    const f32x4 o0 = *(const f32x4*)yp + acc[ai][bj][m][0], o1 = *(const f32x4*)(yp + 4) + acc[ai][bj][m][1];
                    *(f32x4*)yp = o0; *(f32x4*)(yp + 4) = o1;
                    ss += (o0[0] * o0[0] + o0[1] * o0[1]) + (o0[2] * o0[2] + o0[3] * o0[3]) + (o1[0] * o1[0] + o1[1] * o1[1]) + (o1[2] * o1[2] + o1[3] * o1[3]);
                }
                ss += __shfl_xor(ss, 16); ss += __shfl_xor(ss, 32);
                if (fq == 0) SSP[(size_t)row * 16 + u.pn * 4 + wc] = ss;
            }
    }
};
__device__ __forceinline__ void load8_bf16(const bf16* p, float (&x)[8]) { unpack8(*(const v4u*)p, x); }
__device__ __forceinline__ void load8_f32(const float* p, float (&x)[8]) { const f32x4 a = *(const f32x4*)p, b = *(const f32x4*)(p + 4); x[0] = a[0]; x[1] = a[1]; x[2] = a[2]; x[3] = a[3]; x[4] = b[0]; x[5] = b[1]; x[6] = b[2]; x[7] = b[3]; }

constexpr int LRU_CS = 64 * 16 + 16;
template <int MODE> __device__ __forceinline__ void lru_item(const Args& a, int item, LAS unsigned char* lds, int wid, int lane) {
    unsigned char* ws = a.ws;
    const bf16* XA = (const bf16*)(ws + WS_XA); const bf16* GAb = (const bf16*)(ws + WS_GA); const bf16* WL = (const bf16*)(ws + WS_WL);
    const float* C8 = (const float*)(ws + WS_C8); float* AGGA = (float*)(ws + WS_AGGA); float* AGGB = (float*)(ws + WS_AGGB); bf16* MIX = (bf16*)(ws + WS_MIX);
    const int seq = item >> 6, chunk = item & 63, g = wid;
    const int row0 = (MODE == 2) ? MP + item * 64 : seq * SEQ + chunk * 64;
    {
        float w[4][8], bb[8];
#pragma unroll
        for (int j = 0; j < 4; ++j) load8_f32(a.in[I_CAW] + j * DL + 8 * lane, w[j]);
        load8_f32(a.in[I_CAB] + 8 * lane, bb);
#pragma unroll 1
        for (int it = 0; it < 8; ++it) {
            const int tok = it * 8 + wid;
            float s[8];
#pragma unroll
            for (int i = 0; i < 8; ++i) s[i] = bb[i];
#pragma unroll
            for (int j = 0; j < 4; ++j) {
                float x[8];
                if (MODE != 2) { const int t = chunk * 64 + tok - 3 + j;
                    if (t >= 0) load8_bf16(XA + (size_t)(seq * SEQ + t) * DL + 8 * lane, x); else {
#pragma unroll
                        for (int i = 0; i < 8; ++i) x[i] = 0.f; } }
                else { const int n = item * 16 + (tok >> 2), e = (tok & 3) + j;
                    if (e < 3) load8_f32(a.in[I_SCA] + (size_t)(n * 3 + e) * DL + 8 * lane, x); else load8_bf16(XA + (size_t)(MP + 4 * n + e - 3) * DL + 8 * lane, x); }
#pragma unroll
                for (int i = 0; i < 8; ++i) s[i] += w[j][i] * x[i];
            }
            *(LAS v4u*)(lds + lane * LRU_CS + tok * 16) = pack8(s);
        }
    }
    __syncthreads();
    const int r32 = lane & 31, hi = lane >> 5;
    float hc0 = 0.f, hc1 = 0.f, At0 = 1.f, At1 = 1.f;
    if (MODE == 1) {
        for (int c = 0; c < chunk; ++c) { const size_t o = (size_t)(seq * 64 + c) * DL + 64 * g + r32;
            hc0 = AGGA[o] * hc0 + AGGB[o]; hc1 = AGGA[o + 32] * hc1 + AGGB[o + 32]; }
    }
#pragma unroll 1
    for (int mc = 0; mc < 4; ++mc) {
        const int mt = mc >> 1, ct = mc & 1;
        const int ch = 64 * g + 32 * ct + r32;
        float hcur = ct ? hc1 : hc0, Atc = ct ? At1 : At0;
        bf16x8 af[4];
#pragma unroll
        for (int ks = 0; ks < 4; ++ks) af[ks] = *(const LAS bf16x8*)(lds + (8 * g + 2 * ks + hi) * LRU_CS + (32 * mt + r32) * 16);
        f32x16 D[3];
        const bf16* wlp = WL + (size_t)((g * 192 + 32 * ct + r32) * 64 + 8 * hi);
#pragma unroll
        for (int o = 0; o < 3; ++o) {
            D[o] = f32x16{};
#pragma unroll
            for (int ks = 0; ks < 4; ++ks) {
                const bf16x8 bfr = *(const bf16x8*)(wlp + o * 64 * 64 + 16 * ks);
                D[o] = __builtin_amdgcn_mfma_f32_32x32x16_bf16(af[ks], bfr, D[o], 0, 0, 0);
            }
        }
        const float br = a.in[I_BR][ch], bi = a.in[I_BI][ch], c8 = C8[ch];
        float av[16], uv[16];
#pragma unroll
        for (int r = 0; r < 16; ++r) {
            const float rr = sigmoidf_(D[0][r] + br), gi = sigmoidf_(D[1][r] + bi);
            const float la = -c8 * rr; av[r] = __expf(la); uv[r] = __builtin_amdgcn_sqrtf(one_minus_exp(2.f * la)) * gi * D[2][r];
        }
        if (MODE == 2) {
#pragma unroll
            for (int k = 0; k < 4; ++k) {
                const int n = item * 16 + 8 * mt + 2 * k + hi;
                float hh = a.in[I_SLH][(size_t)n * DL + ch];
#pragma unroll
                for (int i = 0; i < 4; ++i) { hh = av[4 * k + i] * hh + uv[4 * k + i]; uv[4 * k + i] = hh; }
                a.out[O_SLH + (size_t)n * DL + ch] = hh;
            }
        } else {
#pragma unroll
            for (int k = 0; k < 4; ++k) {
                const float a0 = av[4 * k], a1 = av[4 * k + 1], a2 = av[4 * k + 2], a3 = av[4 * k + 3];
                const float GAm = (a0 * a1) * (a2 * a3), GBm = ((uv[4 * k] * a1 + uv[4 * k + 1]) * a2 + uv[4 * k + 2]) * a3 + uv[4 * k + 3];
                const float Ao = __shfl_xor(GAm, 32), Bo = __shfl_xor(GBm, 32);
                const float A1 = hi ? Ao : GAm, B1 = hi ? Bo : GBm, A2 = hi ? GAm : Ao, B2 = hi ? GBm : Bo;
                const float hin1 = hcur; hcur = A1 * hcur + B1; const float hin2 = hcur; hcur = A2 * hcur + B2; Atc *= A1 * A2;
                if (MODE == 1) { float hh = hi ? hin2 : hin1;
#pragma unroll
                    for (int i = 0; i < 4; ++i) { hh = av[4 * k + i] * hh + uv[4 * k + i]; uv[4 * k + i] = hh; } }
            }
        }
        if (MODE != 0) {
            const bf16* gap = GAb + (size_t)(row0 + 32 * mt + 4 * hi) * DL + ch; bf16* mxp = MIX + (size_t)(row0 + 32 * mt + 4 * hi) * DM + ch;
#pragma unroll
            for (int r = 0; r < 16; ++r) { const int ro = (r & 3) + 8 * (r >> 2);
                const float gav = bf2f(gap[ro * DL]); mxp[ro * DM] = (bf16)f2bf(uv[r] * gelu_tanh(gav)); }
        }
        if (ct) { hc1 = hcur; At1 = Atc; } else { hc0 = hcur; At0 = Atc; }
    }
#pragma unroll
    for (int ct = 0; ct < 2; ++ct) {
        const int ch = 64 * g + 32 * ct + r32; const float Af = ct ? At1 : At0, hf = ct ? hc1 : hc0;
        if (MODE == 0) { if (hi == 0) { AGGA[(size_t)(seq * 64 + chunk) * DL + ch] = Af; AGGB[(size_t)(seq * 64 + chunk) * DL + ch] = hf; } }
        if (MODE == 1) { if (chunk == 63 && hi == 0) a.out[O_PLH + (size_t)seq * DL + ch] = hf; }
    }
    __syncthreads();
}

constexpr int NK = 384, KCS = NK * 16 + 16, VDS = NK * 64 + 64, ATT_K = 0, ATT_V = 8 * KCS, ATT_WS = ATT_V + 2 * VDS;
static_assert(ATT_WS + NWAVES * 256 <= RING_BYTES, "attention LDS");
__device__ __forceinline__ s16x4 vtr(const LAS unsigned char* p) { typedef short v4i16_t __attribute__((ext_vector_type(4))); return __builtin_bit_cast(s16x4, __builtin_amdgcn_ds_read_tr16_b64_v4i16((LAS v4i16_t*)p)); }

__device__ __forceinline__ void attn_prompt_unit(const Args& a, int unit, LAS unsigned char* lds, int tid, int wid, int lane) {
    unsigned char* ws = a.ws;
    const bf16* Qb = (const bf16*)(ws + WS_Q); const bf16* Kb = (const bf16*)(ws + WS_K); const bf16* Vb = (const bf16*)(ws + WS_V);
    bf16* OP = (bf16*)(ws + WS_OP); float* LSE = (float*)(ws + WS_LSE);
    const int u16 = unit & 15, p = (unit >> 4) % 3, bh = unit / 48, b = bh >> 3, h = bh & 7;
    const int ld = 2 * p, d = 1 << ld;
    const int lnb = 4 - ld, blk = u16 & ((1 << lnb) - 1), r = u16 >> lnb;
    const int j0 = 256 * blk - 128;
    const int kk_min = (blk == 0) ? 128 : 0;
    const size_t rowb = (size_t)b * SEQ;
#pragma unroll
    for (int i = 0; i < 6; ++i) {
        const int piece = tid + NTHR * i, kk = piece >> 3, c = piece & 7;
        if (kk >= kk_min) {
            const size_t row = rowb + (size_t)(r + d * (j0 + kk));
            const v4u kv = *(const v4u*)(Kb + row * 512 + h * 64 + c * 8), vv = *(const v4u*)(Vb + row * 512 + h * 64 + c * 8);
            *(LAS v4u*)(lds + ATT_K + c * KCS + kk * 16) = kv;
            *(LAS v4u*)(lds + ATT_V + (c >> 2) * VDS + kk * 64 + (c & 3) * 16) = vv;
        }
    }
    const int r32 = lane & 31, hi = lane >> 5;
    bf16x8 qr[4];
    { const size_t qrow = rowb + (size_t)(r + d * (256 * blk + 32 * wid + r32));
#pragma unroll
      for (int ks = 0; ks < 4; ++ks) qr[ks] = *(const bf16x8*)(Qb + qrow * 512 + h * 64 + 16 * ks + 8 * hi); }
    __syncthreads();
    const int kt0 = (blk == 0 && wid < 4) ? 4 - wid : 0;
    f32x16 pt[5];
#pragma unroll
    for (int kt = 0; kt < 5; ++kt) {
        if (kt >= kt0) {
            const int T = wid + kt; f32x16 acc = f32x16{};
#pragma unroll
            for (int ks = 0; ks < 4; ++ks) { const bf16x8 kf = *(const LAS bf16x8*)(lds + ATT_K + (2 * ks + hi) * KCS + (32 * T + r32) * 16);
                acc = __builtin_amdgcn_mfma_f32_32x32x16_bf16(kf, qr[ks], acc, 0, 0, 0); }
            if (kt == 0) {
#pragma unroll
                for (int rg = 0; rg < 16; ++rg) if (crow(rg, hi) < r32) acc[rg] = -INFINITY; }
            if (kt == 4) {
#pragma unroll
                for (int rg = 0; rg < 16; ++rg) if (crow(rg, hi) > r32) acc[rg] = -INFINITY; }
            pt[kt] = acc;
        } else {
#pragma unroll
            for (int rg = 0; rg < 16; ++rg) pt[kt][rg] = -INFINITY;
        }
    }
    float mx = -INFINITY;
#pragma unroll
    for (int kt = 0; kt < 5; ++kt)
#pragma unroll
        for (int rg = 0; rg < 16; ++rg) mx = fmaxf(mx, pt[kt][rg]);
    mx = fmaxf(mx, __shfl_xor(mx, 32));
    float lsum = 0.f;
#pragma unroll
    for (int kt = 0; kt < 5; ++kt)
#pragma unroll
        for (int rg = 0; rg < 16; ++rg) { const float e = __builtin_amdgcn_exp2f(pt[kt][rg] - mx); pt[kt][rg] = e; lsum += e; }
    lsum += __shfl_xor(lsum, 32);
    f32x16 o[2]; o[0] = f32x16{}; o[1] = f32x16{};
    const LAS unsigned char* vb = lds + ATT_V + ((lane >> 4) & 1) * 32 + (lane & 3) * 8 + (4 * hi + ((lane & 15) >> 2)) * 64;
#pragma unroll
    for (int kt = 0; kt < 5; ++kt) {
        if (kt >= kt0) {
            const int T = wid + kt;
#pragma unroll
            for (int s = 0; s < 2; ++s) {
                v4u pw; pw.x = pg8::cvt_pk_bf16(pt[kt][8 * s], pt[kt][8 * s + 1]); pw.y = pg8::cvt_pk_bf16(pt[kt][8 * s + 2], pt[kt][8 * s + 3]);
                pw.z = pg8::cvt_pk_bf16(pt[kt][8 * s + 4], pt[kt][8 * s + 5]); pw.w = pg8::cvt_pk_bf16(pt[kt][8 * s + 6], pt[kt][8 * s + 7]);
                const bf16x8 pa = __builtin_bit_cast(bf16x8, pw);
#pragma unroll
                for (int d0 = 0; d0 < 2; ++d0) {
                    const LAS unsigned char* vp = vb + d0 * VDS + (32 * T + 16 * s) * 64;
                    const s16x4 lo = vtr(vp), hh = vtr(vp + 512);
                    const bf16x8 vf = (bf16x8){lo[0], lo[1], lo[2], lo[3], hh[0], hh[1], hh[2], hh[3]};
                    o[d0] = __builtin_amdgcn_mfma_f32_32x32x16_bf16(pa, vf, o[d0], 0, 0, 0);
                }
            }
        }
    }
    LAS float* wsf = (LAS float*)(lds + ATT_WS) + wid * 64;
    if (hi == 0) wsf[r32] = __builtin_amdgcn_rcpf(lsum);
    const size_t qrow_l = rowb + (size_t)(r + d * (256 * blk + 32 * wid + r32));
    if (hi == 0) LSE[((size_t)p * MP + qrow_l) * 8 + h] = mx + __builtin_amdgcn_logf(lsum);
    LDS_WAIT(); asm volatile("" ::: "memory");
#pragma unroll
    for (int rg = 0; rg < 16; ++rg) {
        const int qi = crow(rg, hi); const float rl = wsf[qi];
        const size_t orow = rowb + (size_t)(r + d * (256 * blk + 32 * wid + qi));
        bf16* op = OP + ((size_t)p * MP + orow) * 512 + h * 64 + r32;
        op[0] = (bf16)f2bf(o[0][rg] * rl); op[32] = (bf16)f2bf(o[1][rg] * rl);
    }
    __syncthreads();
}

__device__ __forceinline__ void attn_sample_item(const Args& a, int item, LAS unsigned char* lds, int tid, int wid, int lane) {
    unsigned char* ws = a.ws;
    const float* QS = (const float*)(ws + WS_QS); bf16* MIX = (bf16*)(ws + WS_MIX);
    const float* CK = a.in[I_CK]; const float* CV = a.in[I_CV];
    const int n = item >> 3, h = item & 7, sub = lane & 15, grp = lane >> 4;
    f32x4 q[4];
#pragma unroll
    for (int s = 0; s < 4; ++s) q[s] = *(const f32x4*)(QS + (size_t)(4 * n + s) * 512 + h * 64 + 4 * sub);
    float m[4], l[4]; f32x4 O[4];
#pragma unroll
    for (int s = 0; s < 4; ++s) { m[s] = -1e30f; l[s] = 0.f; O[s] = (f32x4){0.f, 0.f, 0.f, 0.f}; }
#pragma unroll 1
    for (int it4 = 0; it4 < 8; ++it4) {
        f32x4 kv[4], vv[4]; int idxs[4];
#pragma unroll
        for (int u = 0; u < 4; ++u) {
            const int i = (it4 * 4 + u) * 32 + wid * 4 + grp;
            int idx; if (i < 512) idx = 1536 + i; else if (i < 896) { const int k = i - 512; idx = 16 * (k >> 2) + (k & 3); } else idx = 2048 + ((i - 896) & 3);
            const float* kp; const float* vp;
            if (idx < 2048) { const size_t off = (((size_t)n * 2048 + idx) * 8 + h) * 64 + 4 * sub; kp = CK + off; vp = CV + off; }
            else { const size_t off = (size_t)(n * 4 + idx - 2048) * 512 + h * 64 + 4 * sub; kp = a.out + O_SWK + off; vp = a.out + O_SWV + off; }
            kv[u] = *(const f32x4*)kp; vv[u] = *(const f32x4*)vp; idxs[u] = (i < 900) ? idx : -1;
        }
#pragma unroll
        for (int u = 0; u < 4; ++u) {
            const int idx = idxs[u];
#pragma unroll
            for (int s = 0; s < 4; ++s) {
                float dt = (q[s][0] * kv[u][0] + q[s][1] * kv[u][1]) + (q[s][2] * kv[u][2] + q[s][3] * kv[u][3]);
                dt += __shfl_xor(dt, 1); dt += __shfl_xor(dt, 2); dt += __shfl_xor(dt, 4); dt += __shfl_xor(dt, 8);
                int c;
                if (idx < 2048) c = (idx >= 1920 + s ? 1 : 0) + ((idx >= 1536 && (idx & 3) == s) ? 1 : 0) + ((idx & 15) == s ? 1 : 0);
                else { const int sp = idx - 2048; c = (s >= sp ? 1 : 0) + (s == sp ? 2 : 0); }
                if (idx < 0) c = 0;
                { const float mn = c > 0 ? fmaxf(m[s], dt) : m[s], sc = __builtin_amdgcn_exp2f(m[s] - mn), pe = (float)c * __builtin_amdgcn_exp2f(fminf(dt - mn, 0.f));
                    l[s] = l[s] * sc + pe; O[s] = O[s] * sc + vv[u] * pe; m[s] = mn; }
            }
        }
    }
#pragma unroll
    for (int s = 0; s < 4; ++s)
#pragma unroll
        for (int off = 16; off <= 32; off <<= 1) {
            const float mo = __shfl_xor(m[s], off), lo = __shfl_xor(l[s], off);
            f32x4 Oo; Oo[0] = __shfl_xor(O[s][0], off); Oo[1] = __shfl_xor(O[s][1], off); Oo[2] = __shfl_xor(O[s][2], off); Oo[3] = __shfl_xor(O[s][3], off);
            const float mn = fmaxf(m[s], mo); const float sa = (m[s] == mn) ? 1.f : __builtin_amdgcn_exp2f(m[s] - mn), sb = (mo == mn) ? 1.f : __builtin_amdgcn_exp2f(mo - mn);
            l[s] = l[s] * sa + lo * sb; O[s] = O[s] * sa + Oo * sb; m[s] = mn;
        }
    LAS float* red = (LAS float*)lds;
    if (grp == 0) {
#pragma unroll
        for (int s = 0; s < 4; ++s) { LAS float* rp = red + (wid * 4 + s) * 68; *(LAS f32x4*)(rp + 4 * sub) = O[s]; if (sub == 0) { rp[64] = m[s]; rp[65] = l[s]; } }
    }
    __syncthreads();
    if (tid < 256) { const int s = tid >> 6, dim = tid & 63; float mm = -1e30f;
#pragma unroll
        for (int w = 0; w < 8; ++w) mm = fmaxf(mm, red[(w * 4 + s) * 68 + 64]);
        float L = 0.f, Ov = 0.f;
#pragma unroll
        for (int w = 0; w < 8; ++w) { const LAS float* rp = red + (w * 4 + s) * 68; const float mw = rp[64]; const float f = __builtin_amdgcn_exp2f(mw - mm); L += rp[65] * f; Ov += rp[dim] * f; }
        MIX[(size_t)(MP + 4 * n + s) * DM + 512 + h * 64 + dim] = (bf16)f2bf(Ov / L); }
    __syncthreads();
}

__device__ __forceinline__ void combine_item(const Args& a, int item, int tid) {
    unsigned char* ws = a.ws;
    const bf16* OP = (const bf16*)(ws + WS_OP); const float* LSE = (const float*)(ws + WS_LSE); bf16* MIX = (bf16*)(ws + WS_MIX);
#pragma unroll 2
    for (int i = 0; i < 8; ++i) {
        const int e = tid + NTHR * i, row = item * 64 + (e >> 6), hc = e & 63, h = hc >> 3;
        const float l0 = LSE[((size_t)0 * MP + row) * 8 + h], l1 = LSE[((size_t)1 * MP + row) * 8 + h], l2 = LSE[((size_t)2 * MP + row) * 8 + h];
        const float mx = fmaxf(l0, fmaxf(l1, l2)); float w0 = __builtin_amdgcn_exp2f(l0 - mx), w1 = __builtin_amdgcn_exp2f(l1 - mx), w2 = __builtin_amdgcn_exp2f(l2 - mx);
        const float inv = __builtin_amdgcn_rcpf(w0 + w1 + w2); w0 *= inv; w1 *= inv; w2 *= inv;
        float x0[8], x1[8], x2[8], y[8];
        load8_bf16(OP + ((size_t)0 * MP + row) * 512 + hc * 8, x0); load8_bf16(OP + ((size_t)1 * MP + row) * 512 + hc * 8, x1); load8_bf16(OP + ((size_t)2 * MP + row) * 512 + hc * 8, x2);
#pragma unroll
        for (int k = 0; k < 8; ++k) y[k] = w0 * x0[k] + w1 * x1[k] + w2 * x2[k];
        *(v4u*)(MIX + (size_t)row * DM + 512 + hc * 8) = pack8(y);
    }
}
__device__ __forceinline__ void ffn_conv_phase(const Args& a, int gt, int NGT) {
    unsigned char* ws = a.ws;
    const bf16* UFU = (const bf16*)(ws + WS_UFU); bf16* Hb = (bf16*)(ws + WS_H);
    const float* cw = a.in[I_CFW]; const float* cb = a.in[I_CFB];
    for (int e = gt; e < M * (DFF / 8); e += NGT) {
        const int row = e / (DFF / 8), c = (e % (DFF / 8)) * 8;
        const bool samp = row >= MP; const int t = samp ? (row & 3) : (row & 4095); const int n = samp ? (row - MP) >> 2 : (row >> 12);
        float u0[8], u1[8], u2[8], up[8], w0[8], w1[8], w2[8], bb[8], y[8];
        load8_bf16(UFU + (size_t)row * (2 * DFF) + c, u2);
        load8_bf16(UFU + (size_t)row * (2 * DFF) + DFF + c, up);
        if (t >= 1) load8_bf16(UFU + (size_t)(row - 1) * (2 * DFF) + c, u1);
        else if (samp) load8_f32(a.in[I_SCF] + (size_t)(n * 2 + 1) * DFF + c, u1);
        else {
#pragma unroll
            for (int i = 0; i < 8; ++i) u1[i] = 0.f; }
        if (t >= 2) load8_bf16(UFU + (size_t)(row - 2) * (2 * DFF) + c, u0);
        else if (samp) load8_f32(a.in[I_SCF] + (size_t)(n * 2 + t) * DFF + c, u0);
        else {
#pragma unroll
            for (int i = 0; i < 8; ++i) u0[i] = 0.f; }
        load8_f32(cw + c, w0); load8_f32(cw + DFF + c, w1); load8_f32(cw + 2 * DFF + c, w2); load8_f32(cb + c, bb);
#pragma unroll
        for (int i = 0; i < 8; ++i) { const float uc = bb[i] + w0[i] * u0[i] + w1[i] * u1[i] + w2[i] * u2[i]; y[i] = gelu_tanh(uc) * up[i]; }
        *(v4u*)(Hb + (size_t)row * DFF + c) = pack8(y);
        float* so = nullptr;
        if (!samp) { if (t >= SEQ - 2) so = a.out + O_PCF + (size_t)(n * 2 + (t - (SEQ - 2))) * DFF + c; } else if (t >= 2) so = a.out + O_SCF + (size_t)(n * 2 + (t - 2)) * DFF + c;
        if (so) { *(f32x4*)so = (f32x4){u2[0], u2[1], u2[2], u2[3]}; *(f32x4*)(so + 4) = (f32x4){u2[4], u2[5], u2[6], u2[7]}; }
    }
}
__device__ __forceinline__ void final_norm_phase(const Args& a, int gw, int NGW, int lane) {
    float* Y = a.out + O_Y; const float* SSP2 = (const float*)(a.ws + WS_SSP2); const GAS f32x4* gf = (const GAS f32x4*)a.in[I_GFIN] + lane;
    f32x4 g[4];
#pragma unroll
    for (int j = 0; j < 4; ++j) g[j] = gf[64 * j];
    for (int m = gw; m < M; m += NGW) { const float rs = row_rs(SSP2, m); GAS f32x4* yr = (GAS f32x4*)(Y + (size_t)m * DM) + lane;
#pragma unroll
        for (int j = 0; j < 4; ++j) yr[64 * j] = yr[64 * j] * rs * g[j]; }
}

__global__ void __launch_bounds__(NTHR, 2) hymba_fwd(Args args) {
    extern __shared__ __attribute__((aligned(16))) unsigned char lds_raw[];
    LAS unsigned char* lds = (LAS unsigned char*)lds_raw;
    volatile LAS unsigned* MISC = (volatile LAS unsigned*)(lds + MISC_OFF);
    const int tid = threadIdx.x, lane = tid & 63, wave = __builtin_amdgcn_readfirstlane(tid >> 6);
    const int G = gridDim.x, bx = blockIdx.x; const int vcu = (G % 8 == 0) ? (bx % 8) * (G / 8) + bx / 8 : bx;
    unsigned char* ws = args.ws;
    unsigned* ctl = (unsigned*)(ws + WS_CTL);
    for (int u = tid; u < (LDS_BYTES - LDSCTL_OFF) / 4; u += NTHR) ((LAS unsigned*)(lds + LDSCTL_OFF))[u] = 0u;
    __syncthreads();
    XcdBarrier bar; bar.bar = ctl + CW_BAR; bar.x = 0; bar.st = nullptr;
    if (N_LAUNCH == 1) bar = xcd_barrier_post(ctl + CW_BAR, MISC + 8);
    const int lo = args.ph_lo, hi = args.ph_hi;
#ifndef IT_MASK
#define IT_MASK 63
#endif
#ifndef PH_MASK
#define PH_MASK 0x1ff
#endif
#define IN(k) (((PH_MASK >> (k)) & 1) && lo <= (k) && (k) < hi)
#define SEAM(k) do { if (N_LAUNCH == 1 && IN(k) && IN((k) + 1)) xcd_barrier(bar); } while (0)

    if (IN(0)) { p0_prologue(args, lds, tid, wave, lane, vcu, G); SEAM(0); }

    if (IN(1)) {
        pg8::Gemm g{(const bf16*)(ws + WS_XN), (const bf16*)(ws + WS_WIN), M, DIN, DM}; pg8::StaticOrder S; S.init(M, DIN, G, bx);
        EpiZ E{(const float*)(ws + WS_RS1), (const float*)(ws + WS_ROPE), (bf16*)(ws + WS_XA), (bf16*)(ws + WS_GA), (bf16*)(ws + WS_Q), (bf16*)(ws + WS_K), (bf16*)(ws + WS_V), (float*)(ws + WS_QS), args.out};
        pg8::gemm_phase<EpiZ, pg8::StaticOrder, true, true>(lds, g, S, E);
        SEAM(1);
    }
    if (IN(2)) {
        constexpr int NA = NB * NH * 48, NSA = NS * NH, NL = NB * 64;
        for (int it = bx; it < NA + NSA + NL; it += G) {
            if (it < NA) { if (IT_MASK & 1) attn_prompt_unit(args, it, lds, tid, wave, lane); }
            else if (it < NA + NSA) { if (IT_MASK & 2) attn_sample_item(args, it - NA, lds, tid, wave, lane); }
            else { if (IT_MASK & 4) lru_item<0>(args, it - NA - NSA, lds, wave, lane); }
        }
        SEAM(2);
    }
    if (IN(3)) {
        constexpr int NL = NB * 64, NLS = MS / 64, NC = MP / 64;
        for (int it = bx; it < NL + NLS + NC; it += G) {
            if (it < NL) { if (IT_MASK & 8) lru_item<1>(args, it, lds, wave, lane); }
            else if (it < NL + NLS) { if (IT_MASK & 16) lru_item<2>(args, it - NL, lds, wave, lane); }
            else { if (IT_MASK & 32) combine_item(args, it - NL - NLS, tid); }
        }
        SEAM(3);
    }
    if (IN(4)) {
        pg8::Gemm g{(const bf16*)(ws + WS_MIX), (const bf16*)(ws + WS_WOUT), M, DM, DM}; pg8::StaticOrder S; S.init(M, DM, G, bx);
        EpiX1 E{args.in[I_XP], args.in[I_XS], args.out + O_Y, (bf16*)(ws + WS_X1B), (float*)(ws + WS_SSP)};
        pg8::gemm_phase<EpiX1, pg8::StaticOrder, true, true>(lds, g, S, E);
        SEAM(4);
    }
    if (IN(5)) {
        pg8::Gemm g{(const bf16*)(ws + WS_X1B), (const bf16*)(ws + WS_WGU), M, 2 * DFF, DM}; pg8::StaticOrder S; S.init(M, 2 * DFF, G, bx);
        EpiGU E{(const float*)(ws + WS_SSP), (bf16*)(ws + WS_UFU)};
        pg8::gemm_phase<EpiGU, pg8::StaticOrder, true, true>(lds, g, S, E);
        SEAM(5);
    }
    if (IN(6)) { ffn_conv_phase(args, vcu * NTHR + tid, G * NTHR); SEAM(6); }
    if (IN(7)) {
        pg8::Gemm g{(const bf16*)(ws + WS_H), (const bf16*)(ws + WS_WDN), M, DM, DFF}; pg8::StaticOrder S; S.init(M, DM, G, bx);
        EpiX2 E{args.out + O_Y, (float*)(ws + WS_SSP2)};
        pg8::gemm_phase<EpiX2, pg8::StaticOrder, true, true>(lds, g, S, E);
        SEAM(7);
    }
    if (IN(8)) final_norm_phase(args, vcu * NWAVES + wave, G * NWAVES, lane);
#undef IN
#undef SEAM
}

extern "C" void kernel_launch(void* const* d_in, const int* in_sizes, int n_in, void* d_out, int out_size, void* d_ws, size_t ws_size, hipStream_t stream) {
    static int grid = 0;
    if (grid == 0) {
        if (n_in != 24 || out_size != (int)O_END || ws_size < WS_END) { fprintf(stderr, "kernel_launch: unexpected shapes (n_in %d, out %d, ws %zu)\n", n_in, out_size, ws_size); grid = -1; return; }
        int dev = 0, cus = 0, per_cu = 0;
        if (hipGetDevice(&dev) != hipSuccess || hipDeviceGetAttribute(&cus, hipDeviceAttributeMultiprocessorCount, dev) != hipSuccess) { grid = -1; return; }
        if (hipFuncSetAttribute((const void*)hymba_fwd, hipFuncAttributeMaxDynamicSharedMemorySize, LDS_BYTES) != hipSuccess) { fprintf(stderr, "kernel_launch: hipFuncSetAttribute failed\n"); grid = -1; return; }
        if (hipOccupancyMaxActiveBlocksPerMultiprocessor(&per_cu, (const void*)hymba_fwd, NTHR, LDS_BYTES) != hipSuccess || per_cu < 1) fprintf(stderr, "kernel_launch: occupancy query reports %d blocks per CU\n", per_cu);
        (void)hipGetLastError();
        grid = cus;
    }
    if (grid < 0) return;
    if (hipMemsetAsync((char*)d_ws + WS_CTL, 0, CTL_ZERO_BYTES, stream) != hipSuccess) return;
    Args a{};
    for (int i = 0; i < 24; ++i) a.in[i] = (const float*)d_in[i];
    a.out = (float*)d_out; a.ws = (unsigned char*)d_ws;
    if (N_LAUNCH == 1) { a.ph_lo = 0; a.ph_hi = NPH; hipLaunchKernelGGL(hymba_fwd, dim3(grid), dim3(NTHR), LDS_BYTES, stream, a); }
    else for (int k = 0; k < NPH; ++k) { a.ph_lo = k; a.ph_hi = k + 1; hipLaunchKernelGGL(hymba_fwd, dim3(grid), dim3(NTHR), LDS_BYTES, stream, a); }
}
```

```cpp
#include <hip/hip_runtime.h>
#include <cstdio>
#include <cstdint>
#include <cmath>
namespace pg8 {
#define PG8_LAS __attribute__((address_space(3)))
typedef unsigned short bf16_t;
typedef short bf16x8 __attribute__((ext_vector_type(8)));
typedef float f32x4 __attribute__((ext_vector_type(4)));
typedef unsigned u32x4 __attribute__((ext_vector_type(4)));
constexpr int BM = 256, BK = 64, HALF = 128, HTB = HALF * BK * 2  , STAGE_BYTES = 8 * HTB, NXCD = 8, WGM = 8;

__host__ __device__ __forceinline__ int lds_byte(int r, int c) { const int st = (r >> 4) * 2 + (c >> 5), rr = r & 15, cc = c & 31, ob = rr * 64 + cc * 2; return st * 1024 + (ob ^ (((ob >> 9) & 1) << 5)); }
__host__ __device__ __forceinline__ void stage_rc(int b, int& R, int& C) { const int st = b / 1024, sb = b % 1024, swz = sb ^ (((sb >> 9) & 1) << 5); R = (st >> 1) * 16 + swz / 64; C = (st & 1) * 32 + (swz % 64) / 2; }
__host__ __device__ __forceinline__ int perm32(int rho) { const int n = rho >> 4, i = rho & 15; return 8 * (i >> 2) + 4 * n + (i & 3); }

struct Unit { int pm, pn, ko; };
struct Gemm { const bf16_t* A; const bf16_t* Bt; int M, N, K, ld; };

struct StaticOrder {
    int nM, nN, nwg, G, c;
    __host__ __device__ void init(int M, int N, int G_, int c_) { nM = M / BM; nN = N / BM; nwg = nM * nN; G = G_; c = c_; }
    __host__ __device__ bool next(int i, Unit& u) const {
        const long L = (long)i * G + c; if (L >= nwg) return false;
        int wgid = (int)L; { const int q = nwg / NXCD, r = nwg % NXCD, xcd = wgid % NXCD, off = wgid / NXCD; wgid = (xcd < r ? xcd * (q + 1) : r * (q + 1) + (xcd - r) * q) + off; }
        const int nig = WGM * nN, gid = wgid / nig, fm = gid * WGM, gsz = (nM - fm) < WGM ? (nM - fm) : WGM;
        u.pm = fm + ((wgid % nig) % gsz); u.pn = (wgid % nig) / gsz; u.ko = 0; return true;
    }
    __device__ __forceinline__ void a_ready(const Unit&) const {}
    __device__ __forceinline__ void done(const Unit&) const {}
};

__device__ __forceinline__ unsigned cvt_pk_bf16(float lo, float hi) { unsigned r; asm volatile("v_cvt_pk_bf16_f32 %0, %1, %2" : "=v"(r) : "v"(lo), "v"(hi)); return r; }
template <class Epi, class Sched, bool ALIGN_EPI = false, bool SP2 = false>
__device__ __forceinline__ void gemm_phase(PG8_LAS unsigned char* lds, const Gemm g, const Sched& S, const Epi& E) {
    const int tid = threadIdx.x, wid = __builtin_amdgcn_readfirstlane(tid >> 6), lane = tid & 63, wr = wid >> 2, wc = wid & 3, fr = lane & 15, fq = lane >> 4;
    const int K = g.K, nt = K / BK;
    unsigned voffA[2], voffB[2];
#pragma unroll
    for (int i = 0; i < 2; ++i) { int R, C; stage_rc(tid * 16 + i * 8192, R, C); const int Rb = Epi::PERM ? ((R & ~31) + perm32(R & 31)) : R;
        voffA[i] = (unsigned)(R * g.ld + C) * 2u; voffB[i] = (unsigned)(Rb * g.ld + C) * 2u; }
    const size_t kstep = (size_t)(BK * 2);
    const size_t hstep = (size_t)HALF * g.ld * 2;
    const size_t tstep = 2 * hstep;
    const unsigned ldsw = (unsigned)wid * 1024u;
    const int aoff = lds_byte(wr * 64 + fr, fq * 8), boff = lds_byte(wc * 32 + fr, fq * 8);
#define PG8_SA(b, h) (((b) * 2 + (h)) * HTB)
#define PG8_SB(b, h) ((4 + (b) * 2 + (h)) * HTB)
#define PG8_STAGE(bufoff, gbase, voff) do { _Pragma("unroll") for (int _i = 0; _i < 2; ++_i) \
        __builtin_amdgcn_global_load_lds((const unsigned*)((const char*)(gbase) + (voff)[_i]), (PG8_LAS unsigned*)(lds + (bufoff) + ldsw + _i * 8192), 16, 0, 0); } while (0)
#define PG8_LDA(dst, b, h) do { _Pragma("unroll") for (int m = 0; m < 4; ++m) _Pragma("unroll") for (int k = 0; k < 2; ++k) dst[m][k] = *(const PG8_LAS bf16x8*)(lds + PG8_SA(b, h) + aoff + m * 2048 + k * 1024); } while (0)
#define PG8_LDB(dst, b, h) do { _Pragma("unroll") for (int n = 0; n < 2; ++n) _Pragma("unroll") for (int k = 0; k < 2; ++k) dst[n][k] = *(const PG8_LAS bf16x8*)(lds + PG8_SB(b, h) + boff + n * 2048 + k * 1024); } while (0)
#define PG8_MMA(ai, bj, At, Bt) do { __builtin_amdgcn_s_setprio(1); _Pragma("unroll") for (int m = 0; m < 4; ++m) _Pragma("unroll") for (int n = 0; n < 2; ++n) _Pragma("unroll") for (int k = 0; k < 2; ++k) \
        acc[ai][bj][m][n] = __builtin_amdgcn_mfma_f32_16x16x32_bf16(Bt[n][k], At[m][k], acc[ai][bj][m][n], 0, 0, 0); __builtin_amdgcn_s_setprio(0); } while (0)
#define PG8_WAIT_V(n) asm volatile("s_waitcnt vmcnt(" #n ")" ::: "memory")
#define PG8_WAIT_L(n) asm volatile("s_waitcnt lgkmcnt(" #n ")" ::: "memory")
#define PG8_BAR __builtin_amdgcn_s_barrier()
#define PG8_SCHED __builtin_amdgcn_sched_barrier(0)
    Unit cur, nxt; int ui = 0;
    if (!S.next(0, cur)) return;
    f32x4 acc[2][2][4][2];
#pragma unroll
    for (int a = 0; a < 2; ++a)
#pragma unroll
        for (int b = 0; b < 2; ++b)
#pragma unroll
            for (int m = 0; m < 4; ++m)
#pragma unroll
                for (int n = 0; n < 2; ++n) acc[a][b][m][n] = (f32x4){0.f, 0.f, 0.f, 0.f};
    bf16x8 At[4][2], B0[2][2], B1[2][2];
    const char* cA = (const char*)g.A + (size_t)cur.pm * tstep + (size_t)cur.ko * 2; const char* cB = (const char*)g.Bt + (size_t)cur.pn * tstep + (size_t)cur.ko * 2;
    S.a_ready(cur); E.pre(cur, 0, tid);
    if constexpr (SP2) {
        PG8_STAGE(PG8_SB(0, 0), cB, voffB); PG8_STAGE(PG8_SB(0, 1), cB + hstep, voffB); PG8_STAGE(PG8_SA(0, 0), cA, voffA); PG8_STAGE(PG8_SA(0, 1), cA + hstep, voffA);
        if (wr == 1) PG8_BAR;
        PG8_WAIT_V(2); PG8_BAR;
        PG8_STAGE(PG8_SB(1, 0), cB + kstep, voffB); PG8_STAGE(PG8_SA(1, 0), cA + kstep, voffA); PG8_STAGE(PG8_SB(1, 1), cB + hstep + kstep, voffB);
        PG8_WAIT_V(6); PG8_BAR;
    } else {
        PG8_STAGE(PG8_SB(0, 0), cB, voffB); PG8_STAGE(PG8_SA(0, 0), cA, voffA); PG8_STAGE(PG8_SB(0, 1), cB + hstep, voffB); PG8_STAGE(PG8_SA(0, 1), cA + hstep, voffA);
        if (wr == 1) PG8_BAR;
        PG8_WAIT_V(4); PG8_BAR;
        PG8_STAGE(PG8_SB(1, 0), cB + kstep, voffB); PG8_STAGE(PG8_SA(1, 0), cA + kstep, voffA); PG8_STAGE(PG8_SB(1, 1), cB + hstep + kstep, voffB);
        PG8_WAIT_V(6); PG8_BAR;
    }
    for (;;) {
        const bool has_next = S.next(ui + 1, nxt);
        const char* nA = has_next ? (const char*)g.A + (size_t)nxt.pm * tstep + (size_t)nxt.ko * 2 : cA; const char* nB = has_next ? (const char*)g.Bt + (size_t)nxt.pn * tstep + (size_t)nxt.ko * 2 : cB;
        for (int t = 0; t < nt; t += 2) {
            const bool last = (t == nt - 2);
            const char* a1 = cA + (size_t)(t + 1) * kstep;
            const char* a2 = last ? nA : cA + (size_t)(t + 2) * kstep; const char* b2 = last ? nB : cB + (size_t)(t + 2) * kstep;
            const char* a3 = a2 + kstep; const char* b3 = b2 + kstep;
            if (last && has_next) { S.a_ready(nxt); E.pre(nxt, (ui + 1) & 1, tid); }
            if constexpr (SP2) {
            PG8_LDB(B0, 0, 0); PG8_LDB(B1, 0, 1); PG8_SCHED; PG8_LDA(At, 0, 0); PG8_STAGE(PG8_SA(1, 1), a1 + hstep, voffA);
            PG8_WAIT_V(8); PG8_WAIT_L(0); PG8_BAR; PG8_MMA(0, 0, At, B0); PG8_MMA(0, 1, At, B1); PG8_BAR; PG8_SCHED;
            PG8_LDA(At, 0, 1); PG8_STAGE(PG8_SB(0, 0), b2, voffB); PG8_STAGE(PG8_SB(0, 1), b2 + hstep, voffB); PG8_STAGE(PG8_SA(0, 0), a2, voffA);
            PG8_WAIT_V(8); PG8_WAIT_L(0); PG8_BAR; PG8_MMA(1, 0, At, B0); PG8_MMA(1, 1, At, B1); PG8_BAR; PG8_SCHED;
            PG8_LDB(B0, 1, 0); PG8_LDB(B1, 1, 1); PG8_SCHED; PG8_LDA(At, 1, 0); PG8_STAGE(PG8_SA(0, 1), a2 + hstep, voffA);
            PG8_WAIT_V(8); PG8_WAIT_L(0); PG8_BAR; PG8_MMA(0, 0, At, B0); PG8_MMA(0, 1, At, B1); PG8_BAR; PG8_SCHED;
            PG8_LDA(At, 1, 1); PG8_STAGE(PG8_SB(1, 0), b3, voffB); PG8_STAGE(PG8_SB(1, 1), b3 + hstep, voffB); PG8_STAGE(PG8_SA(1, 0), a3, voffA);
            PG8_WAIT_V(8); PG8_WAIT_L(0); PG8_BAR; PG8_MMA(1, 0, At, B0); PG8_MMA(1, 1, At, B1); PG8_BAR; PG8_SCHED;
            } else {
            PG8_LDB(B0, 0, 0); PG8_SCHED; PG8_LDA(At, 0, 0); PG8_STAGE(PG8_SA(1, 1), a1 + hstep, voffA);
            PG8_WAIT_L(8); PG8_BAR; PG8_WAIT_L(0); PG8_MMA(0, 0, At, B0); PG8_BAR; PG8_SCHED;
            PG8_LDB(B1, 0, 1); PG8_STAGE(PG8_SB(0, 0), b2, voffB);
            PG8_BAR; PG8_WAIT_L(0); PG8_MMA(0, 1, At, B1); PG8_BAR;
            PG8_LDA(At, 0, 1); PG8_STAGE(PG8_SA(0, 0), a2, voffA);
            PG8_BAR; PG8_WAIT_L(0); PG8_MMA(1, 0, At, B0); PG8_BAR; PG8_SCHED;
            PG8_STAGE(PG8_SB(0, 1), b2 + hstep, voffB);
            PG8_WAIT_V(6); PG8_BAR; PG8_MMA(1, 1, At, B1); PG8_BAR;
            PG8_LDB(B0, 1, 0); PG8_SCHED; PG8_LDA(At, 1, 0); PG8_STAGE(PG8_SA(0, 1), a2 + hstep, voffA);
            PG8_WAIT_L(8); PG8_BAR; PG8_WAIT_L(0); PG8_MMA(0, 0, At, B0); PG8_BAR; PG8_SCHED;
            PG8_LDB(B1, 1, 1); PG8_STAGE(PG8_SB(1, 0), b3, voffB);
            PG8_BAR; PG8_WAIT_L(0); PG8_MMA(0, 1, At, B1); PG8_BAR;
            PG8_LDA(At, 1, 1); PG8_STAGE(PG8_SA(1, 0), a3, voffA);
            PG8_BAR; PG8_WAIT_L(0); PG8_MMA(1, 0, At, B0); PG8_BAR; PG8_SCHED;
            PG8_STAGE(PG8_SB(1, 1), b3 + hstep, voffB);
            PG8_WAIT_V(6); PG8_BAR; PG8_MMA(1, 1, At, B1); PG8_BAR;
            }
        }
        if constexpr (ALIGN_EPI) { if (wr == 0) PG8_BAR; }
        if constexpr (!Epi::AFTER_DRAIN) { E(acc, cur, wr, wc, fr, fq, ui & 1); S.done(cur); }
        if (!has_next) break;
#pragma unroll
        for (int a = 0; a < 2; ++a)
#pragma unroll
            for (int b = 0; b < 2; ++b)
#pragma unroll
                for (int m = 0; m < 4; ++m)
#pragma unroll
                    for (int n = 0; n < 2; ++n) acc[a][b][m][n] = (f32x4){0.f, 0.f, 0.f, 0.f};
        cur = nxt; cA = nA; cB = nB; ++ui;
        if constexpr (ALIGN_EPI) { if (wr == 1) PG8_BAR; }
    }
    PG8_WAIT_V(0);
    if constexpr (!ALIGN_EPI) { if (wr == 0) PG8_BAR; }
    PG8_BAR;
    if constexpr (Epi::AFTER_DRAIN) { E.fused(acc, cur, wr, wc, fr, fq, lds, wid, lane); S.done(cur); }
#undef PG8_SA
#undef PG8_SB
#undef PG8_STAGE
#undef PG8_LDA
#undef PG8_LDB
#undef PG8_MMA
#undef PG8_WAIT_V
#undef PG8_WAIT_L
#undef PG8_BAR
#undef PG8_SCHED
}
}
#define GAS __attribute__((address_space(1)))
#define LAS __attribute__((address_space(3)))
typedef unsigned short bf16;
typedef unsigned v4u __attribute__((ext_vector_type(4)));
typedef float f32x4 __attribute__((ext_vector_type(4)));
typedef float f32x2 __attribute__((ext_vector_type(2)));
typedef short bf16x8 __attribute__((ext_vector_type(8)));
typedef GAS unsigned gu32;
typedef GAS unsigned long long gu64;
#define RLX_AGENT __ATOMIC_RELAXED, __HIP_MEMORY_SCOPE_AGENT
#define LDS_WAIT() asm volatile("s_waitcnt lgkmcnt(0)" ::: "memory")
#define VM_WAIT() asm volatile("s_waitcnt vmcnt(0)" ::: "memory")
__device__ __forceinline__ unsigned long long rt() { return __builtin_amdgcn_s_memrealtime(); }
__device__ __forceinline__ unsigned f2bf(float f) { unsigned u = __builtin_bit_cast(unsigned, f); return (u + 0x7fffu + ((u >> 16) & 1u)) >> 16; }
__device__ __forceinline__ unsigned pk2(float lo, float hi) { unsigned r; asm("v_cvt_pk_bf16_f32 %0, %1, %2" : "=v"(r) : "v"(lo), "v"(hi)); return r; }

#define XB_TMO      128
#define XB_XCNT(j)  (256  + 64 * (j))
#define XB_XSUB(j)  (1280 + 64 * (j))
#define XB_XGEN(j)  (2304 + 64 * (j))
#define XB_TOP      3328
#define XB_TOPGEN   3392
#define XCD_BAR_WORDS 3456
#define XB_SPIN_CAP (1u << 18)

__device__ __forceinline__ unsigned xb_ld(unsigned* p)              { return __hip_atomic_load(p, __ATOMIC_RELAXED, __HIP_MEMORY_SCOPE_AGENT); }
__device__ __forceinline__ unsigned xb_add(unsigned* p, unsigned v) { return __hip_atomic_fetch_add(p, v, __ATOMIC_RELAXED, __HIP_MEMORY_SCOPE_AGENT); }
__device__ __forceinline__ unsigned xb_xcc_id() { return (unsigned)__builtin_amdgcn_s_getreg((3 << 11) | 20) & 0xFu; }
#define XB_SPIN(cond, bar) do { unsigned _sp = 0; while (cond) { __builtin_amdgcn_s_sleep(1); \
    if ((++_sp & 255u) == 0u) { if (xb_ld(&(bar)[XB_TMO])) break; if (_sp > XB_SPIN_CAP) { atomicAdd(&(bar)[XB_TMO], 1u); break; } } } } while (0)

struct XcdBarrier {
    unsigned* bar; unsigned x;
    volatile LAS unsigned* st;
};

__device__ __forceinline__ XcdBarrier xcd_barrier_post(unsigned* bar, volatile LAS unsigned* st) {
    XcdBarrier b; b.bar = bar; b.x = xb_xcc_id(); b.st = st;
    if (threadIdx.x == 0) (void)xb_add(&bar[XB_XCNT(b.x)], 1u);
    return b;
}
__device__ __forceinline__ void xcd_barrier_complete(unsigned* bar, unsigned x, unsigned& nloc, unsigned& nx) {
    const unsigned G = gridDim.x * gridDim.y * gridDim.z;
    unsigned sum, cnt, mine, sp = 0u;
    for (;;) {
        sum = 0u; cnt = 0u; mine = 0u;
#pragma unroll
        for (unsigned j = 0; j < 16; ++j) { const unsigned c = xb_ld(&bar[XB_XCNT(j)]); sum += c; cnt += (c > 0u) ? 1u : 0u; mine = (j == x) ? c : mine; }
        if (sum == G) break;
        __builtin_amdgcn_s_sleep(1);
        if ((++sp & 255u) == 0u) { if (xb_ld(&bar[XB_TMO])) break; if (sp > XB_SPIN_CAP) { atomicAdd(&bar[XB_TMO], 1u); break; } }
    }
    nloc = mine > 0u ? mine : 1u; nx = cnt > 0u ? cnt : 1u;
}

__device__ __forceinline__ void xcd_barrier(const XcdBarrier& b) {
    asm volatile("s_waitcnt vmcnt(0)" ::: "memory");
    __syncthreads();
    if (threadIdx.x == 0) {
        unsigned* bar = b.bar;
        __builtin_amdgcn_s_waitcnt(0);
        unsigned nloc = b.st[0], nx = b.st[1];
        if (nloc == 0u) { xcd_barrier_complete(bar, b.x, nloc, nx); b.st[0] = nloc; b.st[1] = nx; }
        const unsigned old = xb_add(&bar[XB_XSUB(b.x)], 1u);
        const unsigned gen = old / nloc;
        if (old + 1u == (gen + 1u) * nloc) {
            __builtin_amdgcn_fence(__ATOMIC_RELEASE, "agent");
            asm volatile("s_waitcnt vmcnt(0)" ::: "memory");
            const unsigned og = xb_add(&bar[XB_TOP], 1u);
            const unsigned tg = og / nx;
            if (og + 1u == (tg + 1u) * nx) xb_add(&bar[XB_TOPGEN], 1u);
            else XB_SPIN(xb_ld(&bar[XB_TOPGEN]) == tg, bar);
            __builtin_amdgcn_fence(__ATOMIC_ACQUIRE, "agent");
            xb_add(&bar[XB_XGEN(b.x)], 1u);
            asm volatile("s_waitcnt vmcnt(0)" ::: "memory");
        } else {
            XB_SPIN(xb_ld(&bar[XB_XGEN(b.x)]) == gen, bar);
            __builtin_amdgcn_fence(__ATOMIC_ACQUIRE, "agent");
            asm volatile("s_waitcnt vmcnt(0)" ::: "memory");
        }
    }
    __syncthreads();
}
constexpr int DM = 1024, NB = 8, SEQ = 4096, NS = 128, SSQ = 4;
constexpr int DL = 512, NH = 8, HD = 64, DIN = 2560, DFF = 3072;
constexpr int MP = NB * SEQ, MS = NS * SSQ, M = MP + MS;
constexpr float EPS = 1e-6f;
constexpr float C2 = 0.125f * 1.4426950408889634f;
constexpr int NWAVES = 8, NTHR = 512;
#ifndef N_LAUNCH
#define N_LAUNCH 1
#endif
constexpr int NPH = 9;

constexpr size_t O_Y = 0;
constexpr size_t O_PCA = (size_t)M * DM;
constexpr size_t O_PLH = O_PCA + (size_t)NB * 3 * DL;
constexpr size_t O_PWK = O_PLH + (size_t)NB * DL;
constexpr size_t O_PWV = O_PWK + (size_t)NB * 2048 * 512;
constexpr size_t O_PCF = O_PWV + (size_t)NB * 2048 * 512;
constexpr size_t O_SCA = O_PCF + (size_t)NB * 2 * DFF;
constexpr size_t O_SLH = O_SCA + (size_t)NS * 3 * DL;
constexpr size_t O_SWK = O_SLH + (size_t)NS * DL;
constexpr size_t O_SWV = O_SWK + (size_t)NS * 4 * 512;
constexpr size_t O_SCF = O_SWV + (size_t)NS * 4 * 512;
constexpr size_t O_END = O_SCF + (size_t)NS * 2 * DFF;
static_assert(O_END == 52494336, "output size");

constexpr size_t MiB = 1u << 20;
constexpr size_t WS_CTL = 0, CTL_ZERO_BYTES = 1 * MiB;
constexpr size_t WS_WIN = 2 * MiB, WS_WOUT = 7 * MiB, WS_WGU = 9 * MiB, WS_WDN = 21 * MiB, WS_WL = 27 * MiB;
constexpr size_t WS_C8 = 28 * MiB, WS_ROPE = 28 * MiB + 65536, WS_RS1 = 29 * MiB, WS_SSP = 30 * MiB, WS_SSP2 = 33 * MiB;
constexpr size_t WS_AGGA = 36 * MiB, WS_AGGB = 37 * MiB, WS_QS = 38 * MiB, WS_LSE = 40 * MiB;
constexpr size_t WS_XN = 48 * MiB, WS_XA = 116 * MiB, WS_GA = 150 * MiB, WS_Q = 184 * MiB, WS_K = 218 * MiB, WS_V = 252 * MiB;
constexpr size_t WS_OP = 288 * MiB, WS_MIX = 384 * MiB + 135424, WS_X1B = 450 * MiB, WS_UFU = 516 * MiB, WS_H = 908 * MiB, WS_END = 1104 * MiB;
constexpr size_t WS_HEADU = 516 * MiB, WS_HEADP = 520 * MiB, WS_TAIL = 524 * MiB;
constexpr size_t WS_PART4 = 540 * MiB;
constexpr size_t WS_XBUF = 548 * MiB;
constexpr size_t WS_PART = 528 * MiB;
constexpr int CW_BAR = 4096;

constexpr int RING_BYTES = 131072, LDSCTL_OFF = 155648, MISC_OFF = LDSCTL_OFF + 320, LDS_BYTES = 163840;

typedef float f32x16 __attribute__((ext_vector_type(16)));
typedef short s16x4 __attribute__((ext_vector_type(4)));
typedef unsigned u32x2 __attribute__((ext_vector_type(2)));

__device__ __forceinline__ float bflo(unsigned w) { return __uint_as_float(w << 16); }
__device__ __forceinline__ float bfhi(unsigned w) { return __uint_as_float(w & 0xffff0000u); }
__device__ __forceinline__ float bf2f(bf16 h) { return __uint_as_float((unsigned)h << 16); }
__device__ __forceinline__ void unpack8(const v4u w, float (&x)[8]) { x[0] = bflo(w.x); x[1] = bfhi(w.x); x[2] = bflo(w.y); x[3] = bfhi(w.y); x[4] = bflo(w.z); x[5] = bfhi(w.z); x[6] = bflo(w.w); x[7] = bfhi(w.w); }
__device__ __forceinline__ v4u pack8(const float (&x)[8]) { v4u w; w.x = pk2(x[0], x[1]); w.y = pk2(x[2], x[3]); w.z = pk2(x[4], x[5]); w.w = pk2(x[6], x[7]); return w; }
__device__ __forceinline__ int crow(int r, int hi) { return (r & 3) + 8 * (r >> 2) + 4 * hi; }
__device__ __forceinline__ float wave_sum(float v) {
#pragma unroll
    for (int o = 1; o < 64; o <<= 1) v += __shfl_xor(v, o);
    return v;
}
__device__ __forceinline__ float sigmoidf_(float x) { return __builtin_amdgcn_rcpf(1.f + __expf(-x)); }
__device__ __forceinline__ float one_minus_exp(float x) {
    float p = 1.f / 720.f; p = p * x + 1.f / 120.f; p = p * x + 1.f / 24.f; p = p * x + 1.f / 6.f; p = p * x + 0.5f; p = p * x + 1.f;
    const float e = 1.f - __expf(x); return x > -0.35f ? -x * p : e; }
__device__ __forceinline__ float gelu_tanh(float x) { const float z = x * (-2.3022082f + -0.10294324f * (x * x));
    return x * __builtin_amdgcn_rcpf(1.f + __builtin_amdgcn_exp2f(z)); }

struct Args { const float* in[24]; float* out; unsigned char* ws; int ph_lo, ph_hi, li, pad; };
enum { I_XP = 0, I_XS, I_SCA, I_SLH, I_CK, I_CV, I_SCF, I_GMIX, I_WIN, I_CAW, I_CAB, I_WR, I_BR, I_WI, I_BI, I_LAM, I_WOUT, I_GFFN, I_WG, I_CFW, I_CFB, I_WU, I_WD, I_GFIN };

__device__ __forceinline__ const float* xrow(const Args& a, int m) { return m < MP ? a.in[I_XP] + (size_t)m * DM : a.in[I_XS] + (size_t)(m - MP) * DM; }

__device__ __forceinline__ void p0_transpose_item(const float* W, const float* gk, int K, int N, bf16* WT, int row_off, LAS float* scr, int item, int lane, int mode = 0) {
    const int nblk = N / 32, kb = item / nblk, nb = item % nblk, k0 = 64 * kb, n0 = 32 * nb;
    const int drow0 = mode == 0 ? row_off + n0 : 256 * (n0 >> 7) + (n0 & 127) + (mode == 2 ? 128 : 0);
    float wv[32], gv[32];
#pragma unroll
    for (int i = 0; i < 32; ++i) { const int kk = 2 * i + (lane >> 5); gv[i] = gk ? gk[k0 + kk] : 1.f; wv[i] = __builtin_nontemporal_load(W + (size_t)(k0 + kk) * N + n0 + (lane & 31)); }
#pragma unroll
    for (int i = 0; i < 32; ++i) { const int kk = 2 * i + (lane >> 5); scr[kk * 33 + (lane & 31)] = wv[i] * gv[i]; }
    LDS_WAIT(); asm volatile("" ::: "memory");
    const int c = lane & 7;
#pragma unroll
    for (int j = 0; j < 4; ++j) { const int n = (lane >> 3) + 8 * j; const LAS float* s = scr + (8 * c) * 33 + n;
        v4u o; o.x = pk2(s[0 * 33], s[1 * 33]); o.y = pk2(s[2 * 33], s[3 * 33]); o.z = pk2(s[4 * 33], s[5 * 33]); o.w = pk2(s[6 * 33], s[7 * 33]);
        *(GAS v4u*)(WT + (size_t)(drow0 + n) * K + k0 + 8 * c) = o; }
    LDS_WAIT(); asm volatile("" ::: "memory");
}

__device__ __forceinline__ void p0_prologue(const Args& a, LAS unsigned char* lds, int tid, int wave, int lane, int wgi, int NW, int part) {
    unsigned char* ws = a.ws;
    LAS float* scr = (LAS float*)(lds + wave * 16384);
    const int gw = wgi * NWAVES + wave, NGW = NW * NWAVES;
    constexpr int I_A = (DM / 64) * (DIN / 32), I_B = (DM / 64) * (DM / 32), I_C = (DM / 64) * (DFF / 32), I_D = (DFF / 64) * (DM / 32);
    constexpr int NITEMS = I_B + 2 * I_C + I_D;
    if (part == 0) for (int it = gw; it < I_A; it += NGW) p0_transpose_item(a.in[I_WIN], a.in[I_GMIX], DM, DIN, (bf16*)(ws + WS_WIN), 0, scr, it, lane);
    else for (int it = gw; it < NITEMS; it += NGW) {
        int r = it;
        if (r < I_B) { p0_transpose_item(a.in[I_WOUT], nullptr, DM, DM, (bf16*)(ws + WS_WOUT), 0, scr, r, lane); continue; } r -= I_B;
        if (r < I_C) { p0_transpose_item(a.in[I_WG], a.in[I_GFFN], DM, DFF, (bf16*)(ws + WS_WGU), 0, scr, r, lane, 1); continue; } r -= I_C;
        if (r < I_C) { p0_transpose_item(a.in[I_WU], a.in[I_GFFN], DM, DFF, (bf16*)(ws + WS_WGU), 0, scr, r, lane, 2); continue; } r -= I_C;
        p0_transpose_item(a.in[I_WD], nullptr, DFF, DM, (bf16*)(ws + WS_WDN), 0, scr, r, lane);
    }
    const int gt = wgi * NTHR + tid, NGT = NW * NTHR;
    if (part == 0) {
    { bf16* WL = (bf16*)(ws + WS_WL);
      for (int e = gt; e < 8 * 192 * 64; e += NGT) { const int i = e & 63, o = (e >> 6) % 192, g = e / (192 * 64); float v;
          if (o < 64) v = a.in[I_WR][(g * 64 + i) * 64 + o]; else if (o < 128) v = a.in[I_WI][(g * 64 + i) * 64 + (o - 64)]; else v = (i == o - 128) ? 1.f : 0.f;
          WL[e] = (bf16)f2bf(v); } }
    { float* c8 = (float*)(ws + WS_C8);
      for (int e = gt; e < DL; e += NGT) { const float lam = a.in[I_LAM][e]; const float sp = (lam < -20.f) ? -lam : log1pf(expf(-lam)); c8[e] = 8.f * sp; } }
    { float* rope = (float*)(ws + WS_ROPE);
      for (int e = gt; e < 4100 * 8; e += NGT) { const int pi = e >> 3, i = e & 7; const double pos = pi < 4096 ? (double)pi : (double)(8192 + (pi - 4096));
          const double inv = pow(500000.0, -(double)i / 8.0), ang = pos * inv; rope[pi * 16 + i] = (float)cos(ang); rope[pi * 16 + 8 + i] = (float)sin(ang); } }
    }
    { bf16* XN = (bf16*)(ws + WS_XN); float* RS1 = (float*)(ws + WS_RS1);
      const int M_lo = part == 0 ? MP : 0, M = part == 0 ? ::M : MP;
#pragma unroll 1
      for (int m0 = M_lo + gw; m0 < M; m0 += 8 * NGW) {
          f32x4 v[8][4];
#pragma unroll
          for (int q = 0; q < 8; ++q) { const int m = m0 + q * NGW; if (m < M) { const GAS f32x4* xr = (const GAS f32x4*)xrow(a, m) + lane;
#pragma unroll
                  for (int j = 0; j < 4; ++j) v[q][j] = __builtin_nontemporal_load((const f32x4*)(xr + 64 * j)); } }
#pragma unroll
          for (int q = 0; q < 8; ++q) { const int m = m0 + q * NGW; if (m < M) { float s = 0.f;
#pragma unroll
                  for (int j = 0; j < 4; ++j) s += (v[q][j].x * v[q][j].x + v[q][j].y * v[q][j].y) + (v[q][j].z * v[q][j].z + v[q][j].w * v[q][j].w);
                  s = wave_sum(s); if (lane == 0) RS1[m] = 1.f / sqrtf(s * (1.f / DM) + EPS);
                  GAS unsigned long long* o8 = (GAS unsigned long long*)(XN + (size_t)m * DM) + lane;
#pragma unroll
                  for (int j = 0; j < 4; ++j) o8[64 * j] = (unsigned long long)pk2(v[q][j].x, v[q][j].y) | ((unsigned long long)pk2(v[q][j].z, v[q][j].w) << 32); } }
      } }
}

__device__ __forceinline__ void load8_bf16(const bf16* p, float (&x)[8]) { unpack8(*(const v4u*)p, x); }
__device__ __forceinline__ void load8_f32(const float* p, float (&x)[8]) { const f32x4 a = *(const f32x4*)p, b = *(const f32x4*)(p + 4); x[0] = a[0]; x[1] = a[1]; x[2] = a[2]; x[3] = a[3]; x[4] = b[0]; x[5] = b[1]; x[6] = b[2]; x[7] = b[3]; }
template <bool SAMPC> struct EpiZT {
    static constexpr bool PERM = true, AFTER_DRAIN = false;
    const float* rs1; const float* rope; bf16 *XA, *GA, *Q, *K, *V; float* QS; float* out; LAS float* ex;
    __device__ __forceinline__ void pre(const pg8::Unit& u, int par, int tid) const { if (tid < 256) ex[1024 + par * 256 + tid] = rs1[u.pm * 256 + tid]; }
    __device__ __forceinline__ void operator()(const pg8::f32x4 (&acc)[2][2][4][2], const pg8::Unit& u, int wr, int wc, int fr, int fq, int par) const {
        const int type = u.pn >> 1;
        if (type == 2 || type == 3) body<true, SAMPC>(acc, u, wr, wc, fr, fq, par, type); else body<false, SAMPC>(acc, u, wr, wc, fr, fq, par, type);
    }
    template <bool ROPE_T, bool SAMP>
    __device__ __forceinline__ void body(const pg8::f32x4 (&acc)[2][2][4][2], const pg8::Unit& u, int wr, int wc, int fr, int fq, int par, const int TYPE) const {
        const int cbase = (u.pn & 1) * 256 + wc * 32 + 8 * fq;
        float rsv[2][4];
#pragma unroll
        for (int ai = 0; ai < 2; ++ai)
#pragma unroll
            for (int m = 0; m < 4; ++m) rsv[ai][m] = ex[1024 + par * 256 + ai * 128 + wr * 64 + m * 16 + fr];
        const bool do_rope = ROPE_T && (wc & 1) == 0;
        bf16* const dst = TYPE == 0 ? XA : TYPE == 1 ? GA : TYPE == 2 ? Q : TYPE == 3 ? K : V;
        const bool st_kv = !SAMP && (TYPE == 3 || TYPE == 4) && (u.pm & 15) >= 8;
        const bool st_xa = !SAMP && TYPE == 0 && (u.pm & 15) == 15 && wr == 1;
#pragma unroll
        for (int ai = 0; ai < 2; ++ai) {
            f32x4 rc[4][4];
#pragma unroll
            for (int m = 0; m < 4; ++m) {
                if (ROPE_T && (m & 1) == 0 && do_rope && fq < 2) {
#pragma unroll
                    for (int mm = m; mm < m + 2; ++mm) { const int row = u.pm * 256 + ai * 128 + wr * 64 + mm * 16 + fr; const int pi = SAMP ? 4096 + (row & 3) : (row & 4095);
                        const f32x4* rp = (const f32x4*)(rope + (size_t)pi * 16); rc[mm][0] = rp[0]; rc[mm][1] = rp[1]; rc[mm][2] = rp[2]; rc[mm][3] = rp[3]; }
                }
                const int row = u.pm * 256 + ai * 128 + wr * 64 + m * 16 + fr;
                const float rs = (TYPE == 2) ? rsv[ai][m] * C2 : rsv[ai][m];
                const int b = SAMP ? ((row - MP) >> 2) : (row >> 12), t = SAMP ? (row & 3) : (row & 4095);
#pragma unroll
                for (int bj = 0; bj < 2; ++bj) {
                    const int ct = cbase + 128 * bj;
                    float v[8];
#pragma unroll
                    for (int i = 0; i < 4; ++i) { v[i] = acc[ai][bj][m][0][i] * rs; v[4 + i] = acc[ai][bj][m][1][i] * rs; }
                    if (ROPE_T && do_rope) {
                        float pv[8];
#pragma unroll
                        for (int i = 0; i < 8; ++i) pv[i] = __shfl_xor(v[i], 16);
                        if (fq < 2) { const float sg = fq == 0 ? -1.f : 1.f;
                            const f32x4 c0 = rc[m][0], c1 = rc[m][1], s0 = rc[m][2], s1 = rc[m][3];
#pragma unroll
                            for (int i = 0; i < 4; ++i) { v[i] = v[i] * c0[i] + sg * pv[i] * s0[i]; v[4 + i] = v[4 + i] * c1[i] + sg * pv[4 + i] * s1[i]; } }
                    }
                    *(v4u*)(dst + (size_t)row * 512 + ct) = pack8(v);
                    float* so = nullptr;
                    if (SAMP) {
                        if (TYPE == 0) { if (t >= 1) so = out + O_SCA + (size_t)(b * 3 + t - 1) * DL + ct; }
                        else if (TYPE == 2) so = QS + (size_t)(row - MP) * 512 + ct;
                        else if (TYPE == 3) so = out + O_SWK + (size_t)(b * 4 + t) * 512 + ct;
                        else if (TYPE == 4) so = out + O_SWV + (size_t)(b * 4 + t) * 512 + ct;
                    } else {
                        if (TYPE == 0) { if (st_xa && ai == 1 && m == 3 && fr >= 13) so = out + O_PCA + (size_t)(b * 3 + (t - (SEQ - 3))) * DL + ct; }
                        else if (TYPE == 3) { if (st_kv) so = out + O_PWK + (size_t)(b * 2048 + t - 2048) * 512 + ct; }
                        else if (TYPE == 4) { if (st_kv) so = out + O_PWV + (size_t)(b * 2048 + t - 2048) * 512 + ct; }
                    }
                    if (so) { *(f32x4*)so = (f32x4){v[0], v[1], v[2], v[3]}; *(f32x4*)(so + 4) = (f32x4){v[4], v[5], v[6], v[7]}; }
                }
            }
        }
    }
};
struct EpiX1 {
    static constexpr bool PERM = true, AFTER_DRAIN = false;
    __device__ __forceinline__ void pre(const pg8::Unit&, int, int) const {}
    const float* xp; const float* xs; float* Y; bf16* X1B; float* SSP;
    __device__ __forceinline__ void operator()(const pg8::f32x4 (&acc)[2][2][4][2], const pg8::Unit& u, int wr, int wc, int fr, int fq, int par) const {
        const int cbase = u.pn * 256 + wc * 32 + 8 * fq;
#pragma unroll
        for (int ai = 0; ai < 2; ++ai) {
            f32x4 xv[4][2][2];
#pragma unroll
            for (int m = 0; m < 4; ++m) { const int row = u.pm * 256 + ai * 128 + wr * 64 + m * 16 + fr;
                const float* xr = row < MP ? xp + (size_t)row * DM : xs + (size_t)(row - MP) * DM;
#pragma unroll
                for (int bj = 0; bj < 2; ++bj) { xv[m][bj][0] = __builtin_nontemporal_load((const f32x4*)(xr + cbase + 128 * bj)); xv[m][bj][1] = __builtin_nontemporal_load((const f32x4*)(xr + cbase + 128 * bj + 4)); } }
#pragma unroll
            for (int m = 0; m < 4; ++m) {
                const int row = u.pm * 256 + ai * 128 + wr * 64 + m * 16 + fr;
                float ss = 0.f;
#pragma unroll
                for (int bj = 0; bj < 2; ++bj) {
                    const int ct = cbase + 128 * bj;
                    const f32x4 o0 = xv[m][bj][0] + acc[ai][bj][m][0], o1 = xv[m][bj][1] + acc[ai][bj][m][1];
                    if (u.pm >= MP / 256) { *(f32x4*)(Y + (size_t)row * DM + ct) = o0; *(f32x4*)(Y + (size_t)row * DM + ct + 4) = o1; }
                    const float v[8] = {o0[0], o0[1], o0[2], o0[3], o1[0], o1[1], o1[2], o1[3]};
                    *(v4u*)(X1B + (size_t)row * DM + ct) = pack8(v);
#pragma unroll
                    for (int i = 0; i < 8; ++i) ss += v[i] * v[i];
                }
                ss += __shfl_xor(ss, 16); ss += __shfl_xor(ss, 32);
                if (fq == 0) SSP[(size_t)row * 16 + u.pn * 4 + wc] = ss;
            }
        }
    }
};
__device__ __forceinline__ float row_rs(const float* SSP, int row) {
    const f32x4* p = (const f32x4*)(SSP + (size_t)row * 16); const f32x4 a = p[0], b = p[1], c = p[2], d = p[3];
    const float s = ((a[0] + a[1]) + (a[2] + a[3])) + ((b[0] + b[1]) + (b[2] + b[3])) + ((c[0] + c[1]) + (c[2] + c[3])) + ((d[0] + d[1]) + (d[2] + d[3]));
    return 1.f / sqrtf(s * (1.f / DM) + EPS);
}
template <int CTRL> __device__ __forceinline__ float dpp_t(float v) { return __builtin_bit_cast(float, __builtin_amdgcn_update_dpp(0, __builtin_bit_cast(int, v), CTRL, 0xf, 0xf, false)); }
#define dpp_f(v, ctrl) dpp_t<ctrl>(v)
template <int CTRL> __device__ __forceinline__ float dpp_b(float v) { return __builtin_bit_cast(float, __builtin_amdgcn_update_dpp(0, __builtin_bit_cast(int, v), CTRL, 0xf, 0xf, true)); }
__device__ __forceinline__ float dpp_ror1(float v) { return __builtin_bit_cast(float, __builtin_amdgcn_update_dpp(0, __builtin_bit_cast(int, v), 0x121, 0xf, 0xf, false)); }
__device__ __forceinline__ float dpp_ror2(float v) { return __builtin_bit_cast(float, __builtin_amdgcn_update_dpp(0, __builtin_bit_cast(int, v), 0x122, 0xf, 0xf, false)); }
struct EpiGU {
    static constexpr bool PERM = true, AFTER_DRAIN = false;
    const float* SSP; bf16* H; const float* cw; const float* cb; const float* scf; float* out; float* HEADU; float* HEADP; float* TAIL; LAS float* ex; LAS float* cwl;
    __device__ __forceinline__ void pre(const pg8::Unit& u, int par, int tid) const {
        if (tid < 256) ex[1024 + par * 256 + tid] = row_rs(SSP, u.pm * 256 + tid);
        else { const int t = tid - 256, arr = t >> 6, c2 = (t & 63) * 2; const float* src = (arr < 3 ? cw + arr * DFF : cb) + u.pn * 128 + c2;
            const f32x2 v = *(const f32x2*)src; *(LAS f32x2*)(cwl + par * 512 + arr * 128 + c2) = v; }
    }
    __device__ __forceinline__ void operator()(const pg8::f32x4 (&acc)[2][2][4][2], const pg8::Unit& u, int wr, int wc, int fr, int fq, int par) const {
        if (u.pm >= MP / 256) sample_body(acc, u, wr, wc, fr, fq, par); else prompt_body(acc, u, wr, wc, fr, fq, par);
    }
    __device__ __forceinline__ void prompt_body(const pg8::f32x4 (&acc)[2][2][4][2], const pg8::Unit& u, int wr, int wc, int fr, int fq, int par) const {
        const int j0 = u.pn * 128 + wc * 32 + 8 * fq;
        const int wave = wr * 4 + wc;
        float w0[8], w1[8], w2[8], bb[8];
        { const LAS float* cl = cwl + par * 512 + wc * 32 + 8 * fq;
#pragma unroll
          for (int h = 0; h < 2; ++h) { const f32x4 a0 = *(const LAS f32x4*)(cl + 4 * h), a1 = *(const LAS f32x4*)(cl + 128 + 4 * h), a2 = *(const LAS f32x4*)(cl + 256 + 4 * h), a3 = *(const LAS f32x4*)(cl + 384 + 4 * h);
#pragma unroll
              for (int e = 0; e < 4; ++e) { w0[4 * h + e] = a0[e]; w1[4 * h + e] = a1[e]; w2[4 * h + e] = a2[e]; bb[4 * h + e] = a3[e]; } } }
        const bool l15 = fr == 15, l14 = fr >= 14;
#pragma unroll
        for (int ai = 0; ai < 2; ++ai) {
            const float rs = ex[1024 + par * 256 + ai * 128 + wr * 64 + 48 + fr];
            if (fr >= 14) { LAS float* e = ex + ((wave * 2 + ai) * 2 + (fr - 14)) * 32 + 8 * fq;
                *(LAS f32x4*)e = acc[ai][0][3][0] * rs; *(LAS f32x4*)(e + 4) = acc[ai][0][3][1] * rs; }
        }
        asm volatile("s_waitcnt lgkmcnt(0)\n\ts_barrier" ::: "memory");
#pragma unroll
        for (int ai = 0; ai < 2; ++ai) {
            float gp[8];
            bool pending = false;
            if (wr == 0 && ai == 0) {
#pragma unroll
                for (int e = 0; e < 8; ++e) gp[e] = 0.f;
                pending = (u.pm & 15) != 0;
            } else {
                const int sw = (wr == 1) ? wc : 4 + wc, sa = (wr == 1) ? ai : 0;
                const LAS float* e2 = ex + ((sw * 2 + sa) * 2 + (fr & 1)) * 32 + 8 * fq;
                const f32x4 b0 = *(const LAS f32x4*)e2, b1 = *(const LAS f32x4*)(e2 + 4);
#pragma unroll
                for (int e = 0; e < 4; ++e) { gp[e] = b0[e]; gp[4 + e] = b1[e]; }
            }
            float rsv[4];
#pragma unroll
            for (int m = 0; m < 4; ++m) rsv[m] = ex[1024 + par * 256 + ai * 128 + wr * 64 + m * 16 + fr];
#pragma unroll
            for (int m = 0; m < 4; ++m) {
                const int row = u.pm * 256 + ai * 128 + wr * 64 + m * 16 + fr;
                const float rs = rsv[m];
                float g[8], up[8]; unsigned yw[4];
#pragma unroll
                for (int e = 0; e < 4; ++e) { g[e] = acc[ai][0][m][0][e] * rs; g[4 + e] = acc[ai][0][m][1][e] * rs; up[e] = acc[ai][1][m][0][e] * rs; up[4 + e] = acc[ai][1][m][1][e] * rs; }
#pragma unroll
                for (int e2 = 0; e2 < 4; ++e2) {
                    f32x2 x;
#pragma unroll
                    for (int q = 0; q < 2; ++q) { const int e = 2 * e2 + q;
                        const float h1 = l15 ? gp[e] : g[e], h2 = l14 ? gp[e] : g[e];
                        float uc = fmaf(w2[e], g[e], bb[e]);
                        uc = fmaf(dpp_b<0x121>(h1), w1[e], uc); uc = fmaf(dpp_b<0x122>(h2), w0[e], uc);
                        x[q] = uc; }
                    f32x2 t = x * x; t = t * (f32x2){-0.10294324f, -0.10294324f} + (f32x2){-2.3022082f, -2.3022082f}; t = t * x;
                    f32x2 d = (f32x2){__builtin_amdgcn_exp2f(t[0]), __builtin_amdgcn_exp2f(t[1])} + (f32x2){1.f, 1.f};
                    const f32x2 r = (f32x2){__builtin_amdgcn_rcpf(d[0]), __builtin_amdgcn_rcpf(d[1])};
                    const f32x2 y = (x * r) * (f32x2){up[2 * e2], up[2 * e2 + 1]};
                    yw[e2] = pk2(y[0], y[1]);
                }
                const bool hold = pending && m == 0 && fr < 2;
                if (!hold) *(v4u*)(H + (size_t)row * DFF + j0) = (v4u){yw[0], yw[1], yw[2], yw[3]};
                else { float* hu = HEADU + (size_t)(u.pm * 2 + fr) * DFF + j0; float* hp = HEADP + (size_t)(u.pm * 2 + fr) * DFF + j0;
                    *(f32x4*)hu = (f32x4){g[0], g[1], g[2], g[3]}; *(f32x4*)(hu + 4) = (f32x4){g[4], g[5], g[6], g[7]};
                    *(f32x4*)hp = (f32x4){up[0], up[1], up[2], up[3]}; *(f32x4*)(hp + 4) = (f32x4){up[4], up[5], up[6], up[7]}; }
                if (ai == 1 && wr == 1 && m == 3 && fr >= 14) { float* so = TAIL + (size_t)(u.pm * 2 + (fr - 14)) * DFF + j0;
                    if ((u.pm & 15) == 15) { float* so2 = out + O_PCF + (size_t)((u.pm >> 4) * 2 + (fr - 14)) * DFF + j0;
                        *(f32x4*)so2 = (f32x4){g[0], g[1], g[2], g[3]}; *(f32x4*)(so2 + 4) = (f32x4){g[4], g[5], g[6], g[7]}; }
                    *(f32x4*)so = (f32x4){g[0], g[1], g[2], g[3]}; *(f32x4*)(so + 4) = (f32x4){g[4], g[5], g[6], g[7]}; }
#pragma unroll
                for (int e = 0; e < 8; ++e) gp[e] = g[e];
            }
        }
    }
    __device__ __forceinline__ void sample_body(const pg8::f32x4 (&acc)[2][2][4][2], const pg8::Unit& u, int wr, int wc, int fr, int fq, int par) const {
        const int j0 = u.pn * 128 + wc * 32 + 8 * fq;
        constexpr bool samp = true;
        const int wave = wr * 4 + wc;
        float w0[8], w1[8], w2[8], bb[8];
        { const LAS float* cl = cwl + par * 512 + wc * 32 + 8 * fq;
#pragma unroll
          for (int h = 0; h < 2; ++h) { const f32x4 a0 = *(const LAS f32x4*)(cl + 4 * h), a1 = *(const LAS f32x4*)(cl + 128 + 4 * h), a2 = *(const LAS f32x4*)(cl + 256 + 4 * h), a3 = *(const LAS f32x4*)(cl + 384 + 4 * h);
#pragma unroll
              for (int e = 0; e < 4; ++e) { w0[4 * h + e] = a0[e]; w1[4 * h + e] = a1[e]; w2[4 * h + e] = a2[e]; bb[4 * h + e] = a3[e]; } } }
        if (!samp) {
#pragma unroll
            for (int ai = 0; ai < 2; ++ai) {
                const float rs = ex[1024 + par * 256 + ai * 128 + wr * 64 + 48 + fr];
                if (fr >= 14) { LAS float* e = ex + ((wave * 2 + ai) * 2 + (fr - 14)) * 32 + 8 * fq;
                    *(LAS f32x4*)e = acc[ai][0][3][0] * rs; *(LAS f32x4*)(e + 4) = acc[ai][0][3][1] * rs; }
            }
            asm volatile("s_waitcnt lgkmcnt(0)\n\ts_barrier" ::: "memory");
        }
#pragma unroll
        for (int ai = 0; ai < 2; ++ai) {
            float pR1[8], pR2[8];
            bool pending = false;
            if (!samp) {
                if (wr == 0 && ai == 0) {
#pragma unroll
                    for (int e = 0; e < 8; ++e) { pR1[e] = 0.f; pR2[e] = 0.f; }
                    pending = (u.pm & 15) != 0;
                } else {
                    const int sw = (wr == 1) ? wc : 4 + wc, sa = (wr == 1) ? ai : 0;
                    const LAS float* e1 = ex + ((sw * 2 + sa) * 2 + 1) * 32 + 8 * fq; const LAS float* e2 = ex + ((sw * 2 + sa) * 2 + (fr & 1)) * 32 + 8 * fq;
                    const f32x4 a0 = *(const LAS f32x4*)e1, a1 = *(const LAS f32x4*)(e1 + 4), b0 = *(const LAS f32x4*)e2, b1 = *(const LAS f32x4*)(e2 + 4);
#pragma unroll
                    for (int e = 0; e < 4; ++e) { pR1[e] = a0[e]; pR1[4 + e] = a1[e]; pR2[e] = b0[e]; pR2[4 + e] = b1[e]; }
                }
            }
            float rsv[4];
#pragma unroll
            for (int m = 0; m < 4; ++m) rsv[m] = ex[1024 + par * 256 + ai * 128 + wr * 64 + m * 16 + fr];
#pragma unroll
            for (int m = 0; m < 4; ++m) {
                const int row = u.pm * 256 + ai * 128 + wr * 64 + m * 16 + fr;
                const float rs = rsv[m];
                float g[8], up[8]; unsigned yw[4];
#pragma unroll
                for (int e = 0; e < 4; ++e) { g[e] = acc[ai][0][m][0][e] * rs; g[4 + e] = acc[ai][0][m][1][e] * rs; up[e] = acc[ai][1][m][0][e] * rs; up[4 + e] = acc[ai][1][m][1][e] * rs; }
#pragma unroll
                for (int hf = 0; hf < 2; ++hf) {
                    float yh[4];
                    f32x4 s0 = (f32x4){0.f, 0.f, 0.f, 0.f}, s1 = s0; int sq = 3;
                    if (samp) { const int n = (row - MP) >> 2; sq = fr & 3; s0 = *(const f32x4*)(scf + (size_t)(n * 2) * DFF + j0 + 4 * hf); s1 = *(const f32x4*)(scf + (size_t)(n * 2 + 1) * DFF + j0 + 4 * hf); }
#pragma unroll
                    for (int e4 = 0; e4 < 4; ++e4) { const int e = 4 * hf + e4;
                        const float R1 = dpp_ror1(g[e]), R2 = dpp_ror2(g[e]);
                        float p1, p2;
                        if (!samp) { p1 = fr >= 1 ? R1 : pR1[e]; p2 = fr >= 2 ? R2 : pR2[e]; }
                        else { p1 = sq >= 1 ? R1 : s1[e4]; p2 = sq >= 2 ? R2 : (sq == 1 ? s1[e4] : s0[e4]); }
                        const float uc = bb[e] + w0[e] * p2 + w1[e] * p1 + w2[e] * g[e]; yh[e4] = gelu_tanh(uc) * up[e]; pR1[e] = R1; pR2[e] = R2; }
                    yw[2 * hf] = pk2(yh[0], yh[1]); yw[2 * hf + 1] = pk2(yh[2], yh[3]);
                }
                const bool hold = pending && m == 0 && fr < 2;
                if (!hold) *(v4u*)(H + (size_t)row * DFF + j0) = (v4u){yw[0], yw[1], yw[2], yw[3]};
                else { float* hu = HEADU + (size_t)(u.pm * 2 + fr) * DFF + j0; float* hp = HEADP + (size_t)(u.pm * 2 + fr) * DFF + j0;
                    *(f32x4*)hu = (f32x4){g[0], g[1], g[2], g[3]}; *(f32x4*)(hu + 4) = (f32x4){g[4], g[5], g[6], g[7]};
                    *(f32x4*)hp = (f32x4){up[0], up[1], up[2], up[3]}; *(f32x4*)(hp + 4) = (f32x4){up[4], up[5], up[6], up[7]}; }
                float* so = nullptr;
                if (!samp) { if (ai == 1 && wr == 1 && m == 3 && fr >= 14) { so = TAIL + (size_t)(u.pm * 2 + (fr - 14)) * DFF + j0;
                        if ((u.pm & 15) == 15) { float* so2 = out + O_PCF + (size_t)((u.pm >> 4) * 2 + (fr - 14)) * DFF + j0;
                            *(f32x4*)so2 = (f32x4){g[0], g[1], g[2], g[3]}; *(f32x4*)(so2 + 4) = (f32x4){g[4], g[5], g[6], g[7]}; } } }
                else if ((fr & 3) >= 2) so = out + O_SCF + (size_t)(((row - MP) >> 2) * 2 + ((fr & 3) - 2)) * DFF + j0;
                if (so) { *(f32x4*)so = (f32x4){g[0], g[1], g[2], g[3]}; *(f32x4*)(so + 4) = (f32x4){g[4], g[5], g[6], g[7]}; }
            }
        }
    }
};
struct EpiX2 {
    static constexpr bool PERM = true, AFTER_DRAIN = false;
    __device__ __forceinline__ void pre(const pg8::Unit&, int, int) const {}
    float* Y; const bf16* X1B;
    __device__ __forceinline__ void operator()(const pg8::f32x4 (&acc)[2][2][4][2], const pg8::Unit& u, int wr, int wc, int fr, int fq, int par) const {
        const int cbase = u.pn * 256 + wc * 32 + 8 * fq;
#pragma unroll
        for (int ai = 0; ai < 2; ++ai) {
            v4u xv[4][2];
#pragma unroll
            for (int m = 0; m < 4; ++m) { const bf16* xr = X1B + (size_t)(u.pm * 256 + ai * 128 + wr * 64 + m * 16 + fr) * DM + cbase;
#pragma unroll
                for (int bj = 0; bj < 2; ++bj) xv[m][bj] = *(const v4u*)(xr + 128 * bj); }
#pragma unroll
            for (int m = 0; m < 4; ++m) {
                const int row = u.pm * 256 + ai * 128 + wr * 64 + m * 16 + fr;
#pragma unroll
                for (int bj = 0; bj < 2; ++bj) { float* yp = Y + (size_t)row * DM + cbase + 128 * bj; float x[8]; unpack8(xv[m][bj], x);
                    *(f32x4*)yp = (f32x4){x[0], x[1], x[2], x[3]} + acc[ai][bj][m][0]; *(f32x4*)(yp + 4) = (f32x4){x[4], x[5], x[6], x[7]} + acc[ai][bj][m][1]; }
            }
        }
    }
};
constexpr int CW_X2C = 100000;
struct EpiX2F {
    static constexpr bool PERM = true, AFTER_DRAIN = true;
    __device__ __forceinline__ void pre(const pg8::Unit&, int, int) const {}
    float* Y; const bf16* X1B; const float* gfin; float* xbuf; unsigned* cnt;
    __device__ __forceinline__ void operator()(const pg8::f32x4 (&)[2][2][4][2], const pg8::Unit&, int, int, int, int, int) const {}
    __device__ __forceinline__ void fused(pg8::f32x4 (&acc)[2][2][4][2], const pg8::Unit& u, int wr, int wc, int fr, int fq, LAS unsigned char* lds, int wid, int lane) const {
        const int cbase = u.pn * 256 + wc * 32 + 8 * fq, tid = wid * 64 + lane;
        LAS float* P = (LAS float*)lds; LAS float* S = P + 1024; LAS unsigned* flag = (LAS unsigned*)(S + 256);
        { v4u xv[2][4][2];
#pragma unroll
          for (int ai = 0; ai < 2; ++ai)
#pragma unroll
            for (int m = 0; m < 4; ++m) { const bf16* xr = X1B + (size_t)(u.pm * 256 + ai * 128 + wr * 64 + m * 16 + fr) * DM + cbase;
#pragma unroll
                for (int bj = 0; bj < 2; ++bj) xv[ai][m][bj] = *(const v4u*)(xr + 128 * bj); }
#pragma unroll
          for (int ai = 0; ai < 2; ++ai)
#pragma unroll
            for (int m = 0; m < 4; ++m) { float ss = 0.f;
#pragma unroll
                for (int bj = 0; bj < 2; ++bj) { float x[8]; unpack8(xv[ai][m][bj], x);
#pragma unroll
                    for (int i = 0; i < 4; ++i) { acc[ai][bj][m][0][i] += x[i]; acc[ai][bj][m][1][i] += x[4 + i]; ss += acc[ai][bj][m][0][i] * acc[ai][bj][m][0][i] + acc[ai][bj][m][1][i] * acc[ai][bj][m][1][i]; } }
                ss += __shfl_xor(ss, 16); ss += __shfl_xor(ss, 32);
                if (fq == 0) P[(ai * 128 + wr * 64 + m * 16 + fr) * 4 + wc] = ss; } }
        asm volatile("s_waitcnt lgkmcnt(0)" ::: "memory"); __builtin_amdgcn_s_barrier(); asm volatile("" ::: "memory");
        if (tid < 256) { const pg8::f32x4 p4 = *(const LAS pg8::f32x4*)(P + tid * 4);
            __hip_atomic_store(xbuf + ((size_t)u.pm * 256 + tid) * 4 + u.pn, (p4[0] + p4[1]) + (p4[2] + p4[3]), __ATOMIC_RELAXED, __HIP_MEMORY_SCOPE_AGENT); }
        asm volatile("s_waitcnt vmcnt(0)" ::: "memory");
        if (lane == 0 && wid < 4) __hip_atomic_fetch_add(cnt + u.pm * 16, 1u, __ATOMIC_RELAXED, __HIP_MEMORY_SCOPE_AGENT);
        if (wid == 0) { unsigned spins = 0;
            while ((unsigned)__builtin_amdgcn_readfirstlane(__hip_atomic_load(cnt + u.pm * 16, __ATOMIC_RELAXED, __HIP_MEMORY_SCOPE_AGENT)) < 16u) { if (++spins > (1u << 20)) break; __builtin_amdgcn_s_sleep(2); }
            __builtin_amdgcn_fence(__ATOMIC_ACQUIRE, "agent"); }
        asm volatile("s_waitcnt vmcnt(0) lgkmcnt(0)" ::: "memory"); __builtin_amdgcn_s_barrier(); asm volatile("" ::: "memory");
        if (tid < 256) { const float* sl = xbuf + ((size_t)u.pm * 256 + tid) * 4; float t = 0.f;
#pragma unroll
            for (int k = 0; k < 4; ++k) t += __hip_atomic_load(sl + k, __ATOMIC_RELAXED, __HIP_MEMORY_SCOPE_AGENT);
            S[tid] = 1.f / sqrtf(t * (1.f / DM) + EPS); }
        asm volatile("s_waitcnt vmcnt(0) lgkmcnt(0)" ::: "memory"); __builtin_amdgcn_s_barrier(); asm volatile("" ::: "memory");
        pg8::f32x4 gv[2][2];
#pragma unroll
        for (int bj = 0; bj < 2; ++bj) { gv[bj][0] = *(const pg8::f32x4*)(gfin + cbase + 128 * bj); gv[bj][1] = *(const pg8::f32x4*)(gfin + cbase + 128 * bj + 4); }
#pragma unroll
        for (int ai = 0; ai < 2; ++ai)
#pragma unroll
            for (int m = 0; m < 4; ++m) { const int rl = ai * 128 + wr * 64 + m * 16 + fr; const float rs = S[rl]; float* yp = Y + (size_t)(u.pm * 256 + rl) * DM + cbase;
#pragma unroll
                for (int bj = 0; bj < 2; ++bj) { *(pg8::f32x4*)(yp + 128 * bj) = acc[ai][bj][m][0] * rs * gv[bj][0]; *(pg8::f32x4*)(yp + 128 * bj + 4) = acc[ai][bj][m][1] * rs * gv[bj][1]; } }
    }
};
struct SampleUnitOrder {
    int c, nw;
    __device__ __forceinline__ bool next(int i, pg8::Unit& u) const { const int L = i * nw + c; if (L >= 2 * (DIN / 256)) return false; u.pm = MP / 256 + L / (DIN / 256); u.pn = L % (DIN / 256); u.ko = 0; return true; }
    __device__ __forceinline__ void a_ready(const pg8::Unit&) const {}
    __device__ __forceinline__ void done(const pg8::Unit&) const {}
};
struct OneUnitOrder : pg8::StaticOrder {
    int i0;
    __device__ __forceinline__ bool next(int i, pg8::Unit& u) const { return i == 0 && pg8::StaticOrder::next(i0, u); }
};
constexpr int KSPLIT = 6, KSPLIT4 = 4;
struct EpiPart {
    static constexpr bool PERM = true, AFTER_DRAIN = false;
    __device__ __forceinline__ void pre(const pg8::Unit&, int, int) const {}
    float* PART; int kw;
    __device__ __forceinline__ void operator()(const pg8::f32x4 (&acc)[2][2][4][2], const pg8::Unit& u, int wr, int wc, int fr, int fq, int par) const {
        const int cbase = u.pn * 256 + wc * 32 + 8 * fq; float* P = PART + (size_t)(u.ko / kw) * MS * DM;
#pragma unroll
        for (int ai = 0; ai < 2; ++ai)
#pragma unroll
            for (int m = 0; m < 4; ++m) { const int rS = (u.pm - MP / 256) * 256 + ai * 128 + wr * 64 + m * 16 + fr;
#pragma unroll
                for (int bj = 0; bj < 2; ++bj) { float* pp = P + (size_t)rS * DM + cbase + 128 * bj; *(f32x4*)pp = acc[ai][bj][m][0]; *(f32x4*)(pp + 4) = acc[ai][bj][m][1]; } }
    }
};
struct SplitOrder {
    int G, c, ns, kw;
    __device__ __forceinline__ bool next(int i, pg8::Unit& u) const { const int idx = c + i * G; if (idx >= 8 * ns) return false;
        const int sl = idx >> 3, r = idx & 7; u.pm = MP / 256 + (r >> 2); u.pn = r & 3; u.ko = sl * kw; return true; }
    __device__ __forceinline__ void a_ready(const pg8::Unit&) const {}
    __device__ __forceinline__ void done(const pg8::Unit&) const {}
};
struct GatedOrder : pg8::StaticOrder {
    const unsigned* cnt; unsigned need;
    __device__ __forceinline__ void a_ready(const pg8::Unit& u) const {
        if (u.pm < MP / 256) return;
        if (threadIdx.x < 64) { unsigned spins = 0;
            while ((unsigned)__builtin_amdgcn_readfirstlane(__hip_atomic_load(cnt, __ATOMIC_RELAXED, __HIP_MEMORY_SCOPE_AGENT)) < need) { if (++spins > (1u << 20)) break; __builtin_amdgcn_s_sleep(2); }
            __builtin_amdgcn_fence(__ATOMIC_ACQUIRE, "agent");
            asm volatile("s_waitcnt vmcnt(0)" ::: "memory"); }
        asm volatile("" ::: "memory"); __builtin_amdgcn_s_barrier(); asm volatile("" ::: "memory");
    }
};
constexpr int CW_CNT4 = 90000;
__device__ __forceinline__ void finalize_x1_sample(const Args& a, int bx, int G, int wave, int lane) {
    unsigned char* ws = a.ws; const float* PART4 = (const float*)(ws + WS_PART4); float* Y = a.out + O_Y; bf16* X1B = (bf16*)(ws + WS_X1B); float* SSP = (float*)(ws + WS_SSP);
    unsigned* cnt = (unsigned*)(ws + WS_CTL) + CW_CNT4;
    for (int r = bx + G * wave; r < MS; r += G * NWAVES) {
        const int row = MP + r; f32x4 v[4]; float ss = 0.f;
#pragma unroll
        for (int j = 0; j < 4; ++j) { v[j] = ((const GAS f32x4*)(a.in[I_XS] + (size_t)r * DM) + lane)[64 * j];
#pragma unroll
            for (int sl = 0; sl < KSPLIT4; ++sl) v[j] += ((const GAS f32x4*)(PART4 + ((size_t)sl * MS + r) * DM) + lane)[64 * j];
            ss += (v[j].x * v[j].x + v[j].y * v[j].y) + (v[j].z * v[j].z + v[j].w * v[j].w); }
        ss = wave_sum(ss);
#pragma unroll
        for (int j = 0; j < 4; ++j) { const size_t e = (size_t)row * DM + 4 * (lane + 64 * j);
            __hip_atomic_store((unsigned long long*)(Y + e), ((unsigned long long)__float_as_uint(v[j].y) << 32) | __float_as_uint(v[j].x), __ATOMIC_RELAXED, __HIP_MEMORY_SCOPE_AGENT);
            __hip_atomic_store((unsigned long long*)(Y + e + 2), ((unsigned long long)__float_as_uint(v[j].w) << 32) | __float_as_uint(v[j].z), __ATOMIC_RELAXED, __HIP_MEMORY_SCOPE_AGENT);
            __hip_atomic_store((unsigned long long*)(X1B + e), ((unsigned long long)pk2(v[j].z, v[j].w) << 32) | pk2(v[j].x, v[j].y), __ATOMIC_RELAXED, __HIP_MEMORY_SCOPE_AGENT); }
        if (lane < 8) __hip_atomic_store((unsigned long long*)(SSP + (size_t)row * 16 + 2 * lane), lane == 0 ? (unsigned long long)__float_as_uint(ss) : 0ull, __ATOMIC_RELAXED, __HIP_MEMORY_SCOPE_AGENT);
        asm volatile("s_waitcnt vmcnt(0)" ::: "memory");
        if (lane == 0) __hip_atomic_fetch_add(cnt, 1u, __ATOMIC_RELAXED, __HIP_MEMORY_SCOPE_AGENT);
    }
}

constexpr int LRU_CS = 64 * 16 + 16;
template <int MODE> __device__ __forceinline__ void lru_item(const Args& a, int item, LAS unsigned char* lds, int wid, int lane) {
    unsigned char* ws = a.ws;
    const bf16* XA = (const bf16*)(ws + WS_XA); const bf16* GAb = (const bf16*)(ws + WS_GA); const bf16* WL = (const bf16*)(ws + WS_WL);
    const float* C8 = (const float*)(ws + WS_C8); float* AGGA = (float*)(ws + WS_AGGA); float* AGGB = (float*)(ws + WS_AGGB); bf16* MIX = (bf16*)(ws + WS_MIX);
    const int seq = item >> 6, chunk = item & 63, g = wid;
    const int row0 = (MODE == 2) ? MP + item * 64 : seq * SEQ + chunk * 64;
    {
        float w[4][8], bb[8];
#pragma unroll
        for (int j = 0; j < 4; ++j) load8_f32(a.in[I_CAW] + j * DL + 8 * lane, w[j]);
        load8_f32(a.in[I_CAB] + 8 * lane, bb);
        if (MODE != 2) {
            v4u xr[11];
#pragma unroll
            for (int k = 0; k < 11; ++k) { const int t = chunk * 64 + wid * 8 - 3 + k;
                if (t >= 0) xr[k] = *(const v4u*)(XA + (size_t)(seq * SEQ + t) * DL + 8 * lane); else xr[k] = (v4u){0u, 0u, 0u, 0u}; }
#pragma unroll
            for (int it = 0; it < 8; ++it) {
                float s[8];
#pragma unroll
                for (int i = 0; i < 8; ++i) s[i] = bb[i];
#pragma unroll
                for (int j = 0; j < 4; ++j) { float x[8]; unpack8(xr[it + j], x);
#pragma unroll
                    for (int i = 0; i < 8; ++i) s[i] += w[j][i] * x[i]; }
                *(LAS v4u*)(lds + lane * LRU_CS + (wid * 8 + it) * 16) = pack8(s);
            }
        } else {
#pragma unroll 1
            for (int it = 0; it < 8; ++it) {
                const int tok = it * 8 + wid;
                float s[8];
#pragma unroll
                for (int i = 0; i < 8; ++i) s[i] = bb[i];
#pragma unroll
                for (int j = 0; j < 4; ++j) {
                    float x[8];
                    const int n = item * 16 + (tok >> 2), e = (tok & 3) + j;
                    if (e < 3) load8_f32(a.in[I_SCA] + (size_t)(n * 3 + e) * DL + 8 * lane, x); else load8_bf16(XA + (size_t)(MP + 4 * n + e - 3) * DL + 8 * lane, x);
#pragma unroll
                    for (int i = 0; i < 8; ++i) s[i] += w[j][i] * x[i];
                }
                *(LAS v4u*)(lds + lane * LRU_CS + tok * 16) = pack8(s);
            }
        }
    }
    __syncthreads();
    const int r32 = lane & 31, hi = lane >> 5;
    float hc0 = 0.f, hc1 = 0.f, At0 = 1.f, At1 = 1.f;
    if (MODE == 1) {
#pragma unroll 1
        for (int c0 = 0; c0 < chunk; c0 += 16) {
            float ca0[16], cb0[16], ca1[16], cb1[16];
#pragma unroll
            for (int u = 0; u < 16; ++u) { const int c = c0 + u; const size_t o = (size_t)(seq * 64 + (c < chunk ? c : 0)) * DL + 64 * g + r32;
                ca0[u] = AGGA[o]; cb0[u] = AGGB[o]; ca1[u] = AGGA[o + 32]; cb1[u] = AGGB[o + 32]; }
#pragma unroll
            for (int u = 0; u < 16; ++u) if (c0 + u < chunk) { hc0 = ca0[u] * hc0 + cb0[u]; hc1 = ca1[u] * hc1 + cb1[u]; }
        }
    }
#pragma unroll 1
    for (int mc = 0; mc < 4; ++mc) {
        const int mt = mc >> 1, ct = mc & 1;
        const int ch = 64 * g + 32 * ct + r32;
        float hcur = ct ? hc1 : hc0, Atc = ct ? At1 : At0;
        bf16x8 af[4];
#pragma unroll
        for (int ks = 0; ks < 4; ++ks) af[ks] = *(const LAS bf16x8*)(lds + (8 * g + 2 * ks + hi) * LRU_CS + (32 * mt + r32) * 16);
        f32x16 D[3];
        const bf16* wlp = WL + (size_t)((g * 192 + 32 * ct + r32) * 64 + 8 * hi);
#pragma unroll
        for (int o = 0; o < 3; ++o) {
            D[o] = f32x16{};
#pragma unroll
            for (int ks = 0; ks < 4; ++ks) {
                const bf16x8 bfr = *(const bf16x8*)(wlp + o * 64 * 64 + 16 * ks);
                D[o] = __builtin_amdgcn_mfma_f32_32x32x16_bf16(af[ks], bfr, D[o], 0, 0, 0);
            }
        }
        const float br = a.in[I_BR][ch], bi = a.in[I_BI][ch], c8 = C8[ch];
        float av[16], uv[16];
#pragma unroll
        for (int r = 0; r < 16; ++r) {
            const float rr = sigmoidf_(D[0][r] + br), gi = sigmoidf_(D[1][r] + bi);
            const float la = -c8 * rr; av[r] = __expf(la); uv[r] = __builtin_amdgcn_sqrtf(one_minus_exp(2.f * la)) * gi * D[2][r];
        }
        if (MODE == 2) {
#pragma unroll
            for (int k = 0; k < 4; ++k) {
                const int n = item * 16 + 8 * mt + 2 * k + hi;
                float hh = a.in[I_SLH][(size_t)n * DL + ch];
#pragma unroll
                for (int i = 0; i < 4; ++i) { hh = av[4 * k + i] * hh + uv[4 * k + i]; uv[4 * k + i] = hh; }
                a.out[O_SLH + (size_t)n * DL + ch] = hh;
            }
        } else {
#pragma unroll
            for (int k = 0; k < 4; ++k) {
                const float a0 = av[4 * k], a1 = av[4 * k + 1], a2 = av[4 * k + 2], a3 = av[4 * k + 3];
                const float GAm = (a0 * a1) * (a2 * a3), GBm = ((uv[4 * k] * a1 + uv[4 * k + 1]) * a2 + uv[4 * k + 2]) * a3 + uv[4 * k + 3];
                const float Ao = __shfl_xor(GAm, 32), Bo = __shfl_xor(GBm, 32);
                const float A1 = hi ? Ao : GAm, B1 = hi ? Bo : GBm, A2 = hi ? GAm : Ao, B2 = hi ? GBm : Bo;
                const float hin1 = hcur; hcur = A1 * hcur + B1; const float hin2 = hcur; hcur = A2 * hcur + B2; Atc *= A1 * A2;
                if (MODE == 1) { float hh = hi ? hin2 : hin1;
#pragma unroll
                    for (int i = 0; i < 4; ++i) { hh = av[4 * k + i] * hh + uv[4 * k + i]; uv[4 * k + i] = hh; } }
            }
        }
        if (MODE != 0) {
            const bf16* gap = GAb + (size_t)(row0 + 32 * mt + 4 * hi) * DL + ch; bf16* mxp = MIX + (size_t)(row0 + 32 * mt + 4 * hi) * DM + ch;
            bf16 gv[16];
#pragma unroll
            for (int r = 0; r < 16; ++r) gv[r] = gap[((r & 3) + 8 * (r >> 2)) * DL];
#pragma unroll
            for (int r = 0; r < 16; ++r) { const int ro = (r & 3) + 8 * (r >> 2); mxp[ro * DM] = (bf16)f2bf(uv[r] * gelu_tanh(bf2f(gv[r]))); }
        }
        if (ct) { hc1 = hcur; At1 = Atc; } else { hc0 = hcur; At0 = Atc; }
    }
#pragma unroll
    for (int ct = 0; ct < 2; ++ct) {
        const int ch = 64 * g + 32 * ct + r32; const float Af = ct ? At1 : At0, hf = ct ? hc1 : hc0;
        if (MODE == 0) { if (hi == 0) { AGGA[(size_t)(seq * 64 + chunk) * DL + ch] = Af; AGGB[(size_t)(seq * 64 + chunk) * DL + ch] = hf; } }
        if (MODE == 1) { if (chunk == 63 && hi == 0) a.out[O_PLH + (size_t)seq * DL + ch] = hf; }
    }
    __syncthreads();
}

constexpr int CW_LRUF = 16384;
constexpr int LRF_CS = 1024, LRF_GA = 64 * LRF_CS;
__device__ __forceinline__ void lru_fused_item(const Args& a, int item, LAS unsigned char* lds, int wid, int lane) {
    unsigned char* ws = a.ws;
    const bf16* XA = (const bf16*)(ws + WS_XA); const bf16* GAb = (const bf16*)(ws + WS_GA); const bf16* WL = (const bf16*)(ws + WS_WL);
    const float* C8 = (const float*)(ws + WS_C8); unsigned long long* AGG2 = (unsigned long long*)(ws + WS_AGGA); bf16* MIX = (bf16*)(ws + WS_MIX);
    unsigned* flags = (unsigned*)(ws + WS_CTL) + CW_LRUF;
    asm volatile("" : "+v"(lane));
    const int seq = item >> 6, chunk = item & 63, g = wid;
    const int row0 = seq * SEQ + chunk * 64;
    {
        float w[4][8], bb[8];
#pragma unroll
        for (int j = 0; j < 4; ++j) load8_f32(a.in[I_CAW] + j * DL + 8 * lane, w[j]);
        load8_f32(a.in[I_CAB] + 8 * lane, bb);
        v4u xr[11];
#pragma unroll
        for (int k = 0; k < 11; ++k) { const int t = chunk * 64 + wid * 8 - 3 + k;
            if (t >= 0) xr[k] = *(const v4u*)(XA + (size_t)(seq * SEQ + t) * DL + 8 * lane); else xr[k] = (v4u){0u, 0u, 0u, 0u}; }
#pragma unroll
        for (int it = 0; it < 8; ++it) {
            float s8[8];
#pragma unroll
            for (int i = 0; i < 8; ++i) s8[i] = bb[i];
#pragma unroll
            for (int j = 0; j < 4; ++j) { float x[8]; unpack8(xr[it + j], x);
#pragma unroll
                for (int i = 0; i < 8; ++i) s8[i] += w[j][i] * x[i]; }
            *(LAS v4u*)(lds + lane * LRF_CS + (wid * 8 + it) * 16) = pack8(s8);
        }
#pragma unroll
        for (int it = 0; it < 8; ++it) xr[it] = *(const v4u*)(GAb + (size_t)(row0 + wid * 8 + it) * DL + 8 * lane);
#pragma unroll
        for (int it = 0; it < 8; ++it) *(LAS v4u*)(lds + LRF_GA + (wid * 8 + it) * 1024 + lane * 16) = xr[it];
    }
    __syncthreads();
    int r32 = lane & 31, hi = lane >> 5;
    unsigned pk[4][16];
    float At0 = 1.f, At1 = 1.f, Bt0 = 0.f, Bt1 = 0.f;
    bf16x8 bw[2][4];
#pragma unroll
    for (int mc = 0; mc < 4; ++mc) {
        const int ct = mc >> 1, mt = mc & 1;
        if (mt == 0) {
#pragma unroll
            for (int o = 0; o < 2; ++o)
#pragma unroll
                for (int ks = 0; ks < 4; ++ks) bw[o][ks] = *(const bf16x8*)(WL + (size_t)((g * 192 + 64 * o + 32 * ct + r32) * 64 + 16 * ks + 8 * hi));
        }
        const int ch = 64 * g + 32 * ct + r32;
        bf16x8 af[4];
#pragma unroll
        for (int ks = 0; ks < 4; ++ks) af[ks] = *(const LAS bf16x8*)(lds + (8 * g + 2 * ks + hi) * LRF_CS + (32 * mt + r32) * 16);
        f32x16 D[3];
#pragma unroll
        for (int o = 0; o < 2; ++o) {
            D[o] = f32x16{};
#pragma unroll
            for (int ks = 0; ks < 4; ++ks) D[o] = __builtin_amdgcn_mfma_f32_32x32x16_bf16(af[ks], bw[o][ks], D[o], 0, 0, 0);
        }
        {
            const LAS unsigned short* xp = (const LAS unsigned short*)(lds + (8 * g + 4 * ct + (r32 >> 3)) * LRF_CS + (32 * mt + 4 * hi) * 16 + (r32 & 7) * 2);
#pragma unroll
            for (int r = 0; r < 16; ++r) D[2][r] = bf2f(xp[((r & 3) + 8 * (r >> 2)) * 8]);
        }
        const float br = a.in[I_BR][ch], bi = a.in[I_BI][ch], c8 = C8[ch];
#pragma unroll
        for (int r = 0; r < 16; ++r) {
            const float rr = sigmoidf_(D[0][r] + br), gi = sigmoidf_(D[1][r] + bi);
            const float la = -c8 * rr, oma = one_minus_exp(la); pk[2 * mt + ct][r] = pk2(oma, __builtin_amdgcn_sqrtf(oma * (2.f - oma)) * gi * D[2][r]);
        }
        float Atc = ct ? At1 : At0, Btc = ct ? Bt1 : Bt0;
#pragma unroll
        for (int k = 0; k < 4; ++k) {
            const float a0 = 1.f - bflo(pk[2 * mt + ct][4 * k]), a1 = 1.f - bflo(pk[2 * mt + ct][4 * k + 1]), a2 = 1.f - bflo(pk[2 * mt + ct][4 * k + 2]), a3 = 1.f - bflo(pk[2 * mt + ct][4 * k + 3]);
            const float GAm = (a0 * a1) * (a2 * a3), GBm = ((bfhi(pk[2 * mt + ct][4 * k]) * a1 + bfhi(pk[2 * mt + ct][4 * k + 1])) * a2 + bfhi(pk[2 * mt + ct][4 * k + 2])) * a3 + bfhi(pk[2 * mt + ct][4 * k + 3]);
            const float Ao = __shfl_xor(GAm, 32), Bo = __shfl_xor(GBm, 32);
            const float A1 = hi ? Ao : GAm, B1 = hi ? Bo : GBm, A2 = hi ? GAm : Ao, B2 = hi ? GBm : Bo;
            Btc = A1 * Btc + B1; Btc = A2 * Btc + B2; Atc *= A1 * A2;
        }
        if (ct) { At1 = Atc; Bt1 = Btc; } else { At0 = Atc; Bt0 = Btc; }
        asm volatile("" ::: "memory");
    }
    if (hi == 0) {
        __hip_atomic_store(AGG2 + (size_t)(seq * 64 + chunk) * DL + 64 * g + r32, ((unsigned long long)__float_as_uint(Bt0) << 32) | __float_as_uint(At0), __ATOMIC_RELAXED, __HIP_MEMORY_SCOPE_AGENT);
        __hip_atomic_store(AGG2 + (size_t)(seq * 64 + chunk) * DL + 64 * g + 32 + r32, ((unsigned long long)__float_as_uint(Bt1) << 32) | __float_as_uint(At1), __ATOMIC_RELAXED, __HIP_MEMORY_SCOPE_AGENT);
    }
    asm volatile("s_waitcnt vmcnt(0)" ::: "memory");
    if (lane == 0) __hip_atomic_store(flags + (size_t)((seq * 64 + chunk) * 8 + g) * 16, 1u, __ATOMIC_RELAXED, __HIP_MEMORY_SCOPE_AGENT);
    {
        const unsigned* fp = flags + (size_t)((seq * 64 + (lane < chunk ? lane : 0)) * 8 + g) * 16;
        unsigned spins = 0;
        for (;;) {
            const unsigned v = (lane < chunk) ? __hip_atomic_load(fp, __ATOMIC_RELAXED, __HIP_MEMORY_SCOPE_AGENT) : 1u;
            if (__all(v != 0u)) break;
            if (++spins > (1u << 20)) break;
            __builtin_amdgcn_s_sleep(2);
        }
        asm volatile("" ::: "memory");
    }
    float hc0, hc1;
    {
        const int cmid = chunk >> 1, cb = hi ? cmid : 0, ce = hi ? chunk : cmid;
        float A0 = 1.f, B0 = 0.f, A1 = 1.f, B1 = 0.f;
#pragma unroll 1
        for (int c0 = cb; c0 < ce; c0 += 12) {
            unsigned long long p0[12], p1[12];
#pragma unroll
            for (int u = 0; u < 12; ++u) { const int c = c0 + u; const size_t o = (size_t)(seq * 64 + (c < ce ? c : cb)) * DL + 64 * g + r32;
                p0[u] = __hip_atomic_load(AGG2 + o, __ATOMIC_RELAXED, __HIP_MEMORY_SCOPE_AGENT); p1[u] = __hip_atomic_load(AGG2 + o + 32, __ATOMIC_RELAXED, __HIP_MEMORY_SCOPE_AGENT); }
#pragma unroll
            for (int u = 0; u < 12; ++u) if (c0 + u < ce) {
                const float a0 = __uint_as_float((unsigned)p0[u]), b0 = __uint_as_float((unsigned)(p0[u] >> 32)), a1 = __uint_as_float((unsigned)p1[u]), b1 = __uint_as_float((unsigned)(p1[u] >> 32));
                B0 = a0 * B0 + b0; A0 *= a0; B1 = a1 * B1 + b1; A1 *= a1; }
        }
        const float Bl0 = __shfl_xor(B0, 32), Bl1 = __shfl_xor(B1, 32);
        const float lo0 = hi ? Bl0 : B0, lo1 = hi ? Bl1 : B1;
        const float Ah0 = __shfl_xor(A0, 32), Ah1 = __shfl_xor(A1, 32);
        const float uA0 = hi ? A0 : Ah0, uA1 = hi ? A1 : Ah1, uB0 = hi ? B0 : Bl0, uB1 = hi ? B1 : Bl1;
        hc0 = uA0 * lo0 + uB0; hc1 = uA1 * lo1 + uB1;
    }
#pragma unroll
    for (int mc = 0; mc < 4; ++mc) {
        const int mt = mc >> 1, ct = mc & 1;
        asm volatile("" : "+v"(r32), "+v"(hi));
        const int ch = 64 * g + 32 * ct + r32;
        float hcur = ct ? hc1 : hc0;
        LAS unsigned short* gy = (LAS unsigned short*)(lds + LRF_GA + (32 * mt + 4 * hi) * 1024 + (32 * ct + 64 * g + r32) * 2);
#pragma unroll
        for (int k = 0; k < 4; ++k) {
            const float a0 = 1.f - bflo(pk[mc][4 * k]), a1 = 1.f - bflo(pk[mc][4 * k + 1]), a2 = 1.f - bflo(pk[mc][4 * k + 2]), a3 = 1.f - bflo(pk[mc][4 * k + 3]);
            const float GAm = (a0 * a1) * (a2 * a3), GBm = ((bfhi(pk[mc][4 * k]) * a1 + bfhi(pk[mc][4 * k + 1])) * a2 + bfhi(pk[mc][4 * k + 2])) * a3 + bfhi(pk[mc][4 * k + 3]);
            const float Ao = __shfl_xor(GAm, 32), Bo = __shfl_xor(GBm, 32);
            const float A1 = hi ? Ao : GAm, B1 = hi ? Bo : GBm, A2 = hi ? GAm : Ao, B2 = hi ? GBm : Bo;
            const float hin1 = hcur; hcur = A1 * hcur + B1; const float hin2 = hcur; hcur = A2 * hcur + B2;
            float hh = hi ? hin2 : hin1;
#pragma unroll
            for (int i = 0; i < 4; ++i) { hh = (1.f - bflo(pk[mc][4 * k + i])) * hh + bfhi(pk[mc][4 * k + i]); pk[mc][4 * k + i] = __float_as_uint(hh); }
        }
#pragma unroll
        for (int r = 0; r < 16; ++r) { const int ro = (r & 3) + 8 * (r >> 2); gy[ro * 512] = (unsigned short)(pk2(__uint_as_float(pk[mc][r]) * gelu_tanh(bf2f(gy[ro * 512])), 0.f) & 0xffffu); }
        if (ct) hc1 = hcur; else hc0 = hcur;
        asm volatile("" ::: "memory");
    }
    __syncthreads();
    {
        const int tid_ = wid * 64 + lane;
#pragma unroll
        for (int i = 0; i < 8; ++i) { const int pc = tid_ + NTHR * i, tok = pc >> 6, c16 = pc & 63;
            *(v4u*)(MIX + (size_t)(row0 + tok) * DM + c16 * 8) = *(const LAS v4u*)(lds + LRF_GA + tok * 1024 + c16 * 16); }
    }
    if (chunk == 63 && hi == 0) { a.out[O_PLH + (size_t)seq * DL + 64 * g + r32] = hc0; a.out[O_PLH + (size_t)seq * DL + 64 * g + 32 + r32] = hc1; }
    __syncthreads();
}

constexpr int NK = 384, KCS = NK * 16 + 16, VDS = NK * 64 + 64, ATT_K = 0, ATT_V = 8 * KCS, ATT_WS = ATT_V + 2 * VDS;
static_assert(ATT_WS + NWAVES * 256 <= RING_BYTES, "attention LDS");
__device__ __forceinline__ s16x4 vtr(const LAS unsigned char* p) { typedef short v4i16_t __attribute__((ext_vector_type(4))); return __builtin_bit_cast(s16x4, __builtin_amdgcn_ds_read_tr16_b64_v4i16((LAS v4i16_t*)p)); }

__device__ __forceinline__ void attn_prompt_unit(const Args& a, int unit, LAS unsigned char* lds, int tid, int wid, int lane) {
    unsigned char* ws = a.ws;
    const bf16* Qb = (const bf16*)(ws + WS_Q); const bf16* Kb = (const bf16*)(ws + WS_K); const bf16* Vb = (const bf16*)(ws + WS_V);
    bf16* OP = (bf16*)(ws + WS_OP); float* LSE = (float*)(ws + WS_LSE);
    const int u16 = unit & 15, p = (unit >> 4) % 3, bh = unit / 48, b = bh >> 3, h = bh & 7;
    const int ld = 2 * p, d = 1 << ld;
    const int lnb = 4 - ld, blk = u16 & ((1 << lnb) - 1), r = u16 >> lnb;
    const int j0 = 256 * blk - 128;
    const int kk_min = (blk == 0) ? 128 : 0;
    const size_t rowb = (size_t)b * SEQ;
#pragma unroll
    for (int i = 0; i < 6; ++i) {
        const int piece = tid + NTHR * i, kk = piece >> 3, c = piece & 7;
        if (kk >= kk_min) {
            const size_t row = rowb + (size_t)(r + d * (j0 + kk));
            const v4u kv = *(const v4u*)(Kb + row * 512 + h * 64 + c * 8), vv = *(const v4u*)(Vb + row * 512 + h * 64 + c * 8);
            *(LAS v4u*)(lds + ATT_K + c * KCS + kk * 16) = kv;
            *(LAS v4u*)(lds + ATT_V + (c >> 2) * VDS + kk * 64 + (c & 3) * 16) = vv;
        }
    }
    const int r32 = lane & 31, hi = lane >> 5;
    bf16x8 qr[4];
    { const size_t qrow = rowb + (size_t)(r + d * (256 * blk + 32 * wid + r32));
#pragma unroll
      for (int ks = 0; ks < 4; ++ks) qr[ks] = *(const bf16x8*)(Qb + qrow * 512 + h * 64 + 16 * ks + 8 * hi); }
    __syncthreads();
    const int kt0 = (blk == 0 && wid < 4) ? 4 - wid : 0;
    f32x16 pt[5];
#pragma unroll
    for (int kt = 0; kt < 5; ++kt) {
        if (kt >= kt0) {
            const int T = wid + kt; f32x16 acc = f32x16{};
#pragma unroll
            for (int ks = 0; ks < 4; ++ks) { const bf16x8 kf = *(const LAS bf16x8*)(lds + ATT_K + (2 * ks + hi) * KCS + (32 * T + r32) * 16);
                acc = __builtin_amdgcn_mfma_f32_32x32x16_bf16(kf, qr[ks], acc, 0, 0, 0); }
            if (kt == 0) {
#pragma unroll
                for (int rg = 0; rg < 16; ++rg) if (crow(rg, hi) < r32) acc[rg] = -INFINITY; }
            if (kt == 4) {
#pragma unroll
                for (int rg = 0; rg < 16; ++rg) if (crow(rg, hi) > r32) acc[rg] = -INFINITY; }
            pt[kt] = acc;
        } else {
#pragma unroll
            for (int rg = 0; rg < 16; ++rg) pt[kt][rg] = -INFINITY;
        }
    }
    float mx = -INFINITY;
#pragma unroll
    for (int kt = 0; kt < 5; ++kt)
#pragma unroll
        for (int rg = 0; rg < 16; ++rg) mx = fmaxf(mx, pt[kt][rg]);
    mx = fmaxf(mx, __shfl_xor(mx, 32));
    float lsum = 0.f;
#pragma unroll
    for (int kt = 0; kt < 5; ++kt)
#pragma unroll
        for (int rg = 0; rg < 16; ++rg) { const float e = __builtin_amdgcn_exp2f(pt[kt][rg] - mx); pt[kt][rg] = e; lsum += e; }
    lsum += __shfl_xor(lsum, 32);
    f32x16 o[2]; o[0] = f32x16{}; o[1] = f32x16{};
    const LAS unsigned char* vb = lds + ATT_V + ((lane >> 4) & 1) * 32 + (lane & 3) * 8 + (4 * hi + ((lane & 15) >> 2)) * 64;
#pragma unroll
    for (int kt = 0; kt < 5; ++kt) {
        if (kt >= kt0) {
            const int T = wid + kt;
#pragma unroll
            for (int s = 0; s < 2; ++s) {
                v4u pw; pw.x = pg8::cvt_pk_bf16(pt[kt][8 * s], pt[kt][8 * s + 1]); pw.y = pg8::cvt_pk_bf16(pt[kt][8 * s + 2], pt[kt][8 * s + 3]);
                pw.z = pg8::cvt_pk_bf16(pt[kt][8 * s + 4], pt[kt][8 * s + 5]); pw.w = pg8::cvt_pk_bf16(pt[kt][8 * s + 6], pt[kt][8 * s + 7]);
                const bf16x8 pa = __builtin_bit_cast(bf16x8, pw);
#pragma unroll
                for (int d0 = 0; d0 < 2; ++d0) {
                    const LAS unsigned char* vp = vb + d0 * VDS + (32 * T + 16 * s) * 64;
                    const s16x4 lo = vtr(vp), hh = vtr(vp + 512);
                    const bf16x8 vf = (bf16x8){lo[0], lo[1], lo[2], lo[3], hh[0], hh[1], hh[2], hh[3]};
                    o[d0] = __builtin_amdgcn_mfma_f32_32x32x16_bf16(pa, vf, o[d0], 0, 0, 0);
                }
            }
        }
    }
    LAS float* wsf = (LAS float*)(lds + ATT_WS) + wid * 64;
    if (hi == 0) wsf[r32] = __builtin_amdgcn_rcpf(lsum);
    const size_t qrow_l = rowb + (size_t)(r + d * (256 * blk + 32 * wid + r32));
    if (hi == 0) LSE[((size_t)p * MP + qrow_l) * 8 + h] = mx + __builtin_amdgcn_logf(lsum);
    LDS_WAIT(); asm volatile("" ::: "memory");
#pragma unroll
    for (int rg = 0; rg < 16; ++rg) {
        const int qi = crow(rg, hi); const float rl = wsf[qi];
        const size_t orow = rowb + (size_t)(r + d * (256 * blk + 32 * wid + qi));
        bf16* op = OP + ((size_t)p * MP + orow) * 512 + h * 64 + r32;
        { const unsigned w2 = pk2(o[0][rg] * rl, o[1][rg] * rl); op[0] = (bf16)(w2 & 0xffffu); op[32] = (bf16)(w2 >> 16); }
    }
    __syncthreads();
}

constexpr int AP_K = 0, AP_KCS = NK * 16, AP_V = 8 * AP_KCS, AP_VDS = NK * 64, AP_VBUF = 2 * AP_VDS, AP_WS = AP_V + 2 * AP_VBUF;
static_assert(AP_WS + NWAVES * 256 <= LDSCTL_OFF, "pipelined attention LDS");
struct APUnit { int b, h, p, d, r, blk; };
__device__ __forceinline__ APUnit ap_decode(int unit) { APUnit u; const int u16 = unit & 15; u.p = (unit >> 4) % 3; const int bh = unit / 48; u.b = bh >> 3; u.h = bh & 7;
    const int ld = 2 * u.p; u.d = 1 << ld; const int lnb = 4 - ld; u.blk = u16 & ((1 << lnb) - 1); u.r = u16 >> lnb; return u; }
__device__ __forceinline__ void ap_issue_k(const APUnit& u, const bf16* Kb, LAS unsigned char* lds, int wid, int lane) {
#pragma unroll
    for (int i = 0; i < 6; ++i) { const int j = wid + 8 * i, c = j & 7, kb = j >> 3;
        if (u.blk == 0 && kb < 2) continue;
        const size_t row = (size_t)u.b * SEQ + (size_t)(u.r + u.d * (256 * u.blk - 128 + 64 * kb + lane));
        __builtin_amdgcn_global_load_lds((const unsigned*)(Kb + row * 512 + u.h * 64 + c * 8), (LAS unsigned*)(lds + AP_K + c * AP_KCS + kb * 1024), 16, 0, 0); }
}
__device__ __forceinline__ void ap_issue_v(const APUnit& u, const bf16* Vb, LAS unsigned char* lds, int vbuf, int wid, int lane) {
#pragma unroll
    for (int i = 0; i < 6; ++i) { const int j = wid + 8 * i, dh = j & 1, kb16 = j >> 1;
        if (u.blk == 0 && kb16 < 8) continue;
        const size_t row = (size_t)u.b * SEQ + (size_t)(u.r + u.d * (256 * u.blk - 128 + 16 * kb16 + (lane >> 2)));
        __builtin_amdgcn_global_load_lds((const unsigned*)(Vb + row * 512 + u.h * 64 + dh * 32 + (lane & 3) * 8), (LAS unsigned*)(lds + AP_V + vbuf * AP_VBUF + dh * AP_VDS + kb16 * 1024), 16, 0, 0); }
}
__device__ __forceinline__ void ap_load_q(const APUnit& u, const bf16* Qb, bf16x8 (&qr)[4], int wid, int lane) {
    const int r32 = lane & 31, hi = lane >> 5;
    const size_t qrow = (size_t)u.b * SEQ + (size_t)(u.r + u.d * (256 * u.blk + 32 * wid + r32));
#pragma unroll
    for (int ks = 0; ks < 4; ++ks) qr[ks] = *(const bf16x8*)(Qb + qrow * 512 + u.h * 64 + 16 * ks + 8 * hi);
}
__device__ __forceinline__ void attn_prompt_phase(const Args& a, LAS unsigned char* lds, int bx, int G, int n_units, int tid, int wid, int lane) {
    unsigned char* ws = a.ws;
    const bf16* Qb = (const bf16*)(ws + WS_Q); const bf16* Kb = (const bf16*)(ws + WS_K); const bf16* Vb = (const bf16*)(ws + WS_V);
    bf16* OP = (bf16*)(ws + WS_OP); float* LSE = (float*)(ws + WS_LSE);
    const int r32 = lane & 31, hi = lane >> 5;
    if (bx >= n_units) return;
    APUnit cur = ap_decode(bx);
    bf16x8 qn[4];
    ap_issue_k(cur, Kb, lds, wid, lane); ap_issue_v(cur, Vb, lds, 0, wid, lane); ap_load_q(cur, Qb, qn, wid, lane);
    int vb_i = 0;
#pragma unroll 1
    for (int unit = bx; unit < n_units; unit += G, vb_i ^= 1) {
        const bool has_next = unit + G < n_units;
        APUnit nxt = cur; if (has_next) nxt = ap_decode(unit + G);
        asm volatile("s_waitcnt vmcnt(0)" ::: "memory"); __syncthreads();
        if (has_next) ap_issue_v(nxt, Vb, lds, vb_i ^ 1, wid, lane);
        bf16x8 qr[4];
#pragma unroll
        for (int ks = 0; ks < 4; ++ks) qr[ks] = qn[ks];
        const int kt0 = (cur.blk == 0 && wid < 4) ? 4 - wid : 0;
        f32x16 pt[5];
#pragma unroll
        for (int kt = 0; kt < 5; ++kt) {
            if (kt >= kt0) {
                const int T = wid + kt; f32x16 acc = f32x16{};
#pragma unroll
                for (int ks = 0; ks < 4; ++ks) { const bf16x8 kf = *(const LAS bf16x8*)(lds + AP_K + (2 * ks + hi) * AP_KCS + (32 * T + r32) * 16);
                    acc = __builtin_amdgcn_mfma_f32_32x32x16_bf16(kf, qr[ks], acc, 0, 0, 0); }
                if (kt == 0) {
#pragma unroll
                    for (int rg = 0; rg < 16; ++rg) if (crow(rg, hi) < r32) acc[rg] = -INFINITY; }
                if (kt == 4) {
#pragma unroll
                    for (int rg = 0; rg < 16; ++rg) if (crow(rg, hi) > r32) acc[rg] = -INFINITY; }
                pt[kt] = acc;
            } else {
#pragma unroll
                for (int rg = 0; rg < 16; ++rg) pt[kt][rg] = -INFINITY;
            }
        }
        asm volatile("s_waitcnt lgkmcnt(0)" ::: "memory"); __syncthreads();
        if (has_next) { ap_issue_k(nxt, Kb, lds, wid, lane); ap_load_q(nxt, Qb, qn, wid, lane); }
        float mx = -INFINITY;
#pragma unroll
        for (int kt = 0; kt < 5; ++kt)
#pragma unroll
            for (int rg = 0; rg < 16; ++rg) mx = fmaxf(mx, pt[kt][rg]);
        mx = fmaxf(mx, __shfl_xor(mx, 32));
        float lsum = 0.f;
#pragma unroll
        for (int kt = 0; kt < 5; ++kt)
#pragma unroll
            for (int rg = 0; rg < 16; ++rg) { const float e = __builtin_amdgcn_exp2f(pt[kt][rg] - mx); pt[kt][rg] = e; lsum += e; }
        lsum += __shfl_xor(lsum, 32);
        f32x16 o[2]; o[0] = f32x16{}; o[1] = f32x16{};
        const LAS unsigned char* vb = lds + AP_V + vb_i * AP_VBUF + ((lane >> 4) & 1) * 32 + (lane & 3) * 8 + (4 * hi + ((lane & 15) >> 2)) * 64;
#pragma unroll
        for (int kt = 0; kt < 5; ++kt) {
            if (kt >= kt0) {
                const int T = wid + kt;
#pragma unroll
                for (int s2 = 0; s2 < 2; ++s2) {
                    v4u pw; pw.x = pg8::cvt_pk_bf16(pt[kt][8 * s2], pt[kt][8 * s2 + 1]); pw.y = pg8::cvt_pk_bf16(pt[kt][8 * s2 + 2], pt[kt][8 * s2 + 3]);
                    pw.z = pg8::cvt_pk_bf16(pt[kt][8 * s2 + 4], pt[kt][8 * s2 + 5]); pw.w = pg8::cvt_pk_bf16(pt[kt][8 * s2 + 6], pt[kt][8 * s2 + 7]);
                    const bf16x8 pa = __builtin_bit_cast(bf16x8, pw);
#pragma unroll
                    for (int d0 = 0; d0 < 2; ++d0) {
                        const LAS unsigned char* vp = vb + d0 * AP_VDS + (32 * T + 16 * s2) * 64;
                        const s16x4 lo = vtr(vp), hh = vtr(vp + 512);
                        const bf16x8 vf = (bf16x8){lo[0], lo[1], lo[2], lo[3], hh[0], hh[1], hh[2], hh[3]};
                        o[d0] = __builtin_amdgcn_mfma_f32_32x32x16_bf16(pa, vf, o[d0], 0, 0, 0);
                    }
                }
            }
        }
        LAS float* wsf = (LAS float*)(lds + AP_WS) + wid * 64;
        if (hi == 0) wsf[r32] = __builtin_amdgcn_rcpf(lsum);
        const size_t rowb = (size_t)cur.b * SEQ;
        const size_t qrow_l = rowb + (size_t)(cur.r + cur.d * (256 * cur.blk + 32 * wid + r32));
        if (hi == 0) LSE[((size_t)cur.p * MP + qrow_l) * 8 + cur.h] = mx + __builtin_amdgcn_logf(lsum);
        LDS_WAIT(); asm volatile("" ::: "memory");
#pragma unroll
        for (int rg = 0; rg < 16; ++rg) {
            const int qi = crow(rg, hi); const float rl = wsf[qi];
            const size_t orow = rowb + (size_t)(cur.r + cur.d * (256 * cur.blk + 32 * wid + qi));
            bf16* op = OP + ((size_t)cur.p * MP + orow) * 512 + cur.h * 64 + r32;
            { const unsigned w2 = pk2(o[0][rg] * rl, o[1][rg] * rl); op[0] = (bf16)(w2 & 0xffffu); op[32] = (bf16)(w2 >> 16); }
        }
        cur = nxt;
    }
    asm volatile("s_waitcnt vmcnt(0) lgkmcnt(0)" ::: "memory"); __syncthreads();
}

__device__ __forceinline__ void attn_sample_item(const Args& a, int item, LAS unsigned char* lds, int tid, int wid, int lane) {
    unsigned char* ws = a.ws;
    const float* QS = (const float*)(ws + WS_QS); bf16* MIX = (bf16*)(ws + WS_MIX);
    const float* CK = a.in[I_CK]; const float* CV = a.in[I_CV];
    asm volatile("" : "+v"(lane));
    const int n = item >> 3, h = item & 7, sub = lane & 15, grp = lane >> 4;
    f32x4 q[4];
#pragma unroll
    for (int s = 0; s < 4; ++s) q[s] = *(const f32x4*)(QS + (size_t)(4 * n + s) * 512 + h * 64 + 4 * sub);
    float m[4], l[4]; f32x4 O[4];
#pragma unroll
    for (int s = 0; s < 4; ++s) { m[s] = -1e30f; l[s] = 0.f; O[s] = (f32x4){0.f, 0.f, 0.f, 0.f}; }
#define SA_ROW(t_) (((t_) < 16) ? 1536 + (t_) * 32 + wid * 4 + grp : 16 * ((((t_) - 16) * 32 + wid * 4 + grp) >> 2) + (grp & 3))
#define SA_OFF(idx_) ((((size_t)n * 2048 + (idx_)) * 8 + h) * 64 + 4 * sub)
    const f32x4 qo = grp == 0 ? q[0] : grp == 1 ? q[1] : grp == 2 ? q[2] : q[3];
    const float cown = (wid & 3) == 0 ? 2.f : 1.f;
    float mo = -1e30f, lo = 0.f; f32x4 Oo = (f32x4){0.f, 0.f, 0.f, 0.f};
    LAS unsigned char* ring = lds + wid * 16384;
#define SA_DMA(j_) do { const int t_ = (j_) < 12 ? (j_) : (j_) + 4; const size_t o_ = SA_OFF(SA_ROW(t_)); \
        __builtin_amdgcn_global_load_lds((const unsigned*)(CK + o_), (LAS unsigned*)(ring + ((j_) & 7) * 2048), 16, 0, 2); \
        __builtin_amdgcn_global_load_lds((const unsigned*)(CV + o_), (LAS unsigned*)(ring + ((j_) & 7) * 2048 + 1024), 16, 0, 2); } while (0)
#pragma unroll
    for (int j = 0; j < 8; ++j) SA_DMA(j);
#define SA_GEN(NU, kv, vv, idxs) do { float d[NU][4]; int c[NU][4]; \
        _Pragma("unroll") for (int u = 0; u < NU; ++u) { const int idx = idxs[u]; \
            _Pragma("unroll") for (int s = 0; s < 4; ++s) { \
                float dt = (q[s][0] * kv[u][0] + q[s][1] * kv[u][1]) + (q[s][2] * kv[u][2] + q[s][3] * kv[u][3]); \
                dt += dpp_f(dt, 0xB1); dt += dpp_f(dt, 0x4E); dt += dpp_f(dt, 0x141); dt += dpp_f(dt, 0x140); \
                int cc; \
                if (idx < 2048) cc = (idx >= 1920 + s ? 1 : 0) + ((idx >= 1536 && (idx & 3) == s) ? 1 : 0) + ((idx & 15) == s ? 1 : 0); \
                else { const int sp = idx - 2048; cc = (s >= sp ? 1 : 0) + (s == sp ? 2 : 0); } \
                if (idx < 0) cc = 0; \
                d[u][s] = dt; c[u][s] = cc; } } \
        _Pragma("unroll") for (int s = 0; s < 4; ++s) { float mn = m[s]; \
            _Pragma("unroll") for (int u = 0; u < NU; ++u) mn = c[u][s] > 0 ? fmaxf(mn, d[u][s]) : mn; \
            const float sc = __builtin_amdgcn_exp2f(m[s] - mn); l[s] *= sc; O[s] = O[s] * sc; m[s] = mn; \
            _Pragma("unroll") for (int u = 0; u < NU; ++u) { const float pe = (float)c[u][s] * __builtin_amdgcn_exp2f(fminf(d[u][s] - mn, 0.f)); l[s] += pe; O[s] = O[s] + vv[u] * pe; } } } while (0)
    {
        f32x4 kv[4], vv[4]; int idxs[4];
#pragma unroll
        for (int u = 0; u < 4; ++u) { idxs[u] = SA_ROW(12 + u); const size_t o_ = SA_OFF(idxs[u]); kv[u] = *(const f32x4*)(CK + o_); vv[u] = *(const f32x4*)(CV + o_); }
        f32x4 kn[1], vn[1]; int idn[1];
        { const size_t o_ = (size_t)(n * 4 + grp) * 512 + h * 64 + 4 * sub; kn[0] = *(const f32x4*)(a.out + O_SWK + o_); vn[0] = *(const f32x4*)(a.out + O_SWV + o_); idn[0] = wid == 0 ? 2048 + grp : -1; }
        SA_GEN(4, kv, vv, idxs);
        asm volatile("" ::: "memory");
        SA_GEN(1, kn, vn, idn);
    }
#pragma unroll 1
    for (int b = 0; b < 6; ++b) {
        f32x4 kv[4], vv[4];
#pragma unroll
        for (int u = 0; u < 4; ++u) { const int j = 4 * b + u;
            asm volatile("s_waitcnt vmcnt(14)" ::: "memory");
            kv[u] = *(const LAS f32x4*)(ring + (j & 7) * 2048 + lane * 16); vv[u] = *(const LAS f32x4*)(ring + (j & 7) * 2048 + 1024 + lane * 16);
            asm volatile("s_waitcnt lgkmcnt(0)" ::: "memory");
            SA_DMA(j + 8 < 24 ? j + 8 : 23); }
        const float cm = b < 3 ? cown : 1.f;
        float d[4];
#pragma unroll
        for (int u = 0; u < 4; ++u) { float dt = (qo[0] * kv[u][0] + qo[1] * kv[u][1]) + (qo[2] * kv[u][2] + qo[3] * kv[u][3]);
            dt += dpp_f(dt, 0xB1); dt += dpp_f(dt, 0x4E); dt += dpp_f(dt, 0x141); dt += dpp_f(dt, 0x140); d[u] = dt; }
        const float mn = fmaxf(fmaxf(mo, fmaxf(d[0], d[1])), fmaxf(d[2], d[3]));
        const float sc = __builtin_amdgcn_exp2f(mo - mn); lo *= sc; Oo = Oo * sc; mo = mn;
#pragma unroll
        for (int u = 0; u < 4; ++u) { const float pe = cm * __builtin_amdgcn_exp2f(d[u] - mn); lo += pe; Oo = Oo + vv[u] * pe; }
    }
    asm volatile("s_waitcnt vmcnt(0)" ::: "memory");
#undef SA_DMA
#define SA_LD4(x)
#undef SA_LD4
#pragma unroll
    for (int s = 0; s < 4; ++s) if (grp == s) { const float mn = fmaxf(m[s], mo), sa = __builtin_amdgcn_exp2f(m[s] - mn), sb = __builtin_amdgcn_exp2f(mo - mn); l[s] = l[s] * sa + lo * sb; O[s] = O[s] * sa + Oo * sb; m[s] = mn; }
#undef SA_GEN
#undef SA_ROW
#undef SA_OFF
#pragma unroll
    for (int s = 0; s < 4; ++s)
#pragma unroll
        for (int off = 16; off <= 32; off <<= 1) {
            const float mo = __shfl_xor(m[s], off), lo = __shfl_xor(l[s], off);
            f32x4 Oo; Oo[0] = __shfl_xor(O[s][0], off); Oo[1] = __shfl_xor(O[s][1], off); Oo[2] = __shfl_xor(O[s][2], off); Oo[3] = __shfl_xor(O[s][3], off);
            const float mn = fmaxf(m[s], mo); const float sa = (m[s] == mn) ? 1.f : __builtin_amdgcn_exp2f(m[s] - mn), sb = (mo == mn) ? 1.f : __builtin_amdgcn_exp2f(mo - mn);
            l[s] = l[s] * sa + lo * sb; O[s] = O[s] * sa + Oo * sb; m[s] = mn;
        }
    LAS float* red = (LAS float*)(lds + 131072);
    if (grp == 0) {
#pragma unroll
        for (int s = 0; s < 4; ++s) { LAS float* rp = red + (wid * 4 + s) * 68; *(LAS f32x4*)(rp + 4 * sub) = O[s]; if (sub == 0) { rp[64] = m[s]; rp[65] = l[s]; } }
    }
    __syncthreads();
    if (tid < 256) { const int s = tid >> 6, dim = tid & 63; float mm = -1e30f;
#pragma unroll
        for (int w = 0; w < 8; ++w) mm = fmaxf(mm, red[(w * 4 + s) * 68 + 64]);
        float L = 0.f, Ov = 0.f;
#pragma unroll
        for (int w = 0; w < 8; ++w) { const LAS float* rp = red + (w * 4 + s) * 68; const float mw = rp[64]; const float f = __builtin_amdgcn_exp2f(mw - mm); L += rp[65] * f; Ov += rp[dim] * f; }
        MIX[(size_t)(MP + 4 * n + s) * DM + 512 + h * 64 + dim] = (bf16)f2bf(Ov / L); }
    __syncthreads();
}

__device__ __forceinline__ void combine_item(const Args& a, int item, int tid) {
    unsigned char* ws = a.ws;
    const bf16* OP = (const bf16*)(ws + WS_OP); const float* LSE = (const float*)(ws + WS_LSE); bf16* MIX = (bf16*)(ws + WS_MIX);
#pragma unroll 1
    for (int i0 = 0; i0 < 8; i0 += 4) {
        float l[4][3]; v4u xw[4][3];
#pragma unroll
        for (int i = 0; i < 4; ++i) { const int e = tid + NTHR * (i0 + i), row = item * 64 + (e >> 6), hc = e & 63, h = hc >> 3;
#pragma unroll
            for (int p = 0; p < 3; ++p) { l[i][p] = LSE[((size_t)p * MP + row) * 8 + h]; xw[i][p] = *(const v4u*)(OP + ((size_t)p * MP + row) * 512 + hc * 8); } }
#pragma unroll
        for (int i = 0; i < 4; ++i) { const int e = tid + NTHR * (i0 + i), row = item * 64 + (e >> 6), hc = e & 63;
            const float mx = fmaxf(l[i][0], fmaxf(l[i][1], l[i][2])); float w0 = __builtin_amdgcn_exp2f(l[i][0] - mx), w1 = __builtin_amdgcn_exp2f(l[i][1] - mx), w2 = __builtin_amdgcn_exp2f(l[i][2] - mx);
            const float inv = __builtin_amdgcn_rcpf(w0 + w1 + w2); w0 *= inv; w1 *= inv; w2 *= inv;
            float x0[8], x1[8], x2[8], y[8]; unpack8(xw[i][0], x0); unpack8(xw[i][1], x1); unpack8(xw[i][2], x2);
#pragma unroll
            for (int k = 0; k < 8; ++k) y[k] = w0 * x0[k] + w1 * x1[k] + w2 * x2[k];
            *(v4u*)(MIX + (size_t)row * DM + 512 + hc * 8) = pack8(y); }
    }
}

__device__ __forceinline__ void ffn_fixup_phase(const Args& a, int gt, int NGT) {
    unsigned char* ws = a.ws;
    const float* HEADU = (const float*)(ws + WS_HEADU); const float* HEADP = (const float*)(ws + WS_HEADP); const float* TAIL = (const float*)(ws + WS_TAIL); bf16* Hb = (bf16*)(ws + WS_H);
    const float* cw = a.in[I_CFW]; const float* cb = a.in[I_CFB];
    for (int e = gt; e < (MP / 256) * 2 * (DFF / 8); e += NGT) {
        const int pm = e / (2 * (DFF / 8)), rem = e % (2 * (DFF / 8)), j = rem / (DFF / 8), c = (rem % (DFF / 8)) * 8;
        if ((pm & 15) == 0) continue;
        float p2[8], p1[8], cur[8], up[8], w0[8], w1[8], w2[8], bb[8], y[8];
        load8_f32(TAIL + (size_t)((pm - 1) * 2 + j) * DFF + c, p2);
        if (j == 0) load8_f32(TAIL + (size_t)((pm - 1) * 2 + 1) * DFF + c, p1); else load8_f32(HEADU + (size_t)(pm * 2) * DFF + c, p1);
        load8_f32(HEADU + (size_t)(pm * 2 + j) * DFF + c, cur); load8_f32(HEADP + (size_t)(pm * 2 + j) * DFF + c, up);
        load8_f32(cw + c, w0); load8_f32(cw + DFF + c, w1); load8_f32(cw + 2 * DFF + c, w2); load8_f32(cb + c, bb);
#pragma unroll
        for (int i = 0; i < 8; ++i) { const float uc = bb[i] + w0[i] * p2[i] + w1[i] * p1[i] + w2[i] * cur[i]; y[i] = gelu_tanh(uc) * up[i]; }
        *(v4u*)(Hb + (size_t)(pm * 256 + j) * DFF + c) = pack8(y);
    }
}
__device__ __forceinline__ void final_norm_phase(const Args& a, int gw, int NGW, int lane, bool prompt_too) {
    float* Y = a.out + O_Y; const float* PART = (const float*)(a.ws + WS_PART); const GAS f32x4* gf = (const GAS f32x4*)a.in[I_GFIN] + lane;
    f32x4 g[4];
#pragma unroll
    for (int j = 0; j < 4; ++j) g[j] = gf[64 * j];
#pragma unroll 1
    for (int m0 = gw; prompt_too && m0 < MP; m0 += 4 * NGW) {
        f32x4 v[4][4];
#pragma unroll
        for (int q = 0; q < 4; ++q) { const int m = m0 + q * NGW; if (m < MP) { const GAS f32x4* yr = (const GAS f32x4*)(Y + (size_t)m * DM) + lane;
#pragma unroll
                for (int j = 0; j < 4; ++j) v[q][j] = yr[64 * j]; } }
#pragma unroll
        for (int q = 0; q < 4; ++q) { const int m = m0 + q * NGW; if (m < MP) { float ss = 0.f;
#pragma unroll
                for (int j = 0; j < 4; ++j) ss += (v[q][j].x * v[q][j].x + v[q][j].y * v[q][j].y) + (v[q][j].z * v[q][j].z + v[q][j].w * v[q][j].w);
                const float rs = 1.f / sqrtf(wave_sum(ss) * (1.f / DM) + EPS); GAS f32x4* yr = (GAS f32x4*)(Y + (size_t)m * DM) + lane;
#pragma unroll
                for (int j = 0; j < 4; ++j) yr[64 * j] = v[q][j] * rs * g[j]; } }
    }
    for (int r = gw; r < MS; r += NGW) {
        GAS f32x4* yr = (GAS f32x4*)(Y + (size_t)(MP + r) * DM) + lane; f32x4 v[4]; float ss = 0.f;
#pragma unroll
        for (int j = 0; j < 4; ++j) { v[j] = yr[64 * j];
#pragma unroll
            for (int sl = 0; sl < KSPLIT; ++sl) v[j] += ((const GAS f32x4*)(PART + ((size_t)sl * MS + r) * DM) + lane)[64 * j];
            ss += (v[j].x * v[j].x + v[j].y * v[j].y) + (v[j].z * v[j].z + v[j].w * v[j].w); }
        const float rs = 1.f / sqrtf(wave_sum(ss) * (1.f / DM) + EPS);
#pragma unroll
        for (int j = 0; j < 4; ++j) yr[64 * j] = v[j] * rs * g[j];
    }
}

__global__ void __launch_bounds__(NTHR, 2) hymba_fwd(Args args) {
    extern __shared__ __attribute__((aligned(16))) unsigned char lds_raw[];
    LAS unsigned char* lds = (LAS unsigned char*)lds_raw;
    volatile LAS unsigned* MISC = (volatile LAS unsigned*)(lds + MISC_OFF);
    const int tid = threadIdx.x, lane = tid & 63, wave = __builtin_amdgcn_readfirstlane(tid >> 6);
    const int G = gridDim.x, bx = blockIdx.x; const int vcu = (G % 8 == 0) ? (bx % 8) * (G / 8) + bx / 8 : bx;
    unsigned char* ws = args.ws;
    unsigned* ctl = (unsigned*)(ws + WS_CTL);
    for (int u = tid; u < (LDS_BYTES - LDSCTL_OFF) / 4; u += NTHR) ((LAS unsigned*)(lds + LDSCTL_OFF))[u] = 0u;
    __syncthreads();
    XcdBarrier bar; bar.bar = ctl + CW_BAR + args.li * XCD_BAR_WORDS; bar.x = 0; bar.st = nullptr;
    if (N_LAUNCH == 1) bar = xcd_barrier_post(ctl + CW_BAR + args.li * XCD_BAR_WORDS, MISC + 8);
    const int lo = args.ph_lo, hi = args.ph_hi;
#ifndef REP_MASK
#define REP_MASK 0
#endif
#define REPS(k) for (int rep_ = 0; rep_ < 1 + ((REP_MASK >> (k)) & 1); ++rep_)
#ifndef STAG1
#define STAG1 0
#endif
#ifndef STAG4
#define STAG4 0
#endif
#ifndef STAG7
#define STAG7 0
#endif
#ifndef STAG_G
#define STAG_G 3
#endif
#define STAGGER(ticks) do { if ((ticks) > 0) { const int g_ = (bx / 8) % STAG_G; if (g_) { const unsigned long long t0_ = rt(); while (rt() - t0_ < (unsigned long long)(g_ * (ticks))) __builtin_amdgcn_s_sleep(8); } } } while (0)
#ifndef IT_MASK
#define IT_MASK 63
#endif
#ifndef PH_MASK
#define PH_MASK 0x1ff
#endif
#define IN(k) (((PH_MASK >> (k)) & 1) && lo <= (k) && (k) < hi)
#define SEAM(k) do { if (N_LAUNCH == 1 && IN(k) && IN((k) + 1)) xcd_barrier(bar); } while (0)

    constexpr int NP1S = 2 * (DIN / 256);
    if (IN(0)) REPS(0) {
        const int ns = (G >= 4 * NP1S && N_LAUNCH == 1) ? NP1S : 0;
        p0_prologue(args, lds, tid, wave, lane, vcu, G, 0);
        if (N_LAUNCH == 1) xcd_barrier(bar);
        if (bx >= ns) p0_prologue(args, lds, tid, wave, lane, bx - ns, G - ns, 1);
        if (ns == 0 || bx < ns) {
            if (ns == 0) __syncthreads();
            pg8::Gemm g{(const bf16*)(ws + WS_XN), (const bf16*)(ws + WS_WIN), M, DIN, DM, DM}; SampleUnitOrder S{bx, ns ? ns : G};
            EpiZT<true> E{(const float*)(ws + WS_RS1), (const float*)(ws + WS_ROPE), (bf16*)(ws + WS_XA), (bf16*)(ws + WS_GA), (bf16*)(ws + WS_Q), (bf16*)(ws + WS_K), (bf16*)(ws + WS_V), (float*)(ws + WS_QS), args.out, (LAS float*)(lds + MISC_OFF + 256)};
            pg8::gemm_phase<EpiZT<true>, SampleUnitOrder, true, true>(lds, g, S, E);
        }
        SEAM(0);
    }

    if (IN(1)) REPS(1) {
        STAGGER(STAG1);
        pg8::Gemm g{(const bf16*)(ws + WS_XN), (const bf16*)(ws + WS_WIN), MP, DIN, DM, DM}; pg8::StaticOrder S; S.init(MP, DIN, G, bx);
        EpiZT<false> E{(const float*)(ws + WS_RS1), (const float*)(ws + WS_ROPE), (bf16*)(ws + WS_XA), (bf16*)(ws + WS_GA), (bf16*)(ws + WS_Q), (bf16*)(ws + WS_K), (bf16*)(ws + WS_V), (float*)(ws + WS_QS), args.out, (LAS float*)(lds + MISC_OFF + 256)};
        pg8::gemm_phase<EpiZT<false>, pg8::StaticOrder, true, true>(lds, g, S, E);
        SEAM(1);
    }
    if (IN(2)) REPS(2) {
        constexpr int NA = NB * NH * 48, NSA = NS * NH, NL = NB * 64;
        if (args.pad & 4) for (int it = bx; it < NL; it += G) lru_fused_item(args, it, lds, wave, lane);
        if (bx & 1) { if (args.pad & 2) for (int it = bx; it < NSA; it += G) attn_sample_item(args, it, lds, tid, wave, lane); }
        if (args.pad & 1) attn_prompt_phase(args, lds, bx, G, NA, tid, wave, lane);
        if (!(bx & 1)) { if (args.pad & 2) for (int it = bx; it < NSA; it += G) attn_sample_item(args, it, lds, tid, wave, lane); }
        SEAM(2);
    }
    if (IN(3)) REPS(3) {
        constexpr int NLS = MS / 64, NC = MP / 64;
        if (bx < NLS && G > NLS) lru_item<2>(args, bx, lds, wave, lane);
        else if (G > NLS) { for (int it = bx - NLS; it < NC; it += G - NLS) combine_item(args, it, tid); }
        else for (int it = bx; it < NLS + NC; it += G) { if (it < NLS) lru_item<2>(args, it, lds, wave, lane); else combine_item(args, it - NLS, tid); }
        SEAM(3);
    }
    if (IN(4)) REPS(4) {
        STAGGER(STAG4);
        { pg8::Gemm g{(const bf16*)(ws + WS_MIX), (const bf16*)(ws + WS_WOUT), MP, DM, DM, DM}; pg8::StaticOrder S; S.init(MP, DM, G, bx);
          EpiX1 E{args.in[I_XP], args.in[I_XS], args.out + O_Y, (bf16*)(ws + WS_X1B), (float*)(ws + WS_SSP)};
          pg8::gemm_phase<EpiX1, pg8::StaticOrder, true, true>(lds, g, S, E); }
        { pg8::Gemm g{(const bf16*)(ws + WS_MIX), (const bf16*)(ws + WS_WOUT), M, DM, DM / KSPLIT4, DM}; SplitOrder S{G, bx, KSPLIT4, DM / KSPLIT4};
          EpiPart E{(float*)(ws + WS_PART4), DM / KSPLIT4};
          pg8::gemm_phase<EpiPart, SplitOrder, true, true>(lds, g, S, E); }
        SEAM(4);
    }
    if (IN(5)) REPS(5) {
        finalize_x1_sample(args, bx, G, wave, lane);
        pg8::Gemm g{(const bf16*)(ws + WS_X1B), (const bf16*)(ws + WS_WGU), M, 2 * DFF, DM, DM}; GatedOrder S; S.init(M, 2 * DFF, G, bx); S.cnt = (const unsigned*)(ws + WS_CTL) + CW_CNT4; S.need = MS;
        EpiGU E{(const float*)(ws + WS_SSP), (bf16*)(ws + WS_H), args.in[I_CFW], args.in[I_CFB], args.in[I_SCF], args.out, (float*)(ws + WS_HEADU), (float*)(ws + WS_HEADP), (float*)(ws + WS_TAIL), (LAS float*)(lds + MISC_OFF + 256), (LAS float*)(lds + RING_BYTES)};
        pg8::gemm_phase<EpiGU, GatedOrder, true, true>(lds, g, S, E);
        SEAM(5);
    }
    if (IN(6)) REPS(6) {
        if (G == 256) {
            if (bx < 8 * KSPLIT) { pg8::Gemm g{(const bf16*)(ws + WS_H), (const bf16*)(ws + WS_WDN), M, DM, DFF / KSPLIT, DFF}; SplitOrder S{G, bx, KSPLIT, DFF / KSPLIT};
                EpiPart E{(float*)(ws + WS_PART), DFF / KSPLIT};
                pg8::gemm_phase<EpiPart, SplitOrder, true, true>(lds, g, S, E); }
            else ffn_fixup_phase(args, (bx - 8 * KSPLIT) * NTHR + tid, (G - 8 * KSPLIT) * NTHR);
        } else ffn_fixup_phase(args, vcu * NTHR + tid, G * NTHR);
        SEAM(6);
    }
    if (IN(7)) {
        STAGGER(STAG7);
        if (G == 256) {
            final_norm_phase(args, vcu * NWAVES + wave, G * NWAVES, lane, false);
            pg8::Gemm g{(const bf16*)(ws + WS_H), (const bf16*)(ws + WS_WDN), MP, DM, DFF, DFF};
            EpiX2F E{args.out + O_Y, (const bf16*)(ws + WS_X1B), args.in[I_GFIN], (float*)(ws + WS_XBUF), (unsigned*)(ws + WS_CTL) + CW_X2C};
            { OneUnitOrder S; S.init(MP, DM, G, bx); S.i0 = 0; pg8::gemm_phase<EpiX2F, OneUnitOrder, false, true>(lds, g, S, E); }
            __syncthreads();
            { OneUnitOrder S; S.init(MP, DM, G, bx); S.i0 = 1; pg8::gemm_phase<EpiX2F, OneUnitOrder, false, true>(lds, g, S, E); }
            __syncthreads();
        } else {
            pg8::Gemm g{(const bf16*)(ws + WS_H), (const bf16*)(ws + WS_WDN), MP, DM, DFF, DFF}; pg8::StaticOrder S; S.init(MP, DM, G, bx);
            EpiX2 E{args.out + O_Y, (const bf16*)(ws + WS_X1B)};
            pg8::gemm_phase<EpiX2, pg8::StaticOrder, true, true>(lds, g, S, E);
        }
        if (G != 256) { pg8::Gemm g{(const bf16*)(ws + WS_H), (const bf16*)(ws + WS_WDN), M, DM, DFF / KSPLIT, DFF}; SplitOrder S{G, bx, KSPLIT, DFF / KSPLIT};
          EpiPart E{(float*)(ws + WS_PART), DFF / KSPLIT};
          pg8::gemm_phase<EpiPart, SplitOrder, true, true>(lds, g, S, E); }
        if (G != 256) SEAM(7);
    }
    if (IN(8) && G != 256) final_norm_phase(args, vcu * NWAVES + wave, G * NWAVES, lane, true);
#undef IN
#undef SEAM
}

extern "C" void kernel_launch(void* const* d_in, const int* in_sizes, int n_in, void* d_out, int out_size, void* d_ws, size_t ws_size, hipStream_t stream) {
    static int grid = 0;
    if (grid == 0) {
        if (n_in != 24 || out_size != (int)O_END || ws_size < WS_END) { fprintf(stderr, "kernel_launch: unexpected shapes (n_in %d, out %d, ws %zu)\n", n_in, out_size, ws_size); grid = -1; return; }
        int dev = 0, cus = 0, per_cu = 0;
        if (hipGetDevice(&dev) != hipSuccess || hipDeviceGetAttribute(&cus, hipDeviceAttributeMultiprocessorCount, dev) != hipSuccess) { grid = -1; return; }
        if (hipFuncSetAttribute((const void*)hymba_fwd, hipFuncAttributeMaxDynamicSharedMemorySize, LDS_BYTES) != hipSuccess) { fprintf(stderr, "kernel_launch: hipFuncSetAttribute failed\n"); grid = -1; return; }
        if (hipOccupancyMaxActiveBlocksPerMultiprocessor(&per_cu, (const void*)hymba_fwd, NTHR, LDS_BYTES) != hipSuccess || per_cu < 1) fprintf(stderr, "kernel_launch: occupancy query reports %d blocks per CU\n", per_cu);
        (void)hipGetLastError();
        grid = cus;
    }
    if (grid < 0) return;
    if (hipMemsetAsync((char*)d_ws + WS_CTL, 0, CTL_ZERO_BYTES, stream) != hipSuccess) return;
    Args a{};
    for (int i = 0; i < 24; ++i) a.in[i] = (const float*)d_in[i];
    a.out = (float*)d_out; a.ws = (unsigned char*)d_ws; a.pad = 7;
#if defined(PROBE_PH)
    a.ph_lo = 0; a.ph_hi = PROBE_PH + 1; a.li = 0; hipLaunchKernelGGL(hymba_fwd, dim3(grid), dim3(NTHR), LDS_BYTES, stream, a);
    a.ph_lo = PROBE_PH; a.ph_hi = NPH; a.li = 1;
#if defined(PROBE_ITEMS)
    a.pad = PROBE_ITEMS; a.ph_hi = PROBE_PH + 1; hipLaunchKernelGGL(hymba_fwd, dim3(grid), dim3(NTHR), LDS_BYTES, stream, a); a.pad = 7; a.ph_lo = PROBE_PH + 1; a.ph_hi = NPH; a.li = 2;
#endif
    hipLaunchKernelGGL(hymba_fwd, dim3(grid), dim3(NTHR), LDS_BYTES, stream, a);
    return;
#endif
    if (N_LAUNCH == 1) { a.ph_lo = 0; a.ph_hi = NPH; hipLaunchKernelGGL(hymba_fwd, dim3(grid), dim3(NTHR), LDS_BYTES, stream, a); }
    else for (int k = 0; k < NPH; ++k) { a.ph_lo = k; a.ph_hi = k + 1; hipLaunchKernelGGL(hymba_fwd, dim3(grid), dim3(NTHR), LDS_BYTES, stream, a); }
}
```

```cpp
#include <hip/hip_runtime.h>
#include <cstdio>
#include <cstdint>
#include <cmath>
namespace pg8 {
#define PG8_LAS __attribute__((address_space(3)))
typedef unsigned short bf16_t;
typedef short bf16x8 __attribute__((ext_vector_type(8)));
typedef float f32x4 __attribute__((ext_vector_type(4)));
typedef unsigned u32x4 __attribute__((ext_vector_type(4)));
constexpr int BM = 256, BK = 64, HALF = 128, HTB = HALF * BK * 2  , STAGE_BYTES = 8 * HTB, NXCD = 8, WGM = 8;

__host__ __device__ __forceinline__ int lds_byte(int r, int c) { const int st = (r >> 4) * 2 + (c >> 5), rr = r & 15, cc = c & 31, ob = rr * 64 + cc * 2; return st * 1024 + (ob ^ (((ob >> 9) & 1) << 5)); }
__host__ __device__ __forceinline__ void stage_rc(int b, int& R, int& C) { const int st = b / 1024, sb = b % 1024, swz = sb ^ (((sb >> 9) & 1) << 5); R = (st >> 1) * 16 + swz / 64; C = (st & 1) * 32 + (swz % 64) / 2; }
__host__ __device__ __forceinline__ int perm32(int rho) { const int n = rho >> 4, i = rho & 15; return 8 * (i >> 2) + 4 * n + (i & 3); }

struct Unit { int pm, pn, ko; };
struct Gemm { const bf16_t* A; const bf16_t* Bt; int M, N, K, ld; };

struct StaticOrder {
    int nM, nN, nwg, G, c;
    __host__ __device__ void init(int M, int N, int G_, int c_) { nM = M / BM; nN = N / BM; nwg = nM * nN; G = G_; c = c_; }
    __host__ __device__ bool next(int i, Unit& u) const {
        const long L = (long)i * G + c; if (L >= nwg) return false;
        int wgid = (int)L; { const int q = nwg / NXCD, r = nwg % NXCD, xcd = wgid % NXCD, off = wgid / NXCD; wgid = (xcd < r ? xcd * (q + 1) : r * (q + 1) + (xcd - r) * q) + off; }
        const int nig = WGM * nN, gid = wgid / nig, fm = gid * WGM, gsz = (nM - fm) < WGM ? (nM - fm) : WGM;
        u.pm = fm + ((wgid % nig) % gsz); u.pn = (wgid % nig) / gsz; u.ko = 0; return true;
    }
    __device__ __forceinline__ void a_ready(const Unit&) const {}
    __device__ __forceinline__ void done(const Unit&) const {}
};

__device__ __forceinline__ unsigned cvt_pk_bf16(float lo, float hi) { unsigned r; asm volatile("v_cvt_pk_bf16_f32 %0, %1, %2" : "=v"(r) : "v"(lo), "v"(hi)); return r; }
template <class Epi, class Sched, bool ALIGN_EPI = false, bool SP2 = false>
__device__ __forceinline__ void gemm_phase(PG8_LAS unsigned char* lds, const Gemm g, const Sched& S, const Epi& E) {
    const int tid = threadIdx.x, wid = __builtin_amdgcn_readfirstlane(tid >> 6), lane = tid & 63, wr = wid >> 2, wc = wid & 3, fr = lane & 15, fq = lane >> 4;
    const int K = g.K, nt = K / BK;
    unsigned voffA[2], voffB[2];
#pragma unroll
    for (int i = 0; i < 2; ++i) { int R, C; stage_rc(tid * 16 + i * 8192, R, C); const int Rb = Epi::PERM ? ((R & ~31) + perm32(R & 31)) : R;
        voffA[i] = (unsigned)(R * g.ld + C) * 2u; voffB[i] = (unsigned)(Rb * g.ld + C) * 2u; }
    const size_t kstep = (size_t)(BK * 2);
    const size_t hstep = (size_t)HALF * g.ld * 2;
    const size_t tstep = 2 * hstep;
    const unsigned ldsw = (unsigned)wid * 1024u;
    const int aoff = lds_byte(wr * 64 + fr, fq * 8), boff = lds_byte(wc * 32 + fr, fq * 8);
#define PG8_SA(b, h) (((b) * 2 + (h)) * HTB)
#define PG8_SB(b, h) ((4 + (b) * 2 + (h)) * HTB)
#define PG8_STAGE(bufoff, gbase, voff) do { _Pragma("unroll") for (int _i = 0; _i < 2; ++_i) \
        __builtin_amdgcn_global_load_lds((const unsigned*)((const char*)(gbase) + (voff)[_i]), (PG8_LAS unsigned*)(lds + (bufoff) + ldsw + _i * 8192), 16, 0, 0); } while (0)
#define PG8_LDA(dst, b, h) do { _Pragma("unroll") for (int m = 0; m < 4; ++m) _Pragma("unroll") for (int k = 0; k < 2; ++k) dst[m][k] = *(const PG8_LAS bf16x8*)(lds + PG8_SA(b, h) + aoff + m * 2048 + k * 1024); } while (0)
#define PG8_LDB(dst, b, h) do { _Pragma("unroll") for (int n = 0; n < 2; ++n) _Pragma("unroll") for (int k = 0; k < 2; ++k) dst[n][k] = *(const PG8_LAS bf16x8*)(lds + PG8_SB(b, h) + boff + n * 2048 + k * 1024); } while (0)
#define PG8_MMA(ai, bj, At, Bt) do { __builtin_amdgcn_s_setprio(1); _Pragma("unroll") for (int m = 0; m < 4; ++m) _Pragma("unroll") for (int n = 0; n < 2; ++n) _Pragma("unroll") for (int k = 0; k < 2; ++k) \
        acc[ai][bj][m][n] = __builtin_amdgcn_mfma_f32_16x16x32_bf16(Bt[n][k], At[m][k], acc[ai][bj][m][n], 0, 0, 0); __builtin_amdgcn_s_setprio(0); } while (0)
#define PG8_WAIT_V(n) asm volatile("s_waitcnt vmcnt(" #n ")" ::: "memory")
#define PG8_WAIT_L(n) asm volatile("s_waitcnt lgkmcnt(" #n ")" ::: "memory")
#define PG8_BAR __builtin_amdgcn_s_barrier()
#define PG8_SCHED __builtin_amdgcn_sched_barrier(0)
    Unit cur, nxt; int ui = 0;
    if (!S.next(0, cur)) return;
    f32x4 acc[2][2][4][2];
#pragma unroll
    for (int a = 0; a < 2; ++a)
#pragma unroll
        for (int b = 0; b < 2; ++b)
#pragma unroll
            for (int m = 0; m < 4; ++m)
#pragma unroll
                for (int n = 0; n < 2; ++n) acc[a][b][m][n] = (f32x4){0.f, 0.f, 0.f, 0.f};
    bf16x8 At[4][2], B0[2][2], B1[2][2];
    const char* cA = (const char*)g.A + (size_t)cur.pm * tstep + (size_t)cur.ko * 2; const char* cB = (const char*)g.Bt + (size_t)cur.pn * tstep + (size_t)cur.ko * 2;
    S.a_ready(cur); E.pre(cur, 0, tid);
    if constexpr (SP2) {
        PG8_STAGE(PG8_SB(0, 0), cB, voffB); PG8_STAGE(PG8_SB(0, 1), cB + hstep, voffB); PG8_STAGE(PG8_SA(0, 0), cA, voffA); PG8_STAGE(PG8_SA(0, 1), cA + hstep, voffA);
        if (wr == 1) PG8_BAR;
        PG8_WAIT_V(2); PG8_BAR;
        PG8_STAGE(PG8_SB(1, 0), cB + kstep, voffB); PG8_STAGE(PG8_SA(1, 0), cA + kstep, voffA); PG8_STAGE(PG8_SB(1, 1), cB + hstep + kstep, voffB);
        PG8_WAIT_V(6); PG8_BAR;
    } else {
        PG8_STAGE(PG8_SB(0, 0), cB, voffB); PG8_STAGE(PG8_SA(0, 0), cA, voffA); PG8_STAGE(PG8_SB(0, 1), cB + hstep, voffB); PG8_STAGE(PG8_SA(0, 1), cA + hstep, voffA);
        if (wr == 1) PG8_BAR;
        PG8_WAIT_V(4); PG8_BAR;
        PG8_STAGE(PG8_SB(1, 0), cB + kstep, voffB); PG8_STAGE(PG8_SA(1, 0), cA + kstep, voffA); PG8_STAGE(PG8_SB(1, 1), cB + hstep + kstep, voffB);
        PG8_WAIT_V(6); PG8_BAR;
    }
    for (;;) {
        const bool has_next = S.next(ui + 1, nxt);
        const char* nA = has_next ? (const char*)g.A + (size_t)nxt.pm * tstep + (size_t)nxt.ko * 2 : cA; const char* nB = has_next ? (const char*)g.Bt + (size_t)nxt.pn * tstep + (size_t)nxt.ko * 2 : cB;
        for (int t = 0; t < nt; t += 2) {
            const bool last = (t == nt - 2);
            const char* a1 = cA + (size_t)(t + 1) * kstep;
            const char* a2 = last ? nA : cA + (size_t)(t + 2) * kstep; const char* b2 = last ? nB : cB + (size_t)(t + 2) * kstep;
            const char* a3 = a2 + kstep; const char* b3 = b2 + kstep;
            if (last && has_next) { S.a_ready(nxt); E.pre(nxt, (ui + 1) & 1, tid); }
            if constexpr (SP2) {
            PG8_LDB(B0, 0, 0); PG8_LDB(B1, 0, 1); PG8_SCHED; PG8_LDA(At, 0, 0); PG8_STAGE(PG8_SA(1, 1), a1 + hstep, voffA);
            PG8_WAIT_V(8); PG8_WAIT_L(0); PG8_BAR; PG8_MMA(0, 0, At, B0); PG8_MMA(0, 1, At, B1); PG8_BAR; PG8_SCHED;
            PG8_LDA(At, 0, 1); PG8_STAGE(PG8_SB(0, 0), b2, voffB); PG8_STAGE(PG8_SB(0, 1), b2 + hstep, voffB); PG8_STAGE(PG8_SA(0, 0), a2, voffA);
            PG8_WAIT_V(8); PG8_WAIT_L(0); PG8_BAR; PG8_MMA(1, 0, At, B0); PG8_MMA(1, 1, At, B1); PG8_BAR; PG8_SCHED;
            PG8_LDB(B0, 1, 0); PG8_LDB(B1, 1, 1); PG8_SCHED; PG8_LDA(At, 1, 0); PG8_STAGE(PG8_SA(0, 1), a2 + hstep, voffA);
            PG8_WAIT_V(8); PG8_WAIT_L(0); PG8_BAR; PG8_MMA(0, 0, At, B0); PG8_MMA(0, 1, At, B1); PG8_BAR; PG8_SCHED;
            PG8_LDA(At, 1, 1); PG8_STAGE(PG8_SB(1, 0), b3, voffB); PG8_STAGE(PG8_SB(1, 1), b3 + hstep, voffB); PG8_STAGE(PG8_SA(1, 0), a3, voffA);
            PG8_WAIT_V(8); PG8_WAIT_L(0); PG8_BAR; PG8_MMA(1, 0, At, B0); PG8_MMA(1, 1, At, B1); PG8_BAR; PG8_SCHED;
            } else {
            PG8_LDB(B0, 0, 0); PG8_SCHED; PG8_LDA(At, 0, 0); PG8_STAGE(PG8_SA(1, 1), a1 + hstep, voffA);
            PG8_WAIT_L(8); PG8_BAR; PG8_WAIT_L(0); PG8_MMA(0, 0, At, B0); PG8_BAR; PG8_SCHED;
            PG8_LDB(B1, 0, 1); PG8_STAGE(PG8_SB(0, 0), b2, voffB);
            PG8_BAR; PG8_WAIT_L(0); PG8_MMA(0, 1, At, B1); PG8_BAR;
            PG8_LDA(At, 0, 1); PG8_STAGE(PG8_SA(0, 0), a2, voffA);
            PG8_BAR; PG8_WAIT_L(0); PG8_MMA(1, 0, At, B0); PG8_BAR; PG8_SCHED;
            PG8_STAGE(PG8_SB(0, 1), b2 + hstep, voffB);
            PG8_WAIT_V(6); PG8_BAR; PG8_MMA(1, 1, At, B1); PG8_BAR;
            PG8_LDB(B0, 1, 0); PG8_SCHED; PG8_LDA(At, 1, 0); PG8_STAGE(PG8_SA(0, 1), a2 + hstep, voffA);
            PG8_WAIT_L(8); PG8_BAR; PG8_WAIT_L(0); PG8_MMA(0, 0, At, B0); PG8_BAR; PG8_SCHED;
            PG8_LDB(B1, 1, 1); PG8_STAGE(PG8_SB(1, 0), b3, voffB);
            PG8_BAR; PG8_WAIT_L(0); PG8_MMA(0, 1, At, B1); PG8_BAR;
            PG8_LDA(At, 1, 1); PG8_STAGE(PG8_SA(1, 0), a3, voffA);
            PG8_BAR; PG8_WAIT_L(0); PG8_MMA(1, 0, At, B0); PG8_BAR; PG8_SCHED;
            PG8_STAGE(PG8_SB(1, 1), b3 + hstep, voffB);
            PG8_WAIT_V(6); PG8_BAR; PG8_MMA(1, 1, At, B1); PG8_BAR;
            }
        }
        if constexpr (ALIGN_EPI) { if (wr == 0) PG8_BAR; }
        if constexpr (!Epi::AFTER_DRAIN) { E(acc, cur, wr, wc, fr, fq, ui & 1); S.done(cur); }
        if (!has_next) break;
#pragma unroll
        for (int a = 0; a < 2; ++a)
#pragma unroll
            for (int b = 0; b < 2; ++b)
#pragma unroll
                for (int m = 0; m < 4; ++m)
#pragma unroll
                    for (int n = 0; n < 2; ++n) acc[a][b][m][n] = (f32x4){0.f, 0.f, 0.f, 0.f};
        cur = nxt; cA = nA; cB = nB; ++ui;
        if constexpr (ALIGN_EPI) { if (wr == 1) PG8_BAR; }
    }
    PG8_WAIT_V(0);
    if constexpr (!ALIGN_EPI) { if (wr == 0) PG8_BAR; }
    PG8_BAR;
    if constexpr (Epi::AFTER_DRAIN) { E.fused(acc, cur, wr, wc, fr, fq, lds, wid, lane); S.done(cur); }
#undef PG8_SA
#undef PG8_SB
#undef PG8_STAGE
#undef PG8_LDA
#undef PG8_LDB
#undef PG8_MMA
#undef PG8_WAIT_V
#undef PG8_WAIT_L
#undef PG8_BAR
#undef PG8_SCHED
}
}
#define GAS __attribute__((address_space(1)))
#define LAS __attribute__((address_space(3)))
typedef unsigned short bf16;
typedef unsigned v4u __attribute__((ext_vector_type(4)));
typedef float f32x4 __attribute__((ext_vector_type(4)));
typedef float f32x2 __attribute__((ext_vector_type(2)));
typedef short bf16x8 __attribute__((ext_vector_type(8)));
typedef GAS unsigned gu32;
typedef GAS unsigned long long gu64;
#define RLX_AGENT __ATOMIC_RELAXED, __HIP_MEMORY_SCOPE_AGENT
#define LDS_WAIT() asm volatile("s_waitcnt lgkmcnt(0)" ::: "memory")
#define VM_WAIT() asm volatile("s_waitcnt vmcnt(0)" ::: "memory")
__device__ __forceinline__ unsigned long long rt() { return __builtin_amdgcn_s_memrealtime(); }
__device__ __forceinline__ unsigned f2bf(float f) { unsigned u = __builtin_bit_cast(unsigned, f); return (u + 0x7fffu + ((u >> 16) & 1u)) >> 16; }
__device__ __forceinline__ unsigned pk2(float lo, float hi) { unsigned r; asm("v_cvt_pk_bf16_f32 %0, %1, %2" : "=v"(r) : "v"(lo), "v"(hi)); return r; }

#define XB_TMO      128
#define XB_XCNT(j)  (256  + 64 * (j))
#define XB_XSUB(j)  (1280 + 64 * (j))
#define XB_XGEN(j)  (2304 + 64 * (j))
#define XB_TOP      3328
#define XB_TOPGEN   3392
#define XCD_BAR_WORDS 3456
#define XB_SPIN_CAP (1u << 18)

__device__ __forceinline__ unsigned xb_ld(unsigned* p)              { return __hip_atomic_load(p, __ATOMIC_RELAXED, __HIP_MEMORY_SCOPE_AGENT); }
__device__ __forceinline__ unsigned xb_add(unsigned* p, unsigned v) { return __hip_atomic_fetch_add(p, v, __ATOMIC_RELAXED, __HIP_MEMORY_SCOPE_AGENT); }
__device__ __forceinline__ unsigned xb_xcc_id() { return (unsigned)__builtin_amdgcn_s_getreg((3 << 11) | 20) & 0xFu; }
#define XB_SPIN(cond, bar) do { unsigned _sp = 0; while (cond) { __builtin_amdgcn_s_sleep(1); \
    if ((++_sp & 255u) == 0u) { if (xb_ld(&(bar)[XB_TMO])) break; if (_sp > XB_SPIN_CAP) { atomicAdd(&(bar)[XB_TMO], 1u); break; } } } } while (0)

struct XcdBarrier {
    unsigned* bar; unsigned x;
    volatile LAS unsigned* st;
};

__device__ __forceinline__ XcdBarrier xcd_barrier_post(unsigned* bar, volatile LAS unsigned* st) {
    XcdBarrier b; b.bar = bar; b.x = xb_xcc_id(); b.st = st;
    if (threadIdx.x == 0) (void)xb_add(&bar[XB_XCNT(b.x)], 1u);
    return b;
}
__device__ __forceinline__ void xcd_barrier_complete(unsigned* bar, unsigned x, unsigned& nloc, unsigned& nx) {
    const unsigned G = gridDim.x * gridDim.y * gridDim.z;
    unsigned sum, cnt, mine, sp = 0u;
    for (;;) {
        sum = 0u; cnt = 0u; mine = 0u;
#pragma unroll
        for (unsigned j = 0; j < 16; ++j) { const unsigned c = xb_ld(&bar[XB_XCNT(j)]); sum += c; cnt += (c > 0u) ? 1u : 0u; mine = (j == x) ? c : mine; }
        if (sum == G) break;
        __builtin_amdgcn_s_sleep(1);
        if ((++sp & 255u) == 0u) { if (xb_ld(&bar[XB_TMO])) break; if (sp > XB_SPIN_CAP) { atomicAdd(&bar[XB_TMO], 1u); break; } }
    }
    nloc = mine > 0u ? mine : 1u; nx = cnt > 0u ? cnt : 1u;
}

__device__ __forceinline__ void xcd_barrier(const XcdBarrier& b) {
    asm volatile("s_waitcnt vmcnt(0)" ::: "memory");
    __syncthreads();
    if (threadIdx.x == 0) {
        unsigned* bar = b.bar;
        __builtin_amdgcn_s_waitcnt(0);
        unsigned nloc = b.st[0], nx = b.st[1];
        if (nloc == 0u) { xcd_barrier_complete(bar, b.x, nloc, nx); b.st[0] = nloc; b.st[1] = nx; }
        const unsigned old = xb_add(&bar[XB_XSUB(b.x)], 1u);
        const unsigned gen = old / nloc;
        if (old + 1u == (gen + 1u) * nloc) {
            __builtin_amdgcn_fence(__ATOMIC_RELEASE, "agent");
            asm volatile("s_waitcnt vmcnt(0)" ::: "memory");
            const unsigned og = xb_add(&bar[XB_TOP], 1u);
            const unsigned tg = og / nx;
            if (og + 1u == (tg + 1u) * nx) xb_add(&bar[XB_TOPGEN], 1u);
            else XB_SPIN(xb_ld(&bar[XB_TOPGEN]) == tg, bar);
            __builtin_amdgcn_fence(__ATOMIC_ACQUIRE, "agent");
            xb_add(&bar[XB_XGEN(b.x)], 1u);
            asm volatile("s_waitcnt vmcnt(0)" ::: "memory");
        } else {
            XB_SPIN(xb_ld(&bar[XB_XGEN(b.x)]) == gen, bar);
            __builtin_amdgcn_fence(__ATOMIC_ACQUIRE, "agent");
            asm volatile("s_waitcnt vmcnt(0)" ::: "memory");
        }
    }
    __syncthreads();
}
constexpr int DM = 1024, NB = 8, SEQ = 4096, NS = 128, SSQ = 4;
constexpr int DL = 512, NH = 8, HD = 64, DIN = 2560, DFF = 3072;
constexpr int MP = NB * SEQ, MS = NS * SSQ, M = MP + MS;
constexpr float EPS = 1e-6f;
constexpr float C2 = 0.125f * 1.4426950408889634f;
constexpr int NWAVES = 8, NTHR = 512;
#ifndef N_LAUNCH
#define N_LAUNCH 1
#endif
constexpr int NPH = 9;

constexpr size_t O_Y = 0;
constexpr size_t O_PCA = (size_t)M * DM;
constexpr size_t O_PLH = O_PCA + (size_t)NB * 3 * DL;
constexpr size_t O_PWK = O_PLH + (size_t)NB * DL;
constexpr size_t O_PWV = O_PWK + (size_t)NB * 2048 * 512;
constexpr size_t O_PCF = O_PWV + (size_t)NB * 2048 * 512;
constexpr size_t O_SCA = O_PCF + (size_t)NB * 2 * DFF;
constexpr size_t O_SLH = O_SCA + (size_t)NS * 3 * DL;
constexpr size_t O_SWK = O_SLH + (size_t)NS * DL;
constexpr size_t O_SWV = O_SWK + (size_t)NS * 4 * 512;
constexpr size_t O_SCF = O_SWV + (size_t)NS * 4 * 512;
constexpr size_t O_END = O_SCF + (size_t)NS * 2 * DFF;
static_assert(O_END == 52494336, "output size");

constexpr size_t MiB = 1u << 20;
constexpr size_t WS_CTL = 0, CTL_ZERO_BYTES = 1 * MiB;
constexpr size_t WS_WIN = 2 * MiB, WS_WOUT = 7 * MiB, WS_WGU = 9 * MiB, WS_WDN = 21 * MiB, WS_WL = 27 * MiB;
constexpr size_t WS_C8 = 28 * MiB, WS_ROPE = 28 * MiB + 65536, WS_RS1 = 29 * MiB, WS_SSP = 30 * MiB, WS_SSP2 = 33 * MiB;
constexpr size_t WS_AGGA = 36 * MiB, WS_AGGB = 37 * MiB, WS_QS = 38 * MiB, WS_LSE = 40 * MiB;
constexpr size_t WS_XN = 48 * MiB, WS_XA = 116 * MiB, WS_GA = 150 * MiB, WS_Q = 184 * MiB, WS_K = 218 * MiB, WS_V = 252 * MiB;
constexpr size_t WS_OP = 288 * MiB, WS_MIX = 384 * MiB + 135424, WS_X1B = 450 * MiB, WS_UFU = 516 * MiB, WS_H = 908 * MiB, WS_END = 1104 * MiB;
constexpr size_t WS_HEADU = 516 * MiB, WS_HEADP = 520 * MiB, WS_TAIL = 524 * MiB;
constexpr size_t WS_PART4 = 540 * MiB;
constexpr size_t WS_XBUF = 548 * MiB;
constexpr size_t WS_PART = 528 * MiB;
constexpr int CW_BAR = 4096;

constexpr int RING_BYTES = 131072, LDSCTL_OFF = 155648, MISC_OFF = LDSCTL_OFF + 320, LDS_BYTES = 163840;

typedef float f32x16 __attribute__((ext_vector_type(16)));
typedef short s16x4 __attribute__((ext_vector_type(4)));
typedef unsigned u32x2 __attribute__((ext_vector_type(2)));

__device__ __forceinline__ float bflo(unsigned w) { return __uint_as_float(w << 16); }
__device__ __forceinline__ float bfhi(unsigned w) { return __uint_as_float(w & 0xffff0000u); }
__device__ __forceinline__ float bf2f(bf16 h) { return __uint_as_float((unsigned)h << 16); }
__device__ __forceinline__ void unpack8(const v4u w, float (&x)[8]) { x[0] = bflo(w.x); x[1] = bfhi(w.x); x[2] = bflo(w.y); x[3] = bfhi(w.y); x[4] = bflo(w.z); x[5] = bfhi(w.z); x[6] = bflo(w.w); x[7] = bfhi(w.w); }
__device__ __forceinline__ v4u pack8(const float (&x)[8]) { v4u w; w.x = pk2(x[0], x[1]); w.y = pk2(x[2], x[3]); w.z = pk2(x[4], x[5]); w.w = pk2(x[6], x[7]); return w; }
__device__ __forceinline__ int crow(int r, int hi) { return (r & 3) + 8 * (r >> 2) + 4 * hi; }
__device__ __forceinline__ float wave_sum(float v) {
#pragma unroll
    for (int o = 1; o < 64; o <<= 1) v += __shfl_xor(v, o);
    return v;
}
__device__ __forceinline__ float sigmoidf_(float x) { return __builtin_amdgcn_rcpf(1.f + __expf(-x)); }
__device__ __forceinline__ float one_minus_exp(float x) {
    float p = 1.f / 720.f; p = p * x + 1.f / 120.f; p = p * x + 1.f / 24.f; p = p * x + 1.f / 6.f; p = p * x + 0.5f; p = p * x + 1.f;
    const float e = 1.f - __expf(x); return x > -0.35f ? -x * p : e; }
__device__ __forceinline__ float gelu_tanh(float x) { const float z = x * (-2.3022082f + -0.10294324f * (x * x));
    return x * __builtin_amdgcn_rcpf(1.f + __builtin_amdgcn_exp2f(z)); }

struct Args { const float* in[24]; float* out; unsigned char* ws; int ph_lo, ph_hi, li, pad; };
enum { I_XP = 0, I_XS, I_SCA, I_SLH, I_CK, I_CV, I_SCF, I_GMIX, I_WIN, I_CAW, I_CAB, I_WR, I_BR, I_WI, I_BI, I_LAM, I_WOUT, I_GFFN, I_WG, I_CFW, I_CFB, I_WU, I_WD, I_GFIN };

__device__ __forceinline__ const float* xrow(const Args& a, int m) { return m < MP ? a.in[I_XP] + (size_t)m * DM : a.in[I_XS] + (size_t)(m - MP) * DM; }

__device__ __forceinline__ void p0_transpose_item(const float* W, const float* gk, int K, int N, bf16* WT, int row_off, LAS float* scr, int item, int lane, int mode = 0) {
    const int nblk = N / 32, kb = item / nblk, nb = item % nblk, k0 = 64 * kb, n0 = 32 * nb;
    const int drow0 = mode == 0 ? row_off + n0 : 256 * (n0 >> 7) + (n0 & 127) + (mode == 2 ? 128 : 0);
    float wv[32], gv[32];
#pragma unroll
    for (int i = 0; i < 32; ++i) { const int kk = 2 * i + (lane >> 5); gv[i] = gk ? gk[k0 + kk] : 1.f; wv[i] = __builtin_nontemporal_load(W + (size_t)(k0 + kk) * N + n0 + (lane & 31)); }
#pragma unroll
    for (int i = 0; i < 32; ++i) { const int kk = 2 * i + (lane >> 5); scr[kk * 33 + (lane & 31)] = wv[i] * gv[i]; }
    LDS_WAIT(); asm volatile("" ::: "memory");
    const int c = lane & 7;
#pragma unroll
    for (int j = 0; j < 4; ++j) { const int n = (lane >> 3) + 8 * j; const LAS float* s = scr + (8 * c) * 33 + n;
        v4u o; o.x = pk2(s[0 * 33], s[1 * 33]); o.y = pk2(s[2 * 33], s[3 * 33]); o.z = pk2(s[4 * 33], s[5 * 33]); o.w = pk2(s[6 * 33], s[7 * 33]);
        *(GAS v4u*)(WT + (size_t)(drow0 + n) * K + k0 + 8 * c) = o; }
    LDS_WAIT(); asm volatile("" ::: "memory");
}

__device__ __forceinline__ void p0_prologue(const Args& a, LAS unsigned char* lds, int tid, int wave, int lane, int wgi, int NW, int part) {
    unsigned char* ws = a.ws;
    LAS float* scr = (LAS float*)(lds + wave * 16384);
    const int gw = wgi * NWAVES + wave, NGW = NW * NWAVES;
    constexpr int I_A = (DM / 64) * (DIN / 32), I_B = (DM / 64) * (DM / 32), I_C = (DM / 64) * (DFF / 32), I_D = (DFF / 64) * (DM / 32);
    constexpr int NITEMS = I_B + 2 * I_C + I_D;
    if (part == 0) for (int it = gw; it < I_A; it += NGW) p0_transpose_item(a.in[I_WIN], a.in[I_GMIX], DM, DIN, (bf16*)(ws + WS_WIN), 0, scr, it, lane);
    else for (int it = gw; it < NITEMS; it += NGW) {
        int r = it;
        if (r < I_B) { p0_transpose_item(a.in[I_WOUT], nullptr, DM, DM, (bf16*)(ws + WS_WOUT), 0, scr, r, lane); continue; } r -= I_B;
        if (r < I_C) { p0_transpose_item(a.in[I_WG], a.in[I_GFFN], DM, DFF, (bf16*)(ws + WS_WGU), 0, scr, r, lane, 1); continue; } r -= I_C;
        if (r < I_C) { p0_transpose_item(a.in[I_WU], a.in[I_GFFN], DM, DFF, (bf16*)(ws + WS_WGU), 0, scr, r, lane, 2); continue; } r -= I_C;
        p0_transpose_item(a.in[I_WD], nullptr, DFF, DM, (bf16*)(ws + WS_WDN), 0, scr, r, lane);
    }
    const int gt = wgi * NTHR + tid, NGT = NW * NTHR;
    if (part == 0) {
    { bf16* WL = (bf16*)(ws + WS_WL);
      for (int e = gt; e < 8 * 192 * 64; e += NGT) { const int i = e & 63, o = (e >> 6) % 192, g = e / (192 * 64); float v;
          if (o < 64) v = a.in[I_WR][(g * 64 + i) * 64 + o]; else if (o < 128) v = a.in[I_WI][(g * 64 + i) * 64 + (o - 64)]; else v = (i == o - 128) ? 1.f : 0.f;
          WL[e] = (bf16)f2bf(v); } }
    { float* c8 = (float*)(ws + WS_C8);
      for (int e = gt; e < DL; e += NGT) { const float lam = a.in[I_LAM][e]; const float sp = (lam < -20.f) ? -lam : log1pf(expf(-lam)); c8[e] = 8.f * sp; } }
    { float* rope = (float*)(ws + WS_ROPE);
      for (int e = gt; e < 4100 * 8; e += NGT) { const int pi = e >> 3, i = e & 7; const double pos = pi < 4096 ? (double)pi : (double)(8192 + (pi - 4096));
          const double inv = pow(500000.0, -(double)i / 8.0), ang = pos * inv; rope[pi * 16 + i] = (float)cos(ang); rope[pi * 16 + 8 + i] = (float)sin(ang); } }
    }
    { bf16* XN = (bf16*)(ws + WS_XN); float* RS1 = (float*)(ws + WS_RS1);
      const int M_lo = part == 0 ? MP : 0, M = part == 0 ? ::M : MP;
#pragma unroll 1
      for (int m0 = M_lo + gw; m0 < M; m0 += 8 * NGW) {
          f32x4 v[8][4];
#pragma unroll
          for (int q = 0; q < 8; ++q) { const int m = m0 + q * NGW; if (m < M) { const GAS f32x4* xr = (const GAS f32x4*)xrow(a, m) + lane;
#pragma unroll
                  for (int j = 0; j < 4; ++j) v[q][j] = __builtin_nontemporal_load((const f32x4*)(xr + 64 * j)); } }
#pragma unroll
          for (int q = 0; q < 8; ++q) { const int m = m0 + q * NGW; if (m < M) { float s = 0.f;
#pragma unroll
                  for (int j = 0; j < 4; ++j) s += (v[q][j].x * v[q][j].x + v[q][j].y * v[q][j].y) + (v[q][j].z * v[q][j].z + v[q][j].w * v[q][j].w);
                  s = wave_sum(s); if (lane == 0) RS1[m] = 1.f / sqrtf(s * (1.f / DM) + EPS);
                  GAS unsigned long long* o8 = (GAS unsigned long long*)(XN + (size_t)m * DM) + lane;
#pragma unroll
                  for (int j = 0; j < 4; ++j) o8[64 * j] = (unsigned long long)pk2(v[q][j].x, v[q][j].y) | ((unsigned long long)pk2(v[q][j].z, v[q][j].w) << 32); } }
      } }
}

__device__ __forceinline__ void load8_bf16(const bf16* p, float (&x)[8]) { unpack8(*(const v4u*)p, x); }
__device__ __forceinline__ void load8_f32(const float* p, float (&x)[8]) { const f32x4 a = *(const f32x4*)p, b = *(const f32x4*)(p + 4); x[0] = a[0]; x[1] = a[1]; x[2] = a[2]; x[3] = a[3]; x[4] = b[0]; x[5] = b[1]; x[6] = b[2]; x[7] = b[3]; }
struct EpiZ {
    static constexpr bool PERM = true, AFTER_DRAIN = false;
    const float* rs1; const float* rope; bf16 *XA, *GA, *Q, *K, *V; float* QS; float* out; LAS float* ex;
    __device__ __forceinline__ void pre(const pg8::Unit& u, int par, int tid) const { if (tid < 256) ex[1024 + par * 256 + tid] = rs1[u.pm * 256 + tid]; }
    __device__ __forceinline__ void operator()(const pg8::f32x4 (&acc)[2][2][4][2], const pg8::Unit& u, int wr, int wc, int fr, int fq, int par) const {
        const int type = u.pn >> 1;
        const int cbase = (u.pn & 1) * 256 + wc * 32 + 8 * fq;
        float rsv[2][4];
#pragma unroll
        for (int ai = 0; ai < 2; ++ai)
#pragma unroll
            for (int m = 0; m < 4; ++m) rsv[ai][m] = ex[1024 + par * 256 + ai * 128 + wr * 64 + m * 16 + fr];
        const bool do_rope = (type == 2 || type == 3) && (wc & 1) == 0;
#pragma unroll
        for (int ai = 0; ai < 2; ++ai) {
            f32x4 rc[4][4];
#pragma unroll
            for (int m = 0; m < 4; ++m) {
                if ((m & 1) == 0 && do_rope && fq < 2) {
#pragma unroll
                    for (int mm = m; mm < m + 2; ++mm) { const int row = u.pm * 256 + ai * 128 + wr * 64 + mm * 16 + fr; const int pi = row >= MP ? 4096 + (row & 3) : (row & 4095);
                        const f32x4* rp = (const f32x4*)(rope + (size_t)pi * 16); rc[mm][0] = rp[0]; rc[mm][1] = rp[1]; rc[mm][2] = rp[2]; rc[mm][3] = rp[3]; }
                }
                const int row = u.pm * 256 + ai * 128 + wr * 64 + m * 16 + fr;
                const float rs = rsv[ai][m];
                const bool samp = row >= MP;
                const int b = samp ? ((row - MP) >> 2) : (row >> 12), t = samp ? (row & 3) : (row & 4095);
#pragma unroll
                for (int bj = 0; bj < 2; ++bj) {
                    const int ct = cbase + 128 * bj;
                    float v[8];
#pragma unroll
                    for (int i = 0; i < 4; ++i) { v[i] = acc[ai][bj][m][0][i] * rs; v[4 + i] = acc[ai][bj][m][1][i] * rs; }
                    if (do_rope) {
                        float pv[8];
#pragma unroll
                        for (int i = 0; i < 8; ++i) pv[i] = __shfl_xor(v[i], 16);
                        if (fq < 2) { const float sg = fq == 0 ? -1.f : 1.f;
                            const f32x4 c0 = rc[m][0], c1 = rc[m][1], s0 = rc[m][2], s1 = rc[m][3];
#pragma unroll
                            for (int i = 0; i < 4; ++i) { v[i] = v[i] * c0[i] + sg * pv[i] * s0[i]; v[4 + i] = v[4 + i] * c1[i] + sg * pv[4 + i] * s1[i]; } }
                    }
                    float* so = nullptr;
                    bf16* dst;
                    if (type == 0) { dst = XA; if (!samp) { if (t >= SEQ - 3) so = out + O_PCA + (size_t)(b * 3 + (t - (SEQ - 3))) * DL + ct; } else if (t >= 1) so = out + O_SCA + (size_t)(b * 3 + t - 1) * DL + ct; }
                    else if (type == 1) dst = GA;
                    else if (type == 2) { dst = Q;
#pragma unroll
                        for (int i = 0; i < 8; ++i) v[i] *= C2;
                        if (samp) so = QS + (size_t)(row - MP) * 512 + ct; }
                    else if (type == 3) { dst = K; if (!samp) { if (t >= 2048) so = out + O_PWK + (size_t)(b * 2048 + t - 2048) * 512 + ct; } else so = out + O_SWK + (size_t)(b * 4 + t) * 512 + ct; }
                    else { dst = V; if (!samp) { if (t >= 2048) so = out + O_PWV + (size_t)(b * 2048 + t - 2048) * 512 + ct; } else so = out + O_SWV + (size_t)(b * 4 + t) * 512 + ct; }
                    *(v4u*)(dst + (size_t)row * 512 + ct) = pack8(v);
                    if (so) { *(f32x4*)so = (f32x4){v[0], v[1], v[2], v[3]}; *(f32x4*)(so + 4) = (f32x4){v[4], v[5], v[6], v[7]}; }
                }
            }
        }
    }
};
struct EpiX1 {
    static constexpr bool PERM = true, AFTER_DRAIN = false;
    __device__ __forceinline__ void pre(const pg8::Unit&, int, int) const {}
    const float* xp; const float* xs; float* Y; bf16* X1B; float* SSP;
    __device__ __forceinline__ void operator()(const pg8::f32x4 (&acc)[2][2][4][2], const pg8::Unit& u, int wr, int wc, int fr, int fq, int par) const {
        const int cbase = u.pn * 256 + wc * 32 + 8 * fq;
#pragma unroll
        for (int ai = 0; ai < 2; ++ai) {
            f32x4 xv[4][2][2];
#pragma unroll
            for (int m = 0; m < 4; ++m) { const int row = u.pm * 256 + ai * 128 + wr * 64 + m * 16 + fr;
                const float* xr = row < MP ? xp + (size_t)row * DM : xs + (size_t)(row - MP) * DM;
#pragma unroll
                for (int bj = 0; bj < 2; ++bj) { xv[m][bj][0] = __builtin_nontemporal_load((const f32x4*)(xr + cbase + 128 * bj)); xv[m][bj][1] = __builtin_nontemporal_load((const f32x4*)(xr + cbase + 128 * bj + 4)); } }
#pragma unroll
            for (int m = 0; m < 4; ++m) {
                const int row = u.pm * 256 + ai * 128 + wr * 64 + m * 16 + fr;
                float ss = 0.f;
#pragma unroll
                for (int bj = 0; bj < 2; ++bj) {
                    const int ct = cbase + 128 * bj;
                    const f32x4 o0 = xv[m][bj][0] + acc[ai][bj][m][0], o1 = xv[m][bj][1] + acc[ai][bj][m][1];
                    if (u.pm >= MP / 256) { *(f32x4*)(Y + (size_t)row * DM + ct) = o0; *(f32x4*)(Y + (size_t)row * DM + ct + 4) = o1; }
                    const float v[8] = {o0[0], o0[1], o0[2], o0[3], o1[0], o1[1], o1[2], o1[3]};
                    *(v4u*)(X1B + (size_t)row * DM + ct) = pack8(v);
#pragma unroll
                    for (int i = 0; i < 8; ++i) ss += v[i] * v[i];
                }
                ss += __shfl_xor(ss, 16); ss += __shfl_xor(ss, 32);
                if (fq == 0) SSP[(size_t)row * 16 + u.pn * 4 + wc] = ss;
            }
        }
    }
};
__device__ __forceinline__ float row_rs(const float* SSP, int row) {
    const f32x4* p = (const f32x4*)(SSP + (size_t)row * 16); const f32x4 a = p[0], b = p[1], c = p[2], d = p[3];
    const float s = ((a[0] + a[1]) + (a[2] + a[3])) + ((b[0] + b[1]) + (b[2] + b[3])) + ((c[0] + c[1]) + (c[2] + c[3])) + ((d[0] + d[1]) + (d[2] + d[3]));
    return 1.f / sqrtf(s * (1.f / DM) + EPS);
}
template <int CTRL> __device__ __forceinline__ float dpp_t(float v) { return __builtin_bit_cast(float, __builtin_amdgcn_update_dpp(0, __builtin_bit_cast(int, v), CTRL, 0xf, 0xf, false)); }
#define dpp_f(v, ctrl) dpp_t<ctrl>(v)
template <int CTRL> __device__ __forceinline__ float dpp_b(float v) { return __builtin_bit_cast(float, __builtin_amdgcn_update_dpp(0, __builtin_bit_cast(int, v), CTRL, 0xf, 0xf, true)); }
__device__ __forceinline__ float dpp_ror1(float v) { return __builtin_bit_cast(float, __builtin_amdgcn_update_dpp(0, __builtin_bit_cast(int, v), 0x121, 0xf, 0xf, false)); }
__device__ __forceinline__ float dpp_ror2(float v) { return __builtin_bit_cast(float, __builtin_amdgcn_update_dpp(0, __builtin_bit_cast(int, v), 0x122, 0xf, 0xf, false)); }
struct EpiGU {
    static constexpr bool PERM = true, AFTER_DRAIN = false;
    const float* SSP; bf16* H; const float* cw; const float* cb; const float* scf; float* out; float* HEADU; float* HEADP; float* TAIL; LAS float* ex; LAS float* cwl;
    __device__ __forceinline__ void pre(const pg8::Unit& u, int par, int tid) const {
        if (tid < 256) ex[1024 + par * 256 + tid] = row_rs(SSP, u.pm * 256 + tid);
        else { const int t = tid - 256, arr = t >> 6, c2 = (t & 63) * 2; const float* src = (arr < 3 ? cw + arr * DFF : cb) + u.pn * 128 + c2;
            const f32x2 v = *(const f32x2*)src; *(LAS f32x2*)(cwl + par * 512 + arr * 128 + c2) = v; }
    }
    __device__ __forceinline__ void operator()(const pg8::f32x4 (&acc)[2][2][4][2], const pg8::Unit& u, int wr, int wc, int fr, int fq, int par) const {
        if (u.pm >= MP / 256) sample_body(acc, u, wr, wc, fr, fq, par); else prompt_body(acc, u, wr, wc, fr, fq, par);
    }
    __device__ __forceinline__ void prompt_body(const pg8::f32x4 (&acc)[2][2][4][2], const pg8::Unit& u, int wr, int wc, int fr, int fq, int par) const {
        const int j0 = u.pn * 128 + wc * 32 + 8 * fq;
        const int wave = wr * 4 + wc;
        float w0[8], w1[8], w2[8], bb[8];
        { const LAS float* cl = cwl + par * 512 + wc * 32 + 8 * fq;
#pragma unroll
          for (int h = 0; h < 2; ++h) { const f32x4 a0 = *(const LAS f32x4*)(cl + 4 * h), a1 = *(const LAS f32x4*)(cl + 128 + 4 * h), a2 = *(const LAS f32x4*)(cl + 256 + 4 * h), a3 = *(const LAS f32x4*)(cl + 384 + 4 * h);
#pragma unroll
              for (int e = 0; e < 4; ++e) { w0[4 * h + e] = a0[e]; w1[4 * h + e] = a1[e]; w2[4 * h + e] = a2[e]; bb[4 * h + e] = a3[e]; } } }
        const bool l15 = fr == 15, l14 = fr >= 14;
#pragma unroll
        for (int ai = 0; ai < 2; ++ai) {
            const float rs = ex[1024 + par * 256 + ai * 128 + wr * 64 + 48 + fr];
            if (fr >= 14) { LAS float* e = ex + ((wave * 2 + ai) * 2 + (fr - 14)) * 32 + 8 * fq;
                *(LAS f32x4*)e = acc[ai][0][3][0] * rs; *(LAS f32x4*)(e + 4) = acc[ai][0][3][1] * rs; }
        }
        asm volatile("s_waitcnt lgkmcnt(0)\n\ts_barrier" ::: "memory");
#pragma unroll
        for (int ai = 0; ai < 2; ++ai) {
            float gp[8];
            bool pending = false;
            if (wr == 0 && ai == 0) {
#pragma unroll
                for (int e = 0; e < 8; ++e) gp[e] = 0.f;
                pending = (u.pm & 15) != 0;
            } else {
                const int sw = (wr == 1) ? wc : 4 + wc, sa = (wr == 1) ? ai : 0;
                const LAS float* e2 = ex + ((sw * 2 + sa) * 2 + (fr & 1)) * 32 + 8 * fq;
                const f32x4 b0 = *(const LAS f32x4*)e2, b1 = *(const LAS f32x4*)(e2 + 4);
#pragma unroll
                for (int e = 0; e < 4; ++e) { gp[e] = b0[e]; gp[4 + e] = b1[e]; }
            }
            float rsv[4];
#pragma unroll
            for (int m = 0; m < 4; ++m) rsv[m] = ex[1024 + par * 256 + ai * 128 + wr * 64 + m * 16 + fr];
#pragma unroll
            for (int m = 0; m < 4; ++m) {
                const int row = u.pm * 256 + ai * 128 + wr * 64 + m * 16 + fr;
                const float rs = rsv[m];
                float g[8], up[8]; unsigned yw[4];
#pragma unroll
                for (int e = 0; e < 4; ++e) { g[e] = acc[ai][0][m][0][e] * rs; g[4 + e] = acc[ai][0][m][1][e] * rs; up[e] = acc[ai][1][m][0][e] * rs; up[4 + e] = acc[ai][1][m][1][e] * rs; }
#pragma unroll
                for (int e2 = 0; e2 < 4; ++e2) {
                    f32x2 x;
#pragma unroll
                    for (int q = 0; q < 2; ++q) { const int e = 2 * e2 + q;
                        const float h1 = l15 ? gp[e] : g[e], h2 = l14 ? gp[e] : g[e];
                        float uc = fmaf(w2[e], g[e], bb[e]);
                        uc = fmaf(dpp_b<0x121>(h1), w1[e], uc); uc = fmaf(dpp_b<0x122>(h2), w0[e], uc);
                        x[q] = uc; }
                    f32x2 t = x * x; t = t * (f32x2){-0.10294324f, -0.10294324f} + (f32x2){-2.3022082f, -2.3022082f}; t = t * x;
                    f32x2 d = (f32x2){__builtin_amdgcn_exp2f(t[0]), __builtin_amdgcn_exp2f(t[1])} + (f32x2){1.f, 1.f};
                    const f32x2 r = (f32x2){__builtin_amdgcn_rcpf(d[0]), __builtin_amdgcn_rcpf(d[1])};
                    const f32x2 y = (x * r) * (f32x2){up[2 * e2], up[2 * e2 + 1]};
                    yw[e2] = pk2(y[0], y[1]);
                }
                const bool hold = pending && m == 0 && fr < 2;
                if (!hold) *(v4u*)(H + (size_t)row * DFF + j0) = (v4u){yw[0], yw[1], yw[2], yw[3]};
                else { float* hu = HEADU + (size_t)(u.pm * 2 + fr) * DFF + j0; float* hp = HEADP + (size_t)(u.pm * 2 + fr) * DFF + j0;
                    *(f32x4*)hu = (f32x4){g[0], g[1], g[2], g[3]}; *(f32x4*)(hu + 4) = (f32x4){g[4], g[5], g[6], g[7]};
                    *(f32x4*)hp = (f32x4){up[0], up[1], up[2], up[3]}; *(f32x4*)(hp + 4) = (f32x4){up[4], up[5], up[6], up[7]}; }
                if (ai == 1 && wr == 1 && m == 3 && fr >= 14) { float* so = TAIL + (size_t)(u.pm * 2 + (fr - 14)) * DFF + j0;
                    if ((u.pm & 15) == 15) { float* so2 = out + O_PCF + (size_t)((u.pm >> 4) * 2 + (fr - 14)) * DFF + j0;
                        *(f32x4*)so2 = (f32x4){g[0], g[1], g[2], g[3]}; *(f32x4*)(so2 + 4) = (f32x4){g[4], g[5], g[6], g[7]}; }
                    *(f32x4*)so = (f32x4){g[0], g[1], g[2], g[3]}; *(f32x4*)(so + 4) = (f32x4){g[4], g[5], g[6], g[7]}; }
#pragma unroll
                for (int e = 0; e < 8; ++e) gp[e] = g[e];
            }
        }
    }
    __device__ __forceinline__ void sample_body(const pg8::f32x4 (&acc)[2][2][4][2], const pg8::Unit& u, int wr, int wc, int fr, int fq, int par) const {
        const int j0 = u.pn * 128 + wc * 32 + 8 * fq;
        constexpr bool samp = true;
        const int wave = wr * 4 + wc;
        float w0[8], w1[8], w2[8], bb[8];
        { const LAS float* cl = cwl + par * 512 + wc * 32 + 8 * fq;
#pragma unroll
          for (int h = 0; h < 2; ++h) { const f32x4 a0 = *(const LAS f32x4*)(cl + 4 * h), a1 = *(const LAS f32x4*)(cl + 128 + 4 * h), a2 = *(const LAS f32x4*)(cl + 256 + 4 * h), a3 = *(const LAS f32x4*)(cl + 384 + 4 * h);
#pragma unroll
              for (int e = 0; e < 4; ++e) { w0[4 * h + e] = a0[e]; w1[4 * h + e] = a1[e]; w2[4 * h + e] = a2[e]; bb[4 * h + e] = a3[e]; } } }
        if (!samp) {
#pragma unroll
            for (int ai = 0; ai < 2; ++ai) {
                const float rs = ex[1024 + par * 256 + ai * 128 + wr * 64 + 48 + fr];
                if (fr >= 14) { LAS float* e = ex + ((wave * 2 + ai) * 2 + (fr - 14)) * 32 + 8 * fq;
                    *(LAS f32x4*)e = acc[ai][0][3][0] * rs; *(LAS f32x4*)(e + 4) = acc[ai][0][3][1] * rs; }
            }
            asm volatile("s_waitcnt lgkmcnt(0)\n\ts_barrier" ::: "memory");
        }
#pragma unroll
        for (int ai = 0; ai < 2; ++ai) {
            float pR1[8], pR2[8];
            bool pending = false;
            if (!samp) {
                if (wr == 0 && ai == 0) {
#pragma unroll
                    for (int e = 0; e < 8; ++e) { pR1[e] = 0.f; pR2[e] = 0.f; }
                    pending = (u.pm & 15) != 0;
                } else {
                    const int sw = (wr == 1) ? wc : 4 + wc, sa = (wr == 1) ? ai : 0;
                    const LAS float* e1 = ex + ((sw * 2 + sa) * 2 + 1) * 32 + 8 * fq; const LAS float* e2 = ex + ((sw * 2 + sa) * 2 + (fr & 1)) * 32 + 8 * fq;
                    const f32x4 a0 = *(const LAS f32x4*)e1, a1 = *(const LAS f32x4*)(e1 + 4), b0 = *(const LAS f32x4*)e2, b1 = *(const LAS f32x4*)(e2 + 4);
#pragma unroll
                    for (int e = 0; e < 4; ++e) { pR1[e] = a0[e]; pR1[4 + e] = a1[e]; pR2[e] = b0[e]; pR2[4 + e] = b1[e]; }
                }
            }
            float rsv[4];
#pragma unroll
            for (int m = 0; m < 4; ++m) rsv[m] = ex[1024 + par * 256 + ai * 128 + wr * 64 + m * 16 + fr];
#pragma unroll
            for (int m = 0; m < 4; ++m) {
                const int row = u.pm * 256 + ai * 128 + wr * 64 + m * 16 + fr;
                const float rs = rsv[m];
                float g[8], up[8]; unsigned yw[4];
#pragma unroll
                for (int e = 0; e < 4; ++e) { g[e] = acc[ai][0][m][0][e] * rs; g[4 + e] = acc[ai][0][m][1][e] * rs; up[e] = acc[ai][1][m][0][e] * rs; up[4 + e] = acc[ai][1][m][1][e] * rs; }
#pragma unroll
                for (int hf = 0; hf < 2; ++hf) {
                    float yh[4];
                    f32x4 s0 = (f32x4){0.f, 0.f, 0.f, 0.f}, s1 = s0; int sq = 3;
                    if (samp) { const int n = (row - MP) >> 2; sq = fr & 3; s0 = *(const f32x4*)(scf + (size_t)(n * 2) * DFF + j0 + 4 * hf); s1 = *(const f32x4*)(scf + (size_t)(n * 2 + 1) * DFF + j0 + 4 * hf); }
#pragma unroll
                    for (int e4 = 0; e4 < 4; ++e4) { const int e = 4 * hf + e4;
                        const float R1 = dpp_ror1(g[e]), R2 = dpp_ror2(g[e]);
                        float p1, p2;
                        if (!samp) { p1 = fr >= 1 ? R1 : pR1[e]; p2 = fr >= 2 ? R2 : pR2[e]; }
                        else { p1 = sq >= 1 ? R1 : s1[e4]; p2 = sq >= 2 ? R2 : (sq == 1 ? s1[e4] : s0[e4]); }
                        const float uc = bb[e] + w0[e] * p2 + w1[e] * p1 + w2[e] * g[e]; yh[e4] = gelu_tanh(uc) * up[e]; pR1[e] = R1; pR2[e] = R2; }
                    yw[2 * hf] = pk2(yh[0], yh[1]); yw[2 * hf + 1] = pk2(yh[2], yh[3]);
                }
                const bool hold = pending && m == 0 && fr < 2;
                if (!hold) *(v4u*)(H + (size_t)row * DFF + j0) = (v4u){yw[0], yw[1], yw[2], yw[3]};
                else { float* hu = HEADU + (size_t)(u.pm * 2 + fr) * DFF + j0; float* hp = HEADP + (size_t)(u.pm * 2 + fr) * DFF + j0;
                    *(f32x4*)hu = (f32x4){g[0], g[1], g[2], g[3]}; *(f32x4*)(hu + 4) = (f32x4){g[4], g[5], g[6], g[7]};
                    *(f32x4*)hp = (f32x4){up[0], up[1], up[2], up[3]}; *(f32x4*)(hp + 4) = (f32x4){up[4], up[5], up[6], up[7]}; }
                float* so = nullptr;
                if (!samp) { if (ai == 1 && wr == 1 && m == 3 && fr >= 14) { so = TAIL + (size_t)(u.pm * 2 + (fr - 14)) * DFF + j0;
                        if ((u.pm & 15) == 15) { float* so2 = out + O_PCF + (size_t)((u.pm >> 4) * 2 + (fr - 14)) * DFF + j0;
                            *(f32x4*)so2 = (f32x4){g[0], g[1], g[2], g[3]}; *(f32x4*)(so2 + 4) = (f32x4){g[4], g[5], g[6], g[7]}; } } }
                else if ((fr & 3) >= 2) so = out + O_SCF + (size_t)(((row - MP) >> 2) * 2 + ((fr & 3) - 2)) * DFF + j0;
                if (so) { *(f32x4*)so = (f32x4){g[0], g[1], g[2], g[3]}; *(f32x4*)(so + 4) = (f32x4){g[4], g[5], g[6], g[7]}; }
            }
        }
    }
};
struct EpiX2 {
    static constexpr bool PERM = true, AFTER_DRAIN = false;
    __device__ __forceinline__ void pre(const pg8::Unit&, int, int) const {}
    float* Y; const bf16* X1B;
    __device__ __forceinline__ void operator()(const pg8::f32x4 (&acc)[2][2][4][2], const pg8::Unit& u, int wr, int wc, int fr, int fq, int par) const {
        const int cbase = u.pn * 256 + wc * 32 + 8 * fq;
#pragma unroll
        for (int ai = 0; ai < 2; ++ai) {
            v4u xv[4][2];
#pragma unroll
            for (int m = 0; m < 4; ++m) { const bf16* xr = X1B + (size_t)(u.pm * 256 + ai * 128 + wr * 64 + m * 16 + fr) * DM + cbase;
#pragma unroll
                for (int bj = 0; bj < 2; ++bj) xv[m][bj] = *(const v4u*)(xr + 128 * bj); }
#pragma unroll
            for (int m = 0; m < 4; ++m) {
                const int row = u.pm * 256 + ai * 128 + wr * 64 + m * 16 + fr;
#pragma unroll
                for (int bj = 0; bj < 2; ++bj) { float* yp = Y + (size_t)row * DM + cbase + 128 * bj; float x[8]; unpack8(xv[m][bj], x);
                    *(f32x4*)yp = (f32x4){x[0], x[1], x[2], x[3]} + acc[ai][bj][m][0]; *(f32x4*)(yp + 4) = (f32x4){x[4], x[5], x[6], x[7]} + acc[ai][bj][m][1]; }
            }
        }
    }
};
constexpr int CW_X2C = 100000;
struct EpiX2F {
    static constexpr bool PERM = true, AFTER_DRAIN = true;
    __device__ __forceinline__ void pre(const pg8::Unit&, int, int) const {}
    float* Y; const bf16* X1B; const float* gfin; float* xbuf; unsigned* cnt;
    __device__ __forceinline__ void operator()(const pg8::f32x4 (&)[2][2][4][2], const pg8::Unit&, int, int, int, int, int) const {}
    __device__ __forceinline__ void fused(pg8::f32x4 (&acc)[2][2][4][2], const pg8::Unit& u, int wr, int wc, int fr, int fq, LAS unsigned char* lds, int wid, int lane) const {
        const int cbase = u.pn * 256 + wc * 32 + 8 * fq, tid = wid * 64 + lane;
        LAS float* P = (LAS float*)lds; LAS float* S = P + 1024; LAS unsigned* flag = (LAS unsigned*)(S + 256);
        { v4u xv[2][4][2];
#pragma unroll
          for (int ai = 0; ai < 2; ++ai)
#pragma unroll
            for (int m = 0; m < 4; ++m) { const bf16* xr = X1B + (size_t)(u.pm * 256 + ai * 128 + wr * 64 + m * 16 + fr) * DM + cbase;
#pragma unroll
                for (int bj = 0; bj < 2; ++bj) xv[ai][m][bj] = *(const v4u*)(xr + 128 * bj); }
#pragma unroll
          for (int ai = 0; ai < 2; ++ai)
#pragma unroll
            for (int m = 0; m < 4; ++m) { float ss = 0.f;
#pragma unroll
                for (int bj = 0; bj < 2; ++bj) { float x[8]; unpack8(xv[ai][m][bj], x);
#pragma unroll
                    for (int i = 0; i < 4; ++i) { acc[ai][bj][m][0][i] += x[i]; acc[ai][bj][m][1][i] += x[4 + i]; ss += acc[ai][bj][m][0][i] * acc[ai][bj][m][0][i] + acc[ai][bj][m][1][i] * acc[ai][bj][m][1][i]; } }
                ss += __shfl_xor(ss, 16); ss += __shfl_xor(ss, 32);
                if (fq == 0) P[(ai * 128 + wr * 64 + m * 16 + fr) * 4 + wc] = ss; } }
        asm volatile("s_waitcnt lgkmcnt(0)" ::: "memory"); __builtin_amdgcn_s_barrier(); asm volatile("" ::: "memory");
        if (tid < 256) { const pg8::f32x4 p4 = *(const LAS pg8::f32x4*)(P + tid * 4);
            __hip_atomic_store(xbuf + ((size_t)u.pm * 256 + tid) * 4 + u.pn, (p4[0] + p4[1]) + (p4[2] + p4[3]), __ATOMIC_RELAXED, __HIP_MEMORY_SCOPE_AGENT); }
        asm volatile("s_waitcnt vmcnt(0)" ::: "memory");
        if (lane == 0 && wid < 4) __hip_atomic_fetch_add(cnt + u.pm * 16, 1u, __ATOMIC_RELAXED, __HIP_MEMORY_SCOPE_AGENT);
        if (wid == 0) { unsigned spins = 0;
            while ((unsigned)__builtin_amdgcn_readfirstlane(__hip_atomic_load(cnt + u.pm * 16, __ATOMIC_RELAXED, __HIP_MEMORY_SCOPE_AGENT)) < 16u) { if (++spins > (1u << 20)) break; __builtin_amdgcn_s_sleep(2); }
            __builtin_amdgcn_fence(__ATOMIC_ACQUIRE, "agent"); }
        asm volatile("s_waitcnt vmcnt(0) lgkmcnt(0)" ::: "memory"); __builtin_amdgcn_s_barrier(); asm volatile("" ::: "memory");
        if (tid < 256) { const float* sl = xbuf + ((size_t)u.pm * 256 + tid) * 4; float t = 0.f;
#pragma unroll
            for (int k = 0; k < 4; ++k) t += __hip_atomic_load(sl + k, __ATOMIC_RELAXED, __HIP_MEMORY_SCOPE_AGENT);
            S[tid] = 1.f / sqrtf(t * (1.f / DM) + EPS); }
        asm volatile("s_waitcnt vmcnt(0) lgkmcnt(0)" ::: "memory"); __builtin_amdgcn_s_barrier(); asm volatile("" ::: "memory");
        pg8::f32x4 gv[2][2];
#pragma unroll
        for (int bj = 0; bj < 2; ++bj) { gv[bj][0] = *(const pg8::f32x4*)(gfin + cbase + 128 * bj); gv[bj][1] = *(const pg8::f32x4*)(gfin + cbase + 128 * bj + 4); }
#pragma unroll
        for (int ai = 0; ai < 2; ++ai)
#pragma unroll
            for (int m = 0; m < 4; ++m) { const int rl = ai * 128 + wr * 64 + m * 16 + fr; const float rs = S[rl]; float* yp = Y + (size_t)(u.pm * 256 + rl) * DM + cbase;
#pragma unroll
                for (int bj = 0; bj < 2; ++bj) { *(pg8::f32x4*)(yp + 128 * bj) = acc[ai][bj][m][0] * rs * gv[bj][0]; *(pg8::f32x4*)(yp + 128 * bj + 4) = acc[ai][bj][m][1] * rs * gv[bj][1]; } }
    }
};
struct SampleUnitOrder {
    int c, nw;
    __device__ __forceinline__ bool next(int i, pg8::Unit& u) const { const int L = i * nw + c; if (L >= 2 * (DIN / 256)) return false; u.pm = MP / 256 + L / (DIN / 256); u.pn = L % (DIN / 256); u.ko = 0; return true; }
    __device__ __forceinline__ void a_ready(const pg8::Unit&) const {}
    __device__ __forceinline__ void done(const pg8::Unit&) const {}
};
struct OneUnitOrder : pg8::StaticOrder {
    int i0;
    __device__ __forceinline__ bool next(int i, pg8::Unit& u) const { return i == 0 && pg8::StaticOrder::next(i0, u); }
};
constexpr int KSPLIT = 6, KSPLIT4 = 4;
struct EpiPart {
    static constexpr bool PERM = true, AFTER_DRAIN = false;
    __device__ __forceinline__ void pre(const pg8::Unit&, int, int) const {}
    float* PART; int kw;
    __device__ __forceinline__ void operator()(const pg8::f32x4 (&acc)[2][2][4][2], const pg8::Unit& u, int wr, int wc, int fr, int fq, int par) const {
        const int cbase = u.pn * 256 + wc * 32 + 8 * fq; float* P = PART + (size_t)(u.ko / kw) * MS * DM;
#pragma unroll
        for (int ai = 0; ai < 2; ++ai)
#pragma unroll
            for (int m = 0; m < 4; ++m) { const int rS = (u.pm - MP / 256) * 256 + ai * 128 + wr * 64 + m * 16 + fr;
#pragma unroll
                for (int bj = 0; bj < 2; ++bj) { float* pp = P + (size_t)rS * DM + cbase + 128 * bj; *(f32x4*)pp = acc[ai][bj][m][0]; *(f32x4*)(pp + 4) = acc[ai][bj][m][1]; } }
    }
};
struct SplitOrder {
    int G, c, ns, kw;
    __device__ __forceinline__ bool next(int i, pg8::Unit& u) const { const int idx = c + i * G; if (idx >= 8 * ns) return false;
        const int sl = idx >> 3, r = idx & 7; u.pm = MP / 256 + (r >> 2); u.pn = r & 3; u.ko = sl * kw; return true; }
    __device__ __forceinline__ void a_ready(const pg8::Unit&) const {}
    __device__ __forceinline__ void done(const pg8::Unit&) const {}
};
struct GatedOrder : pg8::StaticOrder {
    const unsigned* cnt; unsigned need;
    __device__ __forceinline__ void a_ready(const pg8::Unit& u) const {
        if (u.pm < MP / 256) return;
        if (threadIdx.x < 64) { unsigned spins = 0;
            while ((unsigned)__builtin_amdgcn_readfirstlane(__hip_atomic_load(cnt, __ATOMIC_RELAXED, __HIP_MEMORY_SCOPE_AGENT)) < need) { if (++spins > (1u << 20)) break; __builtin_amdgcn_s_sleep(2); }
            __builtin_amdgcn_fence(__ATOMIC_ACQUIRE, "agent");
            asm volatile("s_waitcnt vmcnt(0)" ::: "memory"); }
        asm volatile("" ::: "memory"); __builtin_amdgcn_s_barrier(); asm volatile("" ::: "memory");
    }
};
constexpr int CW_P0A = 90064;
constexpr int CW_CNT4 = 90000;
__device__ __forceinline__ void finalize_x1_sample(const Args& a, int bx, int G, int wave, int lane) {
    unsigned char* ws = a.ws; const float* PART4 = (const float*)(ws + WS_PART4); float* Y = a.out + O_Y; bf16* X1B = (bf16*)(ws + WS_X1B); float* SSP = (float*)(ws + WS_SSP);
    unsigned* cnt = (unsigned*)(ws + WS_CTL) + CW_CNT4;
    for (int r = bx + G * wave; r < MS; r += G * NWAVES) {
        const int row = MP + r; f32x4 v[4]; float ss = 0.f;
#pragma unroll
        for (int j = 0; j < 4; ++j) { v[j] = ((const GAS f32x4*)(a.in[I_XS] + (size_t)r * DM) + lane)[64 * j];
#pragma unroll
            for (int sl = 0; sl < KSPLIT4; ++sl) v[j] += ((const GAS f32x4*)(PART4 + ((size_t)sl * MS + r) * DM) + lane)[64 * j];
            ss += (v[j].x * v[j].x + v[j].y * v[j].y) + (v[j].z * v[j].z + v[j].w * v[j].w); }
        ss = wave_sum(ss);
#pragma unroll
        for (int j = 0; j < 4; ++j) { const size_t e = (size_t)row * DM + 4 * (lane + 64 * j);
            __hip_atomic_store((unsigned long long*)(Y + e), ((unsigned long long)__float_as_uint(v[j].y) << 32) | __float_as_uint(v[j].x), __ATOMIC_RELAXED, __HIP_MEMORY_SCOPE_AGENT);
            __hip_atomic_store((unsigned long long*)(Y + e + 2), ((unsigned long long)__float_as_uint(v[j].w) << 32) | __float_as_uint(v[j].z), __ATOMIC_RELAXED, __HIP_MEMORY_SCOPE_AGENT);
            __hip_atomic_store((unsigned long long*)(X1B + e), ((unsigned long long)pk2(v[j].z, v[j].w) << 32) | pk2(v[j].x, v[j].y), __ATOMIC_RELAXED, __HIP_MEMORY_SCOPE_AGENT); }
        if (lane < 8) __hip_atomic_store((unsigned long long*)(SSP + (size_t)row * 16 + 2 * lane), lane == 0 ? (unsigned long long)__float_as_uint(ss) : 0ull, __ATOMIC_RELAXED, __HIP_MEMORY_SCOPE_AGENT);
        asm volatile("s_waitcnt vmcnt(0)" ::: "memory");
        if (lane == 0) __hip_atomic_fetch_add(cnt, 1u, __ATOMIC_RELAXED, __HIP_MEMORY_SCOPE_AGENT);
    }
}

constexpr int LRU_CS = 64 * 16 + 16;
template <int MODE> __device__ __forceinline__ void lru_item(const Args& a, int item, LAS unsigned char* lds, int wid, int lane) {
    unsigned char* ws = a.ws;
    const bf16* XA = (const bf16*)(ws + WS_XA); const bf16* GAb = (const bf16*)(ws + WS_GA); const bf16* WL = (const bf16*)(ws + WS_WL);
    const float* C8 = (const float*)(ws + WS_C8); float* AGGA = (float*)(ws + WS_AGGA); float* AGGB = (float*)(ws + WS_AGGB); bf16* MIX = (bf16*)(ws + WS_MIX);
    const int seq = item >> 6, chunk = item & 63, g = wid;
    const int row0 = (MODE == 2) ? MP + item * 64 : seq * SEQ + chunk * 64;
    {
        float w[4][8], bb[8];
#pragma unroll
        for (int j = 0; j < 4; ++j) load8_f32(a.in[I_CAW] + j * DL + 8 * lane, w[j]);
        load8_f32(a.in[I_CAB] + 8 * lane, bb);
        if (MODE != 2) {
            v4u xr[11];
#pragma unroll
            for (int k = 0; k < 11; ++k) { const int t = chunk * 64 + wid * 8 - 3 + k;
                if (t >= 0) xr[k] = *(const v4u*)(XA + (size_t)(seq * SEQ + t) * DL + 8 * lane); else xr[k] = (v4u){0u, 0u, 0u, 0u}; }
#pragma unroll
            for (int it = 0; it < 8; ++it) {
                float s[8];
#pragma unroll
                for (int i = 0; i < 8; ++i) s[i] = bb[i];
#pragma unroll
                for (int j = 0; j < 4; ++j) { float x[8]; unpack8(xr[it + j], x);
#pragma unroll
                    for (int i = 0; i < 8; ++i) s[i] += w[j][i] * x[i]; }
                *(LAS v4u*)(lds + lane * LRU_CS + (wid * 8 + it) * 16) = pack8(s);
            }
        } else {
#pragma unroll 1
            for (int it = 0; it < 8; ++it) {
                const int tok = it * 8 + wid;
                float s[8];
#pragma unroll
                for (int i = 0; i < 8; ++i) s[i] = bb[i];
#pragma unroll
                for (int j = 0; j < 4; ++j) {
                    float x[8];
                    const int n = item * 16 + (tok >> 2), e = (tok & 3) + j;
                    if (e < 3) load8_f32(a.in[I_SCA] + (size_t)(n * 3 + e) * DL + 8 * lane, x); else load8_bf16(XA + (size_t)(MP + 4 * n + e - 3) * DL + 8 * lane, x);
#pragma unroll
                    for (int i = 0; i < 8; ++i) s[i] += w[j][i] * x[i];
                }
                *(LAS v4u*)(lds + lane * LRU_CS + tok * 16) = pack8(s);
            }
        }
    }
    __syncthreads();
    const int r32 = lane & 31, hi = lane >> 5;
    float hc0 = 0.f, hc1 = 0.f, At0 = 1.f, At1 = 1.f;
    if (MODE == 1) {
#pragma unroll 1
        for (int c0 = 0; c0 < chunk; c0 += 16) {
            float ca0[16], cb0[16], ca1[16], cb1[16];
#pragma unroll
            for (int u = 0; u < 16; ++u) { const int c = c0 + u; const size_t o = (size_t)(seq * 64 + (c < chunk ? c : 0)) * DL + 64 * g + r32;
                ca0[u] = AGGA[o]; cb0[u] = AGGB[o]; ca1[u] = AGGA[o + 32]; cb1[u] = AGGB[o + 32]; }
#pragma unroll
            for (int u = 0; u < 16; ++u) if (c0 + u < chunk) { hc0 = ca0[u] * hc0 + cb0[u]; hc1 = ca1[u] * hc1 + cb1[u]; }
        }
    }
#pragma unroll 1
    for (int mc = 0; mc < 4; ++mc) {
        const int mt = mc >> 1, ct = mc & 1;
        const int ch = 64 * g + 32 * ct + r32;
        float hcur = ct ? hc1 : hc0, Atc = ct ? At1 : At0;
        bf16x8 af[4];
#pragma unroll
        for (int ks = 0; ks < 4; ++ks) af[ks] = *(const LAS bf16x8*)(lds + (8 * g + 2 * ks + hi) * LRU_CS + (32 * mt + r32) * 16);
        f32x16 D[3];
        const bf16* wlp = WL + (size_t)((g * 192 + 32 * ct + r32) * 64 + 8 * hi);
#pragma unroll
        for (int o = 0; o < 3; ++o) {
            D[o] = f32x16{};
#pragma unroll
            for (int ks = 0; ks < 4; ++ks) {
                const bf16x8 bfr = *(const bf16x8*)(wlp + o * 64 * 64 + 16 * ks);
                D[o] = __builtin_amdgcn_mfma_f32_32x32x16_bf16(af[ks], bfr, D[o], 0, 0, 0);
            }
        }
        const float br = a.in[I_BR][ch], bi = a.in[I_BI][ch], c8 = C8[ch];
        float av[16], uv[16];
#pragma unroll
        for (int r = 0; r < 16; ++r) {
            const float rr = sigmoidf_(D[0][r] + br), gi = sigmoidf_(D[1][r] + bi);
            const float la = -c8 * rr; av[r] = __expf(la); uv[r] = __builtin_amdgcn_sqrtf(one_minus_exp(2.f * la)) * gi * D[2][r];
        }
        if (MODE == 2) {
#pragma unroll
            for (int k = 0; k < 4; ++k) {
                const int n = item * 16 + 8 * mt + 2 * k + hi;
                float hh = a.in[I_SLH][(size_t)n * DL + ch];
#pragma unroll
                for (int i = 0; i < 4; ++i) { hh = av[4 * k + i] * hh + uv[4 * k + i]; uv[4 * k + i] = hh; }
                a.out[O_SLH + (size_t)n * DL + ch] = hh;
            }
        } else {
#pragma unroll
            for (int k = 0; k < 4; ++k) {
                const float a0 = av[4 * k], a1 = av[4 * k + 1], a2 = av[4 * k + 2], a3 = av[4 * k + 3];
                const float GAm = (a0 * a1) * (a2 * a3), GBm = ((uv[4 * k] * a1 + uv[4 * k + 1]) * a2 + uv[4 * k + 2]) * a3 + uv[4 * k + 3];
                const float Ao = __shfl_xor(GAm, 32), Bo = __shfl_xor(GBm, 32);
                const float A1 = hi ? Ao : GAm, B1 = hi ? Bo : GBm, A2 = hi ? GAm : Ao, B2 = hi ? GBm : Bo;
                const float hin1 = hcur; hcur = A1 * hcur + B1; const float hin2 = hcur; hcur = A2 * hcur + B2; Atc *= A1 * A2;
                if (MODE == 1) { float hh = hi ? hin2 : hin1;
#pragma unroll
                    for (int i = 0; i < 4; ++i) { hh = av[4 * k + i] * hh + uv[4 * k + i]; uv[4 * k + i] = hh; } }
            }
        }
        if (MODE != 0) {
            const bf16* gap = GAb + (size_t)(row0 + 32 * mt + 4 * hi) * DL + ch; bf16* mxp = MIX + (size_t)(row0 + 32 * mt + 4 * hi) * DM + ch;
            bf16 gv[16];
#pragma unroll
            for (int r = 0; r < 16; ++r) gv[r] = gap[((r & 3) + 8 * (r >> 2)) * DL];
#pragma unroll
            for (int r = 0; r < 16; ++r) { const int ro = (r & 3) + 8 * (r >> 2); mxp[ro * DM] = (bf16)f2bf(uv[r] * gelu_tanh(bf2f(gv[r]))); }
        }
        if (ct) { hc1 = hcur; At1 = Atc; } else { hc0 = hcur; At0 = Atc; }
    }
#pragma unroll
    for (int ct = 0; ct < 2; ++ct) {
        const int ch = 64 * g + 32 * ct + r32; const float Af = ct ? At1 : At0, hf = ct ? hc1 : hc0;
        if (MODE == 0) { if (hi == 0) { AGGA[(size_t)(seq * 64 + chunk) * DL + ch] = Af; AGGB[(size_t)(seq * 64 + chunk) * DL + ch] = hf; } }
        if (MODE == 1) { if (chunk == 63 && hi == 0) a.out[O_PLH + (size_t)seq * DL + ch] = hf; }
    }
    __syncthreads();
}

constexpr int CW_LRUF = 16384;
constexpr int LRF_CS = 1024, LRF_GA = 64 * LRF_CS;
__device__ __forceinline__ void lru_fused_item(const Args& a, int item, LAS unsigned char* lds, int wid, int lane) {
    unsigned char* ws = a.ws;
    const bf16* XA = (const bf16*)(ws + WS_XA); const bf16* GAb = (const bf16*)(ws + WS_GA); const bf16* WL = (const bf16*)(ws + WS_WL);
    const float* C8 = (const float*)(ws + WS_C8); unsigned long long* AGG2 = (unsigned long long*)(ws + WS_AGGA); bf16* MIX = (bf16*)(ws + WS_MIX);
    unsigned* flags = (unsigned*)(ws + WS_CTL) + CW_LRUF;
    asm volatile("" : "+v"(lane));
    const int seq = item >> 6, chunk = item & 63, g = wid;
    const int row0 = seq * SEQ + chunk * 64;
    {
        float w[4][8], bb[8];
#pragma unroll
        for (int j = 0; j < 4; ++j) load8_f32(a.in[I_CAW] + j * DL + 8 * lane, w[j]);
        load8_f32(a.in[I_CAB] + 8 * lane, bb);
        v4u xr[11];
#pragma unroll
        for (int k = 0; k < 11; ++k) { const int t = chunk * 64 + wid * 8 - 3 + k;
            if (t >= 0) xr[k] = *(const v4u*)(XA + (size_t)(seq * SEQ + t) * DL + 8 * lane); else xr[k] = (v4u){0u, 0u, 0u, 0u}; }
#pragma unroll
        for (int it = 0; it < 8; ++it) {
            float s8[8];
#pragma unroll
            for (int i = 0; i < 8; ++i) s8[i] = bb[i];
#pragma unroll
            for (int j = 0; j < 4; ++j) { float x[8]; unpack8(xr[it + j], x);
#pragma unroll
                for (int i = 0; i < 8; ++i) s8[i] += w[j][i] * x[i]; }
            *(LAS v4u*)(lds + lane * LRF_CS + (wid * 8 + it) * 16) = pack8(s8);
        }
#pragma unroll
        for (int it = 0; it < 8; ++it) xr[it] = *(const v4u*)(GAb + (size_t)(row0 + wid * 8 + it) * DL + 8 * lane);
#pragma unroll
        for (int it = 0; it < 8; ++it) *(LAS v4u*)(lds + LRF_GA + (wid * 8 + it) * 1024 + lane * 16) = xr[it];
    }
    __syncthreads();
    int r32 = lane & 31, hi = lane >> 5;
    unsigned pk[4][16];
    float At0 = 1.f, At1 = 1.f, Bt0 = 0.f, Bt1 = 0.f;
    bf16x8 bw[2][4];
#pragma unroll
    for (int mc = 0; mc < 4; ++mc) {
        const int ct = mc >> 1, mt = mc & 1;
        if (mt == 0) {
#pragma unroll
            for (int o = 0; o < 2; ++o)
#pragma unroll
                for (int ks = 0; ks < 4; ++ks) bw[o][ks] = *(const bf16x8*)(WL + (size_t)((g * 192 + 64 * o + 32 * ct + r32) * 64 + 16 * ks + 8 * hi));
        }
        const int ch = 64 * g + 32 * ct + r32;
        bf16x8 af[4];
#pragma unroll
        for (int ks = 0; ks < 4; ++ks) af[ks] = *(const LAS bf16x8*)(lds + (8 * g + 2 * ks + hi) * LRF_CS + (32 * mt + r32) * 16);
        f32x16 D[3];
#pragma unroll
        for (int o = 0; o < 2; ++o) {
            D[o] = f32x16{};
#pragma unroll
            for (int ks = 0; ks < 4; ++ks) D[o] = __builtin_amdgcn_mfma_f32_32x32x16_bf16(af[ks], bw[o][ks], D[o], 0, 0, 0);
        }
        {
            const LAS unsigned short* xp = (const LAS unsigned short*)(lds + (8 * g + 4 * ct + (r32 >> 3)) * LRF_CS + (32 * mt + 4 * hi) * 16 + (r32 & 7) * 2);
#pragma unroll
            for (int r = 0; r < 16; ++r) D[2][r] = bf2f(xp[((r & 3) + 8 * (r >> 2)) * 8]);
        }
        const float br = a.in[I_BR][ch], bi = a.in[I_BI][ch], c8 = C8[ch];
#pragma unroll
        for (int r = 0; r < 16; ++r) {
            const float rr = sigmoidf_(D[0][r] + br), gi = sigmoidf_(D[1][r] + bi);
            const float la = -c8 * rr, oma = one_minus_exp(la); pk[2 * mt + ct][r] = pk2(oma, __builtin_amdgcn_sqrtf(oma * (2.f - oma)) * gi * D[2][r]);
        }
        float Atc = ct ? At1 : At0, Btc = ct ? Bt1 : Bt0;
#pragma unroll
        for (int k = 0; k < 4; ++k) {
            const float a0 = 1.f - bflo(pk[2 * mt + ct][4 * k]), a1 = 1.f - bflo(pk[2 * mt + ct][4 * k + 1]), a2 = 1.f - bflo(pk[2 * mt + ct][4 * k + 2]), a3 = 1.f - bflo(pk[2 * mt + ct][4 * k + 3]);
            const float GAm = (a0 * a1) * (a2 * a3), GBm = ((bfhi(pk[2 * mt + ct][4 * k]) * a1 + bfhi(pk[2 * mt + ct][4 * k + 1])) * a2 + bfhi(pk[2 * mt + ct][4 * k + 2])) * a3 + bfhi(pk[2 * mt + ct][4 * k + 3]);
            const float Ao = __shfl_xor(GAm, 32), Bo = __shfl_xor(GBm, 32);
            const float A1 = hi ? Ao : GAm, B1 = hi ? Bo : GBm, A2 = hi ? GAm : Ao, B2 = hi ? GBm : Bo;
            Btc = A1 * Btc + B1; Btc = A2 * Btc + B2; Atc *= A1 * A2;
        }
        if (ct) { At1 = Atc; Bt1 = Btc; } else { At0 = Atc; Bt0 = Btc; }
        asm volatile("" ::: "memory");
    }
    if (hi == 0) {
        __hip_atomic_store(AGG2 + (size_t)(seq * 64 + chunk) * DL + 64 * g + r32, ((unsigned long long)__float_as_uint(Bt0) << 32) | __float_as_uint(At0), __ATOMIC_RELAXED, __HIP_MEMORY_SCOPE_AGENT);
        __hip_atomic_store(AGG2 + (size_t)(seq * 64 + chunk) * DL + 64 * g + 32 + r32, ((unsigned long long)__float_as_uint(Bt1) << 32) | __float_as_uint(At1), __ATOMIC_RELAXED, __HIP_MEMORY_SCOPE_AGENT);
    }
    asm volatile("s_waitcnt vmcnt(0)" ::: "memory");
    if (lane == 0) __hip_atomic_store(flags + (size_t)((seq * 64 + chunk) * 8 + g) * 16, 1u, __ATOMIC_RELAXED, __HIP_MEMORY_SCOPE_AGENT);
    {
        const unsigned* fp = flags + (size_t)((seq * 64 + (lane < chunk ? lane : 0)) * 8 + g) * 16;
        unsigned spins = 0;
        for (;;) {
            const unsigned v = (lane < chunk) ? __hip_atomic_load(fp, __ATOMIC_RELAXED, __HIP_MEMORY_SCOPE_AGENT) : 1u;
            if (__all(v != 0u)) break;
            if (++spins > (1u << 20)) break;
            __builtin_amdgcn_s_sleep(2);
        }
        asm volatile("" ::: "memory");
    }
    float hc0, hc1;
    {
        const int cmid = chunk >> 1, cb = hi ? cmid : 0, ce = hi ? chunk : cmid;
        float A0 = 1.f, B0 = 0.f, A1 = 1.f, B1 = 0.f;
#pragma unroll 1
        for (int c0 = cb; c0 < ce; c0 += 12) {
            unsigned long long p0[12], p1[12];
#pragma unroll
            for (int u = 0; u < 12; ++u) { const int c = c0 + u; const size_t o = (size_t)(seq * 64 + (c < ce ? c : cb)) * DL + 64 * g + r32;
                p0[u] = __hip_atomic_load(AGG2 + o, __ATOMIC_RELAXED, __HIP_MEMORY_SCOPE_AGENT); p1[u] = __hip_atomic_load(AGG2 + o + 32, __ATOMIC_RELAXED, __HIP_MEMORY_SCOPE_AGENT); }
#pragma unroll
            for (int u = 0; u < 12; ++u) if (c0 + u < ce) {
                const float a0 = __uint_as_float((unsigned)p0[u]), b0 = __uint_as_float((unsigned)(p0[u] >> 32)), a1 = __uint_as_float((unsigned)p1[u]), b1 = __uint_as_float((unsigned)(p1[u] >> 32));
                B0 = a0 * B0 + b0; A0 *= a0; B1 = a1 * B1 + b1; A1 *= a1; }
        }
        const float Bl0 = __shfl_xor(B0, 32), Bl1 = __shfl_xor(B1, 32);
        const float lo0 = hi ? Bl0 : B0, lo1 = hi ? Bl1 : B1;
        const float Ah0 = __shfl_xor(A0, 32), Ah1 = __shfl_xor(A1, 32);
        const float uA0 = hi ? A0 : Ah0, uA1 = hi ? A1 : Ah1, uB0 = hi ? B0 : Bl0, uB1 = hi ? B1 : Bl1;
        hc0 = uA0 * lo0 + uB0; hc1 = uA1 * lo1 + uB1;
    }
#pragma unroll
    for (int mc = 0; mc < 4; ++mc) {
        const int mt = mc >> 1, ct = mc & 1;
        asm volatile("" : "+v"(r32), "+v"(hi));
        const int ch = 64 * g + 32 * ct + r32;
        float hcur = ct ? hc1 : hc0;
        LAS unsigned short* gy = (LAS unsigned short*)(lds + LRF_GA + (32 * mt + 4 * hi) * 1024 + (32 * ct + 64 * g + r32) * 2);
#pragma unroll
        for (int k = 0; k < 4; ++k) {
            const float a0 = 1.f - bflo(pk[mc][4 * k]), a1 = 1.f - bflo(pk[mc][4 * k + 1]), a2 = 1.f - bflo(pk[mc][4 * k + 2]), a3 = 1.f - bflo(pk[mc][4 * k + 3]);
            const float GAm = (a0 * a1) * (a2 * a3), GBm = ((bfhi(pk[mc][4 * k]) * a1 + bfhi(pk[mc][4 * k + 1])) * a2 + bfhi(pk[mc][4 * k + 2])) * a3 + bfhi(pk[mc][4 * k + 3]);
            const float Ao = __shfl_xor(GAm, 32), Bo = __shfl_xor(GBm, 32);
            const float A1 = hi ? Ao : GAm, B1 = hi ? Bo : GBm, A2 = hi ? GAm : Ao, B2 = hi ? GBm : Bo;
            const float hin1 = hcur; hcur = A1 * hcur + B1; const float hin2 = hcur; hcur = A2 * hcur + B2;
            float hh = hi ? hin2 : hin1;
#pragma unroll
            for (int i = 0; i < 4; ++i) { hh = (1.f - bflo(pk[mc][4 * k + i])) * hh + bfhi(pk[mc][4 * k + i]); pk[mc][4 * k + i] = __float_as_uint(hh); }
        }
#pragma unroll
        for (int r = 0; r < 16; ++r) { const int ro = (r & 3) + 8 * (r >> 2); gy[ro * 512] = (unsigned short)(pk2(__uint_as_float(pk[mc][r]) * gelu_tanh(bf2f(gy[ro * 512])), 0.f) & 0xffffu); }
        if (ct) hc1 = hcur; else hc0 = hcur;
        asm volatile("" ::: "memory");
    }
    __syncthreads();
    {
        const int tid_ = wid * 64 + lane;
#pragma unroll
        for (int i = 0; i < 8; ++i) { const int pc = tid_ + NTHR * i, tok = pc >> 6, c16 = pc & 63;
            *(v4u*)(MIX + (size_t)(row0 + tok) * DM + c16 * 8) = *(const LAS v4u*)(lds + LRF_GA + tok * 1024 + c16 * 16); }
    }
    if (chunk == 63 && hi == 0) { a.out[O_PLH + (size_t)seq * DL + 64 * g + r32] = hc0; a.out[O_PLH + (size_t)seq * DL + 64 * g + 32 + r32] = hc1; }
    __syncthreads();
}

constexpr int NK = 384, KCS = NK * 16 + 16, VDS = NK * 64 + 64, ATT_K = 0, ATT_V = 8 * KCS, ATT_WS = ATT_V + 2 * VDS;
static_assert(ATT_WS + NWAVES * 256 <= RING_BYTES, "attention LDS");
__device__ __forceinline__ s16x4 vtr(const LAS unsigned char* p) { typedef short v4i16_t __attribute__((ext_vector_type(4))); return __builtin_bit_cast(s16x4, __builtin_amdgcn_ds_read_tr16_b64_v4i16((LAS v4i16_t*)p)); }

__device__ __forceinline__ void attn_prompt_unit(const Args& a, int unit, LAS unsigned char* lds, int tid, int wid, int lane) {
    unsigned char* ws = a.ws;
    const bf16* Qb = (const bf16*)(ws + WS_Q); const bf16* Kb = (const bf16*)(ws + WS_K); const bf16* Vb = (const bf16*)(ws + WS_V);
    bf16* OP = (bf16*)(ws + WS_OP); float* LSE = (float*)(ws + WS_LSE);
    const int u16 = unit & 15, p = (unit >> 4) % 3, bh = unit / 48, b = bh >> 3, h = bh & 7;
    const int ld = 2 * p, d = 1 << ld;
    const int lnb = 4 - ld, blk = u16 & ((1 << lnb) - 1), r = u16 >> lnb;
    const int j0 = 256 * blk - 128;
    const int kk_min = (blk == 0) ? 128 : 0;
    const size_t rowb = (size_t)b * SEQ;
#pragma unroll
    for (int i = 0; i < 6; ++i) {
        const int piece = tid + NTHR * i, kk = piece >> 3, c = piece & 7;
        if (kk >= kk_min) {
            const size_t row = rowb + (size_t)(r + d * (j0 + kk));
            const v4u kv = *(const v4u*)(Kb + row * 512 + h * 64 + c * 8), vv = *(const v4u*)(Vb + row * 512 + h * 64 + c * 8);
            *(LAS v4u*)(lds + ATT_K + c * KCS + kk * 16) = kv;
            *(LAS v4u*)(lds + ATT_V + (c >> 2) * VDS + kk * 64 + (c & 3) * 16) = vv;
        }
    }
    const int r32 = lane & 31, hi = lane >> 5;
    bf16x8 qr[4];
    { const size_t qrow = rowb + (size_t)(r + d * (256 * blk + 32 * wid + r32));
#pragma unroll
      for (int ks = 0; ks < 4; ++ks) qr[ks] = *(const bf16x8*)(Qb + qrow * 512 + h * 64 + 16 * ks + 8 * hi); }
    __syncthreads();
    const int kt0 = (blk == 0 && wid < 4) ? 4 - wid : 0;
    f32x16 pt[5];
#pragma unroll
    for (int kt = 0; kt < 5; ++kt) {
        if (kt >= kt0) {
            const int T = wid + kt; f32x16 acc = f32x16{};
#pragma unroll
            for (int ks = 0; ks < 4; ++ks) { const bf16x8 kf = *(const LAS bf16x8*)(lds + ATT_K + (2 * ks + hi) * KCS + (32 * T + r32) * 16);
                acc = __builtin_amdgcn_mfma_f32_32x32x16_bf16(kf, qr[ks], acc, 0, 0, 0); }
            if (kt == 0) {
#pragma unroll
                for (int rg = 0; rg < 16; ++rg) if (crow(rg, hi) < r32) acc[rg] = -INFINITY; }
            if (kt == 4) {
#pragma unroll
                for (int rg = 0; rg < 16; ++rg) if (crow(rg, hi) > r32) acc[rg] = -INFINITY; }
            pt[kt] = acc;
        } else {
#pragma unroll
            for (int rg = 0; rg < 16; ++rg) pt[kt][rg] = -INFINITY;
        }
    }
    float mx = -INFINITY;
#pragma unroll
    for (int kt = 0; kt < 5; ++kt)
#pragma unroll
        for (int rg = 0; rg < 16; ++rg) mx = fmaxf(mx, pt[kt][rg]);
    mx = fmaxf(mx, __shfl_xor(mx, 32));
    float lsum = 0.f;
#pragma unroll
    for (int kt = 0; kt < 5; ++kt)
#pragma unroll
        for (int rg = 0; rg < 16; ++rg) { const float e = __builtin_amdgcn_exp2f(pt[kt][rg] - mx); pt[kt][rg] = e; lsum += e; }
    lsum += __shfl_xor(lsum, 32);
    f32x16 o[2]; o[0] = f32x16{}; o[1] = f32x16{};
    const LAS unsigned char* vb = lds + ATT_V + ((lane >> 4) & 1) * 32 + (lane & 3) * 8 + (4 * hi + ((lane & 15) >> 2)) * 64;
#pragma unroll
    for (int kt = 0; kt < 5; ++kt) {
        if (kt >= kt0) {
            const int T = wid + kt;
#pragma unroll
            for (int s = 0; s < 2; ++s) {
                v4u pw; pw.x = pg8::cvt_pk_bf16(pt[kt][8 * s], pt[kt][8 * s + 1]); pw.y = pg8::cvt_pk_bf16(pt[kt][8 * s + 2], pt[kt][8 * s + 3]);
                pw.z = pg8::cvt_pk_bf16(pt[kt][8 * s + 4], pt[kt][8 * s + 5]); pw.w = pg8::cvt_pk_bf16(pt[kt][8 * s + 6], pt[kt][8 * s + 7]);
                const bf16x8 pa = __builtin_bit_cast(bf16x8, pw);
#pragma unroll
                for (int d0 = 0; d0 < 2; ++d0) {
                    const LAS unsigned char* vp = vb + d0 * VDS + (32 * T + 16 * s) * 64;
                    const s16x4 lo = vtr(vp), hh = vtr(vp + 512);
                    const bf16x8 vf = (bf16x8){lo[0], lo[1], lo[2], lo[3], hh[0], hh[1], hh[2], hh[3]};
                    o[d0] = __builtin_amdgcn_mfma_f32_32x32x16_bf16(pa, vf, o[d0], 0, 0, 0);
                }
            }
        }
    }
    LAS float* wsf = (LAS float*)(lds + ATT_WS) + wid * 64;
    if (hi == 0) wsf[r32] = __builtin_amdgcn_rcpf(lsum);
    const size_t qrow_l = rowb + (size_t)(r + d * (256 * blk + 32 * wid + r32));
    if (hi == 0) LSE[((size_t)p * MP + qrow_l) * 8 + h] = mx + __builtin_amdgcn_logf(lsum);
    LDS_WAIT(); asm volatile("" ::: "memory");
#pragma unroll
    for (int rg = 0; rg < 16; ++rg) {
        const int qi = crow(rg, hi); const float rl = wsf[qi];
        const size_t orow = rowb + (size_t)(r + d * (256 * blk + 32 * wid + qi));
        bf16* op = OP + ((size_t)p * MP + orow) * 512 + h * 64 + r32;
        { const unsigned w2 = pk2(o[0][rg] * rl, o[1][rg] * rl); op[0] = (bf16)(w2 & 0xffffu); op[32] = (bf16)(w2 >> 16); }
    }
    __syncthreads();
}

constexpr int AP_K = 0, AP_KCS = NK * 16, AP_V = 8 * AP_KCS, AP_VDS = NK * 64, AP_VBUF = 2 * AP_VDS, AP_WS = AP_V + 2 * AP_VBUF;
static_assert(AP_WS + NWAVES * 256 <= LDSCTL_OFF, "pipelined attention LDS");
struct APUnit { int b, h, p, d, r, blk; };
__device__ __forceinline__ APUnit ap_decode(int unit) { APUnit u; const int u16 = unit & 15; u.p = (unit >> 4) % 3; const int bh = unit / 48; u.b = bh >> 3; u.h = bh & 7;
    const int ld = 2 * u.p; u.d = 1 << ld; const int lnb = 4 - ld; u.blk = u16 & ((1 << lnb) - 1); u.r = u16 >> lnb; return u; }
__device__ __forceinline__ void ap_issue_k(const APUnit& u, const bf16* Kb, LAS unsigned char* lds, int wid, int lane) {
#pragma unroll
    for (int i = 0; i < 6; ++i) { const int j = wid + 8 * i, c = j & 7, kb = j >> 3;
        if (u.blk == 0 && kb < 2) continue;
        const size_t row = (size_t)u.b * SEQ + (size_t)(u.r + u.d * (256 * u.blk - 128 + 64 * kb + lane));
        __builtin_amdgcn_global_load_lds((const unsigned*)(Kb + row * 512 + u.h * 64 + c * 8), (LAS unsigned*)(lds + AP_K + c * AP_KCS + kb * 1024), 16, 0, 0); }
}
__device__ __forceinline__ void ap_issue_v(const APUnit& u, const bf16* Vb, LAS unsigned char* lds, int vbuf, int wid, int lane) {
#pragma unroll
    for (int i = 0; i < 6; ++i) { const int j = wid + 8 * i, dh = j & 1, kb16 = j >> 1;
        if (u.blk == 0 && kb16 < 8) continue;
        const size_t row = (size_t)u.b * SEQ + (size_t)(u.r + u.d * (256 * u.blk - 128 + 16 * kb16 + (lane >> 2)));
        __builtin_amdgcn_global_load_lds((const unsigned*)(Vb + row * 512 + u.h * 64 + dh * 32 + (lane & 3) * 8), (LAS unsigned*)(lds + AP_V + vbuf * AP_VBUF + dh * AP_VDS + kb16 * 1024), 16, 0, 0); }
}
__device__ __forceinline__ void ap_load_q(const APUnit& u, const bf16* Qb, bf16x8 (&qr)[4], int wid, int lane) {
    const int r32 = lane & 31, hi = lane >> 5;
    const size_t qrow = (size_t)u.b * SEQ + (size_t)(u.r + u.d * (256 * u.blk + 32 * wid + r32));
#pragma unroll
    for (int ks = 0; ks < 4; ++ks) qr[ks] = *(const bf16x8*)(Qb + qrow * 512 + u.h * 64 + 16 * ks + 8 * hi);
}
__device__ __forceinline__ void attn_prompt_phase(const Args& a, LAS unsigned char* lds, int bx, int G, int n_units, int tid, int wid, int lane) {
    unsigned char* ws = a.ws;
    const bf16* Qb = (const bf16*)(ws + WS_Q); const bf16* Kb = (const bf16*)(ws + WS_K); const bf16* Vb = (const bf16*)(ws + WS_V);
    bf16* OP = (bf16*)(ws + WS_OP); float* LSE = (float*)(ws + WS_LSE);
    const int r32 = lane & 31, hi = lane >> 5;
    if (bx >= n_units) return;
    APUnit cur = ap_decode(bx);
    bf16x8 qn[4];
    ap_issue_k(cur, Kb, lds, wid, lane); ap_issue_v(cur, Vb, lds, 0, wid, lane); ap_load_q(cur, Qb, qn, wid, lane);
    int vb_i = 0;
#pragma unroll 1
    for (int unit = bx; unit < n_units; unit += G, vb_i ^= 1) {
        const bool has_next = unit + G < n_units;
        APUnit nxt = cur; if (has_next) nxt = ap_decode(unit + G);
        asm volatile("s_waitcnt vmcnt(0)" ::: "memory"); __syncthreads();
        if (has_next) ap_issue_v(nxt, Vb, lds, vb_i ^ 1, wid, lane);
        bf16x8 qr[4];
#pragma unroll
        for (int ks = 0; ks < 4; ++ks) qr[ks] = qn[ks];
        const int kt0 = (cur.blk == 0 && wid < 4) ? 4 - wid : 0;
        f32x16 pt[5];
#pragma unroll
        for (int kt = 0; kt < 5; ++kt) {
            if (kt >= kt0) {
                const int T = wid + kt; f32x16 acc = f32x16{};
#pragma unroll
                for (int ks = 0; ks < 4; ++ks) { const bf16x8 kf = *(const LAS bf16x8*)(lds + AP_K + (2 * ks + hi) * AP_KCS + (32 * T + r32) * 16);
                    acc = __builtin_amdgcn_mfma_f32_32x32x16_bf16(kf, qr[ks], acc, 0, 0, 0); }
                if (kt == 0) {
#pragma unroll
                    for (int rg = 0; rg < 16; ++rg) if (crow(rg, hi) < r32) acc[rg] = -INFINITY; }
                if (kt == 4) {
#pragma unroll
                    for (int rg = 0; rg < 16; ++rg) if (crow(rg, hi) > r32) acc[rg] = -INFINITY; }
                pt[kt] = acc;
            } else {
#pragma unroll
                for (int rg = 0; rg < 16; ++rg) pt[kt][rg] = -INFINITY;
            }
        }
        asm volatile("s_waitcnt lgkmcnt(0)" ::: "memory"); __syncthreads();
        if (has_next) { ap_issue_k(nxt, Kb, lds, wid, lane); ap_load_q(nxt, Qb, qn, wid, lane); }
        float mx = -INFINITY;
#pragma unroll
        for (int kt = 0; kt < 5; ++kt)
#pragma unroll
            for (int rg = 0; rg < 16; ++rg) mx = fmaxf(mx, pt[kt][rg]);
        mx = fmaxf(mx, __shfl_xor(mx, 32));
        float lsum = 0.f;
#pragma unroll
        for (int kt = 0; kt < 5; ++kt)
#pragma unroll
            for (int rg = 0; rg < 16; ++rg) { const float e = __builtin_amdgcn_exp2f(pt[kt][rg] - mx); pt[kt][rg] = e; lsum += e; }
        lsum += __shfl_xor(lsum, 32);
        f32x16 o[2]; o[0] = f32x16{}; o[1] = f32x16{};
        const LAS unsigned char* vb = lds + AP_V + vb_i * AP_VBUF + ((lane >> 4) & 1) * 32 + (lane & 3) * 8 + (4 * hi + ((lane & 15) >> 2)) * 64;
#pragma unroll
        for (int kt = 0; kt < 5; ++kt) {
            if (kt >= kt0) {
                const int T = wid + kt;
#pragma unroll
                for (int s2 = 0; s2 < 2; ++s2) {
                    v4u pw; pw.x = pg8::cvt_pk_bf16(pt[kt][8 * s2], pt[kt][8 * s2 + 1]); pw.y = pg8::cvt_pk_bf16(pt[kt][8 * s2 + 2], pt[kt][8 * s2 + 3]);
                    pw.z = pg8::cvt_pk_bf16(pt[kt][8 * s2 + 4], pt[kt][8 * s2 + 5]); pw.w = pg8::cvt_pk_bf16(pt[kt][8 * s2 + 6], pt[kt][8 * s2 + 7]);
                    const bf16x8 pa = __builtin_bit_cast(bf16x8, pw);
#pragma unroll
                    for (int d0 = 0; d0 < 2; ++d0) {
                        const LAS unsigned char* vp = vb + d0 * AP_VDS + (32 * T + 16 * s2) * 64;
                        const s16x4 lo = vtr(vp), hh = vtr(vp + 512);
                        const bf16x8 vf = (bf16x8){lo[0], lo[1], lo[2], lo[3], hh[0], hh[1], hh[2], hh[3]};
                        o[d0] = __builtin_amdgcn_mfma_f32_32x32x16_bf16(pa, vf, o[d0], 0, 0, 0);
                    }
                }
            }
        }
        LAS float* wsf = (LAS float*)(lds + AP_WS) + wid * 64;
        if (hi == 0) wsf[r32] = __builtin_amdgcn_rcpf(lsum);
        const size_t rowb = (size_t)cur.b * SEQ;
        const size_t qrow_l = rowb + (size_t)(cur.r + cur.d * (256 * cur.blk + 32 * wid + r32));
        if (hi == 0) LSE[((size_t)cur.p * MP + qrow_l) * 8 + cur.h] = mx + __builtin_amdgcn_logf(lsum);
        LDS_WAIT(); asm volatile("" ::: "memory");
#pragma unroll
        for (int rg = 0; rg < 16; ++rg) {
            const int qi = crow(rg, hi); const float rl = wsf[qi];
            const size_t orow = rowb + (size_t)(cur.r + cur.d * (256 * cur.blk + 32 * wid + qi));
            bf16* op = OP + ((size_t)cur.p * MP + orow) * 512 + cur.h * 64 + r32;
            { const unsigned w2 = pk2(o[0][rg] * rl, o[1][rg] * rl); op[0] = (bf16)(w2 & 0xffffu); op[32] = (bf16)(w2 >> 16); }
        }
        cur = nxt;
    }
    asm volatile("s_waitcnt vmcnt(0) lgkmcnt(0)" ::: "memory"); __syncthreads();
}

__device__ __forceinline__ void attn_sample_item(const Args& a, int item, LAS unsigned char* lds, int tid, int wid, int lane) {
    unsigned char* ws = a.ws;
    const float* QS = (const float*)(ws + WS_QS); bf16* MIX = (bf16*)(ws + WS_MIX);
    const float* CK = a.in[I_CK]; const float* CV = a.in[I_CV];
    asm volatile("" : "+v"(lane));
    const int n = item >> 3, h = item & 7, sub = lane & 15, grp = lane >> 4;
    f32x4 q[4];
#pragma unroll
    for (int s = 0; s < 4; ++s) q[s] = *(const f32x4*)(QS + (size_t)(4 * n + s) * 512 + h * 64 + 4 * sub);
    float m[4], l[4]; f32x4 O[4];
#pragma unroll
    for (int s = 0; s < 4; ++s) { m[s] = -1e30f; l[s] = 0.f; O[s] = (f32x4){0.f, 0.f, 0.f, 0.f}; }
#define SA_ROW(t_) (((t_) < 16) ? 1536 + (t_) * 32 + wid * 4 + grp : 16 * ((((t_) - 16) * 32 + wid * 4 + grp) >> 2) + (grp & 3))
#define SA_OFF(idx_) ((((size_t)n * 2048 + (idx_)) * 8 + h) * 64 + 4 * sub)
    const f32x4 qo = grp == 0 ? q[0] : grp == 1 ? q[1] : grp == 2 ? q[2] : q[3];
    const float cown = (wid & 3) == 0 ? 2.f : 1.f;
    float mo = -1e30f, lo = 0.f; f32x4 Oo = (f32x4){0.f, 0.f, 0.f, 0.f};
    LAS unsigned char* ring = lds + wid * 16384;
#define SA_DMA(j_) do { const int t_ = (j_) < 12 ? (j_) : (j_) + 4; const size_t o_ = SA_OFF(SA_ROW(t_)); \
        __builtin_amdgcn_global_load_lds((const unsigned*)(CK + o_), (LAS unsigned*)(ring + ((j_) & 7) * 2048), 16, 0, 2); \
        __builtin_amdgcn_global_load_lds((const unsigned*)(CV + o_), (LAS unsigned*)(ring + ((j_) & 7) * 2048 + 1024), 16, 0, 2); } while (0)
#pragma unroll
    for (int j = 0; j < 8; ++j) SA_DMA(j);
#define SA_GEN(NU, kv, vv, idxs) do { float d[NU][4]; int c[NU][4]; \
        _Pragma("unroll") for (int u = 0; u < NU; ++u) { const int idx = idxs[u]; \
            _Pragma("unroll") for (int s = 0; s < 4; ++s) { \
                float dt = (q[s][0] * kv[u][0] + q[s][1] * kv[u][1]) + (q[s][2] * kv[u][2] + q[s][3] * kv[u][3]); \
                dt += dpp_f(dt, 0xB1); dt += dpp_f(dt, 0x4E); dt += dpp_f(dt, 0x141); dt += dpp_f(dt, 0x140); \
                int cc; \
                if (idx < 2048) cc = (idx >= 1920 + s ? 1 : 0) + ((idx >= 1536 && (idx & 3) == s) ? 1 : 0) + ((idx & 15) == s ? 1 : 0); \
                else { const int sp = idx - 2048; cc = (s >= sp ? 1 : 0) + (s == sp ? 2 : 0); } \
                if (idx < 0) cc = 0; \
                d[u][s] = dt; c[u][s] = cc; } } \
        _Pragma("unroll") for (int s = 0; s < 4; ++s) { float mn = m[s]; \
            _Pragma("unroll") for (int u = 0; u < NU; ++u) mn = c[u][s] > 0 ? fmaxf(mn, d[u][s]) : mn; \
            const float sc = __builtin_amdgcn_exp2f(m[s] - mn); l[s] *= sc; O[s] = O[s] * sc; m[s] = mn; \
            _Pragma("unroll") for (int u = 0; u < NU; ++u) { const float pe = (float)c[u][s] * __builtin_amdgcn_exp2f(fminf(d[u][s] - mn, 0.f)); l[s] += pe; O[s] = O[s] + vv[u] * pe; } } } while (0)
    {
        f32x4 kv[4], vv[4]; int idxs[4];
#pragma unroll
        for (int u = 0; u < 4; ++u) { idxs[u] = SA_ROW(12 + u); const size_t o_ = SA_OFF(idxs[u]); kv[u] = *(const f32x4*)(CK + o_); vv[u] = *(const f32x4*)(CV + o_); }
        f32x4 kn[1], vn[1]; int idn[1];
        { const size_t o_ = (size_t)(n * 4 + grp) * 512 + h * 64 + 4 * sub; kn[0] = *(const f32x4*)(a.out + O_SWK + o_); vn[0] = *(const f32x4*)(a.out + O_SWV + o_); idn[0] = wid == 0 ? 2048 + grp : -1; }
        SA_GEN(4, kv, vv, idxs);
        asm volatile("" ::: "memory");
        SA_GEN(1, kn, vn, idn);
    }
#pragma unroll 1
    for (int b = 0; b < 6; ++b) {
        f32x4 kv[4], vv[4];
#pragma unroll
        for (int u = 0; u < 4; ++u) { const int j = 4 * b + u;
            asm volatile("s_waitcnt vmcnt(14)" ::: "memory");
            kv[u] = *(const LAS f32x4*)(ring + (j & 7) * 2048 + lane * 16); vv[u] = *(const LAS f32x4*)(ring + (j & 7) * 2048 + 1024 + lane * 16);
            asm volatile("s_waitcnt lgkmcnt(0)" ::: "memory");
            SA_DMA(j + 8 < 24 ? j + 8 : 23); }
        const float cm = b < 3 ? cown : 1.f;
        float d[4];
#pragma unroll
        for (int u = 0; u < 4; ++u) { float dt = (qo[0] * kv[u][0] + qo[1] * kv[u][1]) + (qo[2] * kv[u][2] + qo[3] * kv[u][3]);
            dt += dpp_f(dt, 0xB1); dt += dpp_f(dt, 0x4E); dt += dpp_f(dt, 0x141); dt += dpp_f(dt, 0x140); d[u] = dt; }
        const float mn = fmaxf(fmaxf(mo, fmaxf(d[0], d[1])), fmaxf(d[2], d[3]));
        const float sc = __builtin_amdgcn_exp2f(mo - mn); lo *= sc; Oo = Oo * sc; mo = mn;
#pragma unroll
        for (int u = 0; u < 4; ++u) { const float pe = cm * __builtin_amdgcn_exp2f(d[u] - mn); lo += pe; Oo = Oo + vv[u] * pe; }
    }
    asm volatile("s_waitcnt vmcnt(0)" ::: "memory");
#undef SA_DMA
#define SA_LD4(x)
#undef SA_LD4
#pragma unroll
    for (int s = 0; s < 4; ++s) if (grp == s) { const float mn = fmaxf(m[s], mo), sa = __builtin_amdgcn_exp2f(m[s] - mn), sb = __builtin_amdgcn_exp2f(mo - mn); l[s] = l[s] * sa + lo * sb; O[s] = O[s] * sa + Oo * sb; m[s] = mn; }
#undef SA_GEN
#undef SA_ROW
#undef SA_OFF
#pragma unroll
    for (int s = 0; s < 4; ++s)
#pragma unroll
        for (int off = 16; off <= 32; off <<= 1) {
            const float mo = __shfl_xor(m[s], off), lo = __shfl_xor(l[s], off);
            f32x4 Oo; Oo[0] = __shfl_xor(O[s][0], off); Oo[1] = __shfl_xor(O[s][1], off); Oo[2] = __shfl_xor(O[s][2], off); Oo[3] = __shfl_xor(O[s][3], off);
            const float mn = fmaxf(m[s], mo); const float sa = (m[s] == mn) ? 1.f : __builtin_amdgcn_exp2f(m[s] - mn), sb = (mo == mn) ? 1.f : __builtin_amdgcn_exp2f(mo - mn);
            l[s] = l[s] * sa + lo * sb; O[s] = O[s] * sa + Oo * sb; m[s] = mn;
        }
    LAS float* red = (LAS float*)(lds + 131072);
    if (grp == 0) {
#pragma unroll
        for (int s = 0; s < 4; ++s) { LAS float* rp = red + (wid * 4 + s) * 68; *(LAS f32x4*)(rp + 4 * sub) = O[s]; if (sub == 0) { rp[64] = m[s]; rp[65] = l[s]; } }
    }
    __syncthreads();
    if (tid < 256) { const int s = tid >> 6, dim = tid & 63; float mm = -1e30f;
#pragma unroll
        for (int w = 0; w < 8; ++w) mm = fmaxf(mm, red[(w * 4 + s) * 68 + 64]);
        float L = 0.f, Ov = 0.f;
#pragma unroll
        for (int w = 0; w < 8; ++w) { const LAS float* rp = red + (w * 4 + s) * 68; const float mw = rp[64]; const float f = __builtin_amdgcn_exp2f(mw - mm); L += rp[65] * f; Ov += rp[dim] * f; }
        MIX[(size_t)(MP + 4 * n + s) * DM + 512 + h * 64 + dim] = (bf16)f2bf(Ov / L); }
    __syncthreads();
}

__device__ __forceinline__ void combine_item(const Args& a, int item, int tid) {
    unsigned char* ws = a.ws;
    const bf16* OP = (const bf16*)(ws + WS_OP); const float* LSE = (const float*)(ws + WS_LSE); bf16* MIX = (bf16*)(ws + WS_MIX);
#pragma unroll 1
    for (int i0 = 0; i0 < 8; i0 += 4) {
        float l[4][3]; v4u xw[4][3];
#pragma unroll
        for (int i = 0; i < 4; ++i) { const int e = tid + NTHR * (i0 + i), row = item * 64 + (e >> 6), hc = e & 63, h = hc >> 3;
#pragma unroll
            for (int p = 0; p < 3; ++p) { l[i][p] = LSE[((size_t)p * MP + row) * 8 + h]; xw[i][p] = *(const v4u*)(OP + ((size_t)p * MP + row) * 512 + hc * 8); } }
#pragma unroll
        for (int i = 0; i < 4; ++i) { const int e = tid + NTHR * (i0 + i), row = item * 64 + (e >> 6), hc = e & 63;
            const float mx = fmaxf(l[i][0], fmaxf(l[i][1], l[i][2])); float w0 = __builtin_amdgcn_exp2f(l[i][0] - mx), w1 = __builtin_amdgcn_exp2f(l[i][1] - mx), w2 = __builtin_amdgcn_exp2f(l[i][2] - mx);
            const float inv = __builtin_amdgcn_rcpf(w0 + w1 + w2); w0 *= inv; w1 *= inv; w2 *= inv;
            float x0[8], x1[8], x2[8], y[8]; unpack8(xw[i][0], x0); unpack8(xw[i][1], x1); unpack8(xw[i][2], x2);
#pragma unroll
            for (int k = 0; k < 8; ++k) y[k] = w0 * x0[k] + w1 * x1[k] + w2 * x2[k];
            *(v4u*)(MIX + (size_t)row * DM + 512 + hc * 8) = pack8(y); }
    }
}

__device__ __forceinline__ void ffn_fixup_phase(const Args& a, int gt, int NGT) {
    unsigned char* ws = a.ws;
    const float* HEADU = (const float*)(ws + WS_HEADU); const float* HEADP = (const float*)(ws + WS_HEADP); const float* TAIL = (const float*)(ws + WS_TAIL); bf16* Hb = (bf16*)(ws + WS_H);
    const float* cw = a.in[I_CFW]; const float* cb = a.in[I_CFB];
    for (int e = gt; e < (MP / 256) * 2 * (DFF / 8); e += NGT) {
        const int pm = e / (2 * (DFF / 8)), rem = e % (2 * (DFF / 8)), j = rem / (DFF / 8), c = (rem % (DFF / 8)) * 8;
        if ((pm & 15) == 0) continue;
        float p2[8], p1[8], cur[8], up[8], w0[8], w1[8], w2[8], bb[8], y[8];
        load8_f32(TAIL + (size_t)((pm - 1) * 2 + j) * DFF + c, p2);
        if (j == 0) load8_f32(TAIL + (size_t)((pm - 1) * 2 + 1) * DFF + c, p1); else load8_f32(HEADU + (size_t)(pm * 2) * DFF + c, p1);
        load8_f32(HEADU + (size_t)(pm * 2 + j) * DFF + c, cur); load8_f32(HEADP + (size_t)(pm * 2 + j) * DFF + c, up);
        load8_f32(cw + c, w0); load8_f32(cw + DFF + c, w1); load8_f32(cw + 2 * DFF + c, w2); load8_f32(cb + c, bb);
#pragma unroll
        for (int i = 0; i < 8; ++i) { const float uc = bb[i] + w0[i] * p2[i] + w1[i] * p1[i] + w2[i] * cur[i]; y[i] = gelu_tanh(uc) * up[i]; }
        *(v4u*)(Hb + (size_t)(pm * 256 + j) * DFF + c) = pack8(y);
    }
}
__device__ __forceinline__ void final_norm_phase(const Args& a, int gw, int NGW, int lane, bool prompt_too) {
    float* Y = a.out + O_Y; const float* PART = (const float*)(a.ws + WS_PART); const GAS f32x4* gf = (const GAS f32x4*)a.in[I_GFIN] + lane;
    f32x4 g[4];
#pragma unroll
    for (int j = 0; j < 4; ++j) g[j] = gf[64 * j];
#pragma unroll 1
    for (int m0 = gw; prompt_too && m0 < MP; m0 += 4 * NGW) {
        f32x4 v[4][4];
#pragma unroll
        for (int q = 0; q < 4; ++q) { const int m = m0 + q * NGW; if (m < MP) { const GAS f32x4* yr = (const GAS f32x4*)(Y + (size_t)m * DM) + lane;
#pragma unroll
                for (int j = 0; j < 4; ++j) v[q][j] = yr[64 * j]; } }
#pragma unroll
        for (int q = 0; q < 4; ++q) { const int m = m0 + q * NGW; if (m < MP) { float ss = 0.f;
#pragma unroll
                for (int j = 0; j < 4; ++j) ss += (v[q][j].x * v[q][j].x + v[q][j].y * v[q][j].y) + (v[q][j].z * v[q][j].z + v[q][j].w * v[q][j].w);
                const float rs = 1.f / sqrtf(wave_sum(ss) * (1.f / DM) + EPS); GAS f32x4* yr = (GAS f32x4*)(Y + (size_t)m * DM) + lane;
#pragma unroll
                for (int j = 0; j < 4; ++j) yr[64 * j] = v[q][j] * rs * g[j]; } }
    }
    for (int r = gw; r < MS; r += NGW) {
        GAS f32x4* yr = (GAS f32x4*)(Y + (size_t)(MP + r) * DM) + lane; f32x4 v[4]; float ss = 0.f;
#pragma unroll
        for (int j = 0; j < 4; ++j) { v[j] = yr[64 * j];
#pragma unroll
            for (int sl = 0; sl < KSPLIT; ++sl) v[j] += ((const GAS f32x4*)(PART + ((size_t)sl * MS + r) * DM) + lane)[64 * j];
            ss += (v[j].x * v[j].x + v[j].y * v[j].y) + (v[j].z * v[j].z + v[j].w * v[j].w); }
        const float rs = 1.f / sqrtf(wave_sum(ss) * (1.f / DM) + EPS);
#pragma unroll
        for (int j = 0; j < 4; ++j) yr[64 * j] = v[j] * rs * g[j];
    }
}

__global__ void __launch_bounds__(NTHR, 2) hymba_fwd(Args args) {
    extern __shared__ __attribute__((aligned(16))) unsigned char lds_raw[];
    LAS unsigned char* lds = (LAS unsigned char*)lds_raw;
    volatile LAS unsigned* MISC = (volatile LAS unsigned*)(lds + MISC_OFF);
    const int tid = threadIdx.x, lane = tid & 63, wave = __builtin_amdgcn_readfirstlane(tid >> 6);
    const int G = gridDim.x, bx = blockIdx.x; const int vcu = (G % 8 == 0) ? (bx % 8) * (G / 8) + bx / 8 : bx;
    unsigned char* ws = args.ws;
    unsigned* ctl = (unsigned*)(ws + WS_CTL);
    for (int u = tid; u < (LDS_BYTES - LDSCTL_OFF) / 4; u += NTHR) ((LAS unsigned*)(lds + LDSCTL_OFF))[u] = 0u;
    __syncthreads();
    XcdBarrier bar; bar.bar = ctl + CW_BAR + args.li * XCD_BAR_WORDS; bar.x = 0; bar.st = nullptr;
    if (N_LAUNCH == 1) bar = xcd_barrier_post(ctl + CW_BAR + args.li * XCD_BAR_WORDS, MISC + 8);
    const int lo = args.ph_lo, hi = args.ph_hi;
#ifndef REP_MASK
#define REP_MASK 0
#endif
#define REPS(k) for (int rep_ = 0; rep_ < 1 + ((REP_MASK >> (k)) & 1); ++rep_)
#ifndef STAG1
#define STAG1 0
#endif
#ifndef STAG4
#define STAG4 0
#endif
#ifndef STAG7
#define STAG7 0
#endif
#ifndef STAG_G
#define STAG_G 3
#endif
#define STAGGER(ticks) do { if ((ticks) > 0) { const int g_ = (bx / 8) % STAG_G; if (g_) { const unsigned long long t0_ = rt(); while (rt() - t0_ < (unsigned long long)(g_ * (ticks))) __builtin_amdgcn_s_sleep(8); } } } while (0)
#ifndef IT_MASK
#define IT_MASK 63
#endif
#ifndef PH_MASK
#define PH_MASK 0x1ff
#endif
#define IN(k) (((PH_MASK >> (k)) & 1) && lo <= (k) && (k) < hi)
#define SEAM(k) do { if (N_LAUNCH == 1 && IN(k) && IN((k) + 1)) xcd_barrier(bar); } while (0)

    constexpr int NP1S = 2 * (DIN / 256);
    if (IN(0)) REPS(0) {
        const int ns = (G >= 4 * NP1S && N_LAUNCH == 1) ? NP1S : 0;
        p0_prologue(args, lds, tid, wave, lane, vcu, G, 0);
        if (ns) {
            __builtin_amdgcn_fence(__ATOMIC_RELEASE, "agent"); __syncthreads();
            if (tid == 0) __hip_atomic_fetch_add(ctl + CW_P0A, 1u, __ATOMIC_RELAXED, __HIP_MEMORY_SCOPE_AGENT);
            if (bx < ns) {
                if (tid < 64) { unsigned spins = 0;
                    while ((unsigned)__builtin_amdgcn_readfirstlane(__hip_atomic_load(ctl + CW_P0A, __ATOMIC_RELAXED, __HIP_MEMORY_SCOPE_AGENT)) < (unsigned)G) { if (++spins > (1u << 22)) break; __builtin_amdgcn_s_sleep(2); } }
                __syncthreads(); __builtin_amdgcn_fence(__ATOMIC_ACQUIRE, "agent");
            }
        } else if (N_LAUNCH == 1) xcd_barrier(bar);
        if (bx >= ns) p0_prologue(args, lds, tid, wave, lane, bx - ns, G - ns, 1);
        if (ns == 0 || bx < ns) {
            if (ns == 0) __syncthreads();
            pg8::Gemm g{(const bf16*)(ws + WS_XN), (const bf16*)(ws + WS_WIN), M, DIN, DM, DM}; SampleUnitOrder S{bx, ns ? ns : G};
            EpiZ E{(const float*)(ws + WS_RS1), (const float*)(ws + WS_ROPE), (bf16*)(ws + WS_XA), (bf16*)(ws + WS_GA), (bf16*)(ws + WS_Q), (bf16*)(ws + WS_K), (bf16*)(ws + WS_V), (float*)(ws + WS_QS), args.out, (LAS float*)(lds + MISC_OFF + 256)};
            pg8::gemm_phase<EpiZ, SampleUnitOrder, true, true>(lds, g, S, E);
        }
        SEAM(0);
    }

    if (IN(1)) REPS(1) {
        STAGGER(STAG1);
        pg8::Gemm g{(const bf16*)(ws + WS_XN), (const bf16*)(ws + WS_WIN), MP, DIN, DM, DM}; pg8::StaticOrder S; S.init(MP, DIN, G, bx);
        EpiZ E{(const float*)(ws + WS_RS1), (const float*)(ws + WS_ROPE), (bf16*)(ws + WS_XA), (bf16*)(ws + WS_GA), (bf16*)(ws + WS_Q), (bf16*)(ws + WS_K), (bf16*)(ws + WS_V), (float*)(ws + WS_QS), args.out, (LAS float*)(lds + MISC_OFF + 256)};
        pg8::gemm_phase<EpiZ, pg8::StaticOrder, true, true>(lds, g, S, E);
        SEAM(1);
    }
    if (IN(2)) REPS(2) {
        constexpr int NA = NB * NH * 48, NSA = NS * NH, NL = NB * 64;
        if (args.pad & 4) for (int it = bx; it < NL; it += G) lru_fused_item(args, it, lds, wave, lane);
        if (bx & 1) { if (args.pad & 2) for (int it = bx; it < NSA; it += G) attn_sample_item(args, it, lds, tid, wave, lane); }
        if (args.pad & 1) attn_prompt_phase(args, lds, bx, G, NA, tid, wave, lane);
        if (!(bx & 1)) { if (args.pad & 2) for (int it = bx; it < NSA; it += G) attn_sample_item(args, it, lds, tid, wave, lane); }
        SEAM(2);
    }
    if (IN(3)) REPS(3) {
        constexpr int NLS = MS / 64, NC = MP / 64;
        if (bx < NLS && G > NLS) lru_item<2>(args, bx, lds, wave, lane);
        else if (G > NLS) { for (int it = bx - NLS; it < NC; it += G - NLS) combine_item(args, it, tid); }
        else for (int it = bx; it < NLS + NC; it += G) { if (it < NLS) lru_item<2>(args, it, lds, wave, lane); else combine_item(args, it - NLS, tid); }
        SEAM(3);
    }
    if (IN(4)) REPS(4) {
        STAGGER(STAG4);
        { pg8::Gemm g{(const bf16*)(ws + WS_MIX), (const bf16*)(ws + WS_WOUT), MP, DM, DM, DM}; pg8::StaticOrder S; S.init(MP, DM, G, bx);
          EpiX1 E{args.in[I_XP], args.in[I_XS], args.out + O_Y, (bf16*)(ws + WS_X1B), (float*)(ws + WS_SSP)};
          pg8::gemm_phase<EpiX1, pg8::StaticOrder, true, true>(lds, g, S, E); }
        { pg8::Gemm g{(const bf16*)(ws + WS_MIX), (const bf16*)(ws + WS_WOUT), M, DM, DM / KSPLIT4, DM}; SplitOrder S{G, bx, KSPLIT4, DM / KSPLIT4};
          EpiPart E{(float*)(ws + WS_PART4), DM / KSPLIT4};
          pg8::gemm_phase<EpiPart, SplitOrder, true, true>(lds, g, S, E); }
        SEAM(4);
    }
    if (IN(5)) REPS(5) {
        finalize_x1_sample(args, bx, G, wave, lane);
        pg8::Gemm g{(const bf16*)(ws + WS_X1B), (const bf16*)(ws + WS_WGU), M, 2 * DFF, DM, DM}; GatedOrder S; S.init(M, 2 * DFF, G, bx); S.cnt = (const unsigned*)(ws + WS_CTL) + CW_CNT4; S.need = MS;
        EpiGU E{(const float*)(ws + WS_SSP), (bf16*)(ws + WS_H), args.in[I_CFW], args.in[I_CFB], args.in[I_SCF], args.out, (float*)(ws + WS_HEADU), (float*)(ws + WS_HEADP), (float*)(ws + WS_TAIL), (LAS float*)(lds + MISC_OFF + 256), (LAS float*)(lds + RING_BYTES)};
        pg8::gemm_phase<EpiGU, GatedOrder, true, true>(lds, g, S, E);
        SEAM(5);
    }
    if (IN(6)) REPS(6) {
        if (G == 256) {
            if (bx < 8 * KSPLIT) { pg8::Gemm g{(const bf16*)(ws + WS_H), (const bf16*)(ws + WS_WDN), M, DM, DFF / KSPLIT, DFF}; SplitOrder S{G, bx, KSPLIT, DFF / KSPLIT};
                EpiPart E{(float*)(ws + WS_PART), DFF / KSPLIT};
                pg8::gemm_phase<EpiPart, SplitOrder, true, true>(lds, g, S, E); }
            else ffn_fixup_phase(args, (bx - 8 * KSPLIT) * NTHR + tid, (G - 8 * KSPLIT) * NTHR);
        } else ffn_fixup_phase(args, vcu * NTHR + tid, G * NTHR);
        SEAM(6);
    }
    if (IN(7)) {
        STAGGER(STAG7);
        if (G == 256) {
            final_norm_phase(args, vcu * NWAVES + wave, G * NWAVES, lane, false);
            pg8::Gemm g{(const bf16*)(ws + WS_H), (const bf16*)(ws + WS_WDN), MP, DM, DFF, DFF};
            EpiX2F E{args.out + O_Y, (const bf16*)(ws + WS_X1B), args.in[I_GFIN], (float*)(ws + WS_XBUF), (unsigned*)(ws + WS_CTL) + CW_X2C};
            { OneUnitOrder S; S.init(MP, DM, G, bx); S.i0 = 0; pg8::gemm_phase<EpiX2F, OneUnitOrder, false, true>(lds, g, S, E); }
            __syncthreads();
            { OneUnitOrder S; S.init(MP, DM, G, bx); S.i0 = 1; pg8::gemm_phase<EpiX2F, OneUnitOrder, false, true>(lds, g, S, E); }
            __syncthreads();
        } else {
            pg8::Gemm g{(const bf16*)(ws + WS_H), (const bf16*)(ws + WS_WDN), MP, DM, DFF, DFF}; pg8::StaticOrder S; S.init(MP, DM, G, bx);
            EpiX2 E{args.out + O_Y, (const bf16*)(ws + WS_X1B)};
            pg8::gemm_phase<EpiX2, pg8::StaticOrder, true, true>(lds, g, S, E);
        }
        if (G != 256) { pg8::Gemm g{(const bf16*)(ws + WS_H), (const bf16*)(ws + WS_WDN), M, DM, DFF / KSPLIT, DFF}; SplitOrder S{G, bx, KSPLIT, DFF / KSPLIT};
          EpiPart E{(float*)(ws + WS_PART), DFF / KSPLIT};
          pg8::gemm_phase<EpiPart, SplitOrder, true, true>(lds, g, S, E); }
        if (G != 256) SEAM(7);
    }
    if (IN(8) && G != 256) final_norm_phase(args, vcu * NWAVES + wave, G * NWAVES, lane, true);
#undef IN
#undef SEAM
}

extern "C" void kernel_launch(void* const* d_in, const int* in_sizes, int n_in, void* d_out, int out_size, void* d_ws, size_t ws_size, hipStream_t stream) {
    static int grid = 0;
    if (grid == 0) {
        if (n_in != 24 || out_size != (int)O_END || ws_size < WS_END) { fprintf(stderr, "kernel_launch: unexpected shapes (n_in %d, out %d, ws %zu)\n", n_in, out_size, ws_size); grid = -1; return; }
        int dev = 0, cus = 0, per_cu = 0;
        if (hipGetDevice(&dev) != hipSuccess || hipDeviceGetAttribute(&cus, hipDeviceAttributeMultiprocessorCount, dev) != hipSuccess) { grid = -1; return; }
        if (hipFuncSetAttribute((const void*)hymba_fwd, hipFuncAttributeMaxDynamicSharedMemorySize, LDS_BYTES) != hipSuccess) { fprintf(stderr, "kernel_launch: hipFuncSetAttribute failed\n"); grid = -1; return; }
        if (hipOccupancyMaxActiveBlocksPerMultiprocessor(&per_cu, (const void*)hymba_fwd, NTHR, LDS_BYTES) != hipSuccess || per_cu < 1) fprintf(stderr, "kernel_launch: occupancy query reports %d blocks per CU\n", per_cu);
        (void)hipGetLastError();
        grid = cus;
    }
    if (grid < 0) return;
    if (hipMemsetAsync((char*)d_ws + WS_CTL, 0, CTL_ZERO_BYTES, stream) != hipSuccess) return;
    Args a{};
    for (int i = 0; i < 24; ++i) a.in[i] = (const float*)d_in[i];
    a.out = (float*)d_out; a.ws = (unsigned char*)d_ws; a.pad = 7;
#if defined(PROBE_PH)
    a.ph_lo = 0; a.ph_hi = PROBE_PH + 1; a.li = 0; hipLaunchKernelGGL(hymba_fwd, dim3(grid), dim3(NTHR), LDS_BYTES, stream, a);
    a.ph_lo = PROBE_PH; a.ph_hi = NPH; a.li = 1;
#if defined(PROBE_ITEMS)
    a.pad = PROBE_ITEMS; a.ph_hi = PROBE_PH + 1; hipLaunchKernelGGL(hymba_fwd, dim3(grid), dim3(NTHR), LDS_BYTES, stream, a); a.pad = 7; a.ph_lo = PROBE_PH + 1; a.ph_hi = NPH; a.li = 2;
#endif
    hipLaunchKernelGGL(hymba_fwd, dim3(grid), dim3(NTHR), LDS_BYTES, stream, a);
    return;
#endif
    if (N_LAUNCH == 1) { a.ph_lo = 0; a.ph_hi = NPH; hipLaunchKernelGGL(hymba_fwd, dim3(grid), dim3(NTHR), LDS_BYTES, stream, a); }
    else for (int k = 0; k < NPH; ++k) { a.ph_lo = k; a.ph_hi = k + 1; hipLaunchKernelGGL(hymba_fwd, dim3(grid), dim3(NTHR), LDS_BYTES, stream, a); }
}
```

```cpp
#include <hip/hip_runtime.h>
#include <cstdio>
#include <cstdint>
#include <cmath>
namespace pg8 {
#define PG8_LAS __attribute__((address_space(3)))
typedef unsigned short bf16_t;
typedef short bf16x8 __attribute__((ext_vector_type(8)));
typedef float f32x4 __attribute__((ext_vector_type(4)));
typedef unsigned u32x4 __attribute__((ext_vector_type(4)));
constexpr int BM = 256, BK = 64, HALF = 128, HTB = HALF * BK * 2  , STAGE_BYTES = 8 * HTB, NXCD = 8, WGM = 8;

__host__ __device__ __forceinline__ int lds_byte(int r, int c) { const int st = (r >> 4) * 2 + (c >> 5), rr = r & 15, cc = c & 31, ob = rr * 64 + cc * 2; return st * 1024 + (ob ^ (((ob >> 9) & 1) << 5)); }
__host__ __device__ __forceinline__ void stage_rc(int b, int& R, int& C) { const int st = b / 1024, sb = b % 1024, swz = sb ^ (((sb >> 9) & 1) << 5); R = (st >> 1) * 16 + swz / 64; C = (st & 1) * 32 + (swz % 64) / 2; }
__host__ __device__ __forceinline__ int perm32(int rho) { const int n = rho >> 4, i = rho & 15; return 8 * (i >> 2) + 4 * n + (i & 3); }

struct Unit { int pm, pn, ko; };
struct Gemm { const bf16_t* A; const bf16_t* Bt; int M, N, K, ld; };

struct StaticOrder {
    int nM, nN, nwg, G, c;
    __host__ __device__ void init(int M, int N, int G_, int c_) { nM = M / BM; nN = N / BM; nwg = nM * nN; G = G_; c = c_; }
    __host__ __device__ bool next(int i, Unit& u) const {
        const long L = (long)i * G + c; if (L >= nwg) return false;
        int wgid = (int)L; { const int q = nwg / NXCD, r = nwg % NXCD, xcd = wgid % NXCD, off = wgid / NXCD; wgid = (xcd < r ? xcd * (q + 1) : r * (q + 1) + (xcd - r) * q) + off; }
        const int nig = WGM * nN, gid = wgid / nig, fm = gid * WGM, gsz = (nM - fm) < WGM ? (nM - fm) : WGM;
        u.pm = fm + ((wgid % nig) % gsz); u.pn = (wgid % nig) / gsz; u.ko = 0; return true;
    }
    __device__ __forceinline__ void a_ready(const Unit&) const {}
    __device__ __forceinline__ void done(const Unit&) const {}
};

__device__ __forceinline__ unsigned cvt_pk_bf16(float lo, float hi) { unsigned r; asm volatile("v_cvt_pk_bf16_f32 %0, %1, %2" : "=v"(r) : "v"(lo), "v"(hi)); return r; }
template <class Epi, class Sched, bool ALIGN_EPI = false, bool SP2 = false>
__device__ __forceinline__ void gemm_phase(PG8_LAS unsigned char* lds, const Gemm g, const Sched& S, const Epi& E) {
    const int tid = threadIdx.x, wid = __builtin_amdgcn_readfirstlane(tid >> 6), lane = tid & 63, wr = wid >> 2, wc = wid & 3, fr = lane & 15, fq = lane >> 4;
    const int K = g.K, nt = K / BK;
    unsigned voffA[2], voffB[2];
#pragma unroll
    for (int i = 0; i < 2; ++i) { int R, C; stage_rc(tid * 16 + i * 8192, R, C); const int Rb = Epi::PERM ? ((R & ~31) + perm32(R & 31)) : R;
        voffA[i] = (unsigned)(R * g.ld + C) * 2u; voffB[i] = (unsigned)(Rb * g.ld + C) * 2u; }
    const size_t kstep = (size_t)(BK * 2);
    const size_t hstep = (size_t)HALF * g.ld * 2;
    const size_t tstep = 2 * hstep;
    const unsigned ldsw = (unsigned)wid * 1024u;
    const int aoff = lds_byte(wr * 64 + fr, fq * 8), boff = lds_byte(wc * 32 + fr, fq * 8);
#define PG8_SA(b, h) (((b) * 2 + (h)) * HTB)
#define PG8_SB(b, h) ((4 + (b) * 2 + (h)) * HTB)
#define PG8_STAGE(bufoff, gbase, voff) do { _Pragma("unroll") for (int _i = 0; _i < 2; ++_i) \
        __builtin_amdgcn_global_load_lds((const unsigned*)((const char*)(gbase) + (voff)[_i]), (PG8_LAS unsigned*)(lds + (bufoff) + ldsw + _i * 8192), 16, 0, 0); } while (0)
#define PG8_LDA(dst, b, h) do { _Pragma("unroll") for (int m = 0; m < 4; ++m) _Pragma("unroll") for (int k = 0; k < 2; ++k) dst[m][k] = *(const PG8_LAS bf16x8*)(lds + PG8_SA(b, h) + aoff + m * 2048 + k * 1024); } while (0)
#define PG8_LDB(dst, b, h) do { _Pragma("unroll") for (int n = 0; n < 2; ++n) _Pragma("unroll") for (int k = 0; k < 2; ++k) dst[n][k] = *(const PG8_LAS bf16x8*)(lds + PG8_SB(b, h) + boff + n * 2048 + k * 1024); } while (0)
#define PG8_MMA(ai, bj, At, Bt) do { __builtin_amdgcn_s_setprio(1); _Pragma("unroll") for (int m = 0; m < 4; ++m) _Pragma("unroll") for (int n = 0; n < 2; ++n) _Pragma("unroll") for (int k = 0; k < 2; ++k) \
        acc[ai][bj][m][n] = __builtin_amdgcn_mfma_f32_16x16x32_bf16(Bt[n][k], At[m][k], acc[ai][bj][m][n], 0, 0, 0); __builtin_amdgcn_s_setprio(0); } while (0)
#define PG8_WAIT_V(n) asm volatile("s_waitcnt vmcnt(" #n ")" ::: "memory")
#define PG8_WAIT_L(n) asm volatile("s_waitcnt lgkmcnt(" #n ")" ::: "memory")
#define PG8_BAR __builtin_amdgcn_s_barrier()
#define PG8_SCHED __builtin_amdgcn_sched_barrier(0)
    Unit cur, nxt; int ui = 0;
    if (!S.next(0, cur)) return;
    f32x4 acc[2][2][4][2];
#pragma unroll
    for (int a = 0; a < 2; ++a)
#pragma unroll
        for (int b = 0; b < 2; ++b)
#pragma unroll
            for (int m = 0; m < 4; ++m)
#pragma unroll
                for (int n = 0; n < 2; ++n) acc[a][b][m][n] = (f32x4){0.f, 0.f, 0.f, 0.f};
    bf16x8 At[4][2], B0[2][2], B1[2][2];
    const char* cA = (const char*)g.A + (size_t)cur.pm * tstep + (size_t)cur.ko * 2; const char* cB = (const char*)g.Bt + (size_t)cur.pn * tstep + (size_t)cur.ko * 2;
    S.a_ready(cur); E.pre(cur, 0, tid);
    if constexpr (SP2) {
        PG8_STAGE(PG8_SB(0, 0), cB, voffB); PG8_STAGE(PG8_SB(0, 1), cB + hstep, voffB); PG8_STAGE(PG8_SA(0, 0), cA, voffA); PG8_STAGE(PG8_SA(0, 1), cA + hstep, voffA);
        if (wr == 1) PG8_BAR;
        PG8_WAIT_V(2); PG8_BAR;
        PG8_STAGE(PG8_SB(1, 0), cB + kstep, voffB); PG8_STAGE(PG8_SA(1, 0), cA + kstep, voffA); PG8_STAGE(PG8_SB(1, 1), cB + hstep + kstep, voffB);
        PG8_WAIT_V(6); PG8_BAR;
    } else {
        PG8_STAGE(PG8_SB(0, 0), cB, voffB); PG8_STAGE(PG8_SA(0, 0), cA, voffA); PG8_STAGE(PG8_SB(0, 1), cB + hstep, voffB); PG8_STAGE(PG8_SA(0, 1), cA + hstep, voffA);
        if (wr == 1) PG8_BAR;
        PG8_WAIT_V(4); PG8_BAR;
        PG8_STAGE(PG8_SB(1, 0), cB + kstep, voffB); PG8_STAGE(PG8_SA(1, 0), cA + kstep, voffA); PG8_STAGE(PG8_SB(1, 1), cB + hstep + kstep, voffB);
        PG8_WAIT_V(6); PG8_BAR;
    }
    for (;;) {
        const bool has_next = S.next(ui + 1, nxt);
        const char* nA = has_next ? (const char*)g.A + (size_t)nxt.pm * tstep + (size_t)nxt.ko * 2 : cA; const char* nB = has_next ? (const char*)g.Bt + (size_t)nxt.pn * tstep + (size_t)nxt.ko * 2 : cB;
        for (int t = 0; t < nt; t += 2) {
            const bool last = (t == nt - 2);
            const char* a1 = cA + (size_t)(t + 1) * kstep;
            const char* a2 = last ? nA : cA + (size_t)(t + 2) * kstep; const char* b2 = last ? nB : cB + (size_t)(t + 2) * kstep;
            const char* a3 = a2 + kstep; const char* b3 = b2 + kstep;
            if (last) { E.mid(cur, ui & 1, tid); if (has_next) { S.a_ready(nxt); E.pre(nxt, (ui + 1) & 1, tid); } }
            if constexpr (SP2) {
            PG8_LDB(B0, 0, 0); PG8_LDB(B1, 0, 1); PG8_SCHED; PG8_LDA(At, 0, 0); PG8_STAGE(PG8_SA(1, 1), a1 + hstep, voffA);
            PG8_WAIT_V(8); PG8_WAIT_L(0); PG8_BAR; PG8_MMA(0, 0, At, B0); PG8_MMA(0, 1, At, B1); PG8_BAR; PG8_SCHED;
            PG8_LDA(At, 0, 1); PG8_STAGE(PG8_SB(0, 0), b2, voffB); PG8_STAGE(PG8_SB(0, 1), b2 + hstep, voffB); PG8_STAGE(PG8_SA(0, 0), a2, voffA);
            PG8_WAIT_V(8); PG8_WAIT_L(0); PG8_BAR; PG8_MMA(1, 0, At, B0); PG8_MMA(1, 1, At, B1); PG8_BAR; PG8_SCHED;
            PG8_LDB(B0, 1, 0); PG8_LDB(B1, 1, 1); PG8_SCHED; PG8_LDA(At, 1, 0); PG8_STAGE(PG8_SA(0, 1), a2 + hstep, voffA);
            PG8_WAIT_V(8); PG8_WAIT_L(0); PG8_BAR; PG8_MMA(0, 0, At, B0); PG8_MMA(0, 1, At, B1); PG8_BAR; PG8_SCHED;
            PG8_LDA(At, 1, 1); PG8_STAGE(PG8_SB(1, 0), b3, voffB); PG8_STAGE(PG8_SB(1, 1), b3 + hstep, voffB); PG8_STAGE(PG8_SA(1, 0), a3, voffA);
            PG8_WAIT_V(8); PG8_WAIT_L(0); PG8_BAR; PG8_MMA(1, 0, At, B0); PG8_MMA(1, 1, At, B1); PG8_BAR; PG8_SCHED;
            } else {
            PG8_LDB(B0, 0, 0); PG8_SCHED; PG8_LDA(At, 0, 0); PG8_STAGE(PG8_SA(1, 1), a1 + hstep, voffA);
            PG8_WAIT_L(8); PG8_BAR; PG8_WAIT_L(0); PG8_MMA(0, 0, At, B0); PG8_BAR; PG8_SCHED;
            PG8_LDB(B1, 0, 1); PG8_STAGE(PG8_SB(0, 0), b2, voffB);
            PG8_BAR; PG8_WAIT_L(0); PG8_MMA(0, 1, At, B1); PG8_BAR;
            PG8_LDA(At, 0, 1); PG8_STAGE(PG8_SA(0, 0), a2, voffA);
            PG8_BAR; PG8_WAIT_L(0); PG8_MMA(1, 0, At, B0); PG8_BAR; PG8_SCHED;
            PG8_STAGE(PG8_SB(0, 1), b2 + hstep, voffB);
            PG8_WAIT_V(6); PG8_BAR; PG8_MMA(1, 1, At, B1); PG8_BAR;
            PG8_LDB(B0, 1, 0); PG8_SCHED; PG8_LDA(At, 1, 0); PG8_STAGE(PG8_SA(0, 1), a2 + hstep, voffA);
            PG8_WAIT_L(8); PG8_BAR; PG8_WAIT_L(0); PG8_MMA(0, 0, At, B0); PG8_BAR; PG8_SCHED;
            PG8_LDB(B1, 1, 1); PG8_STAGE(PG8_SB(1, 0), b3, voffB);
            PG8_BAR; PG8_WAIT_L(0); PG8_MMA(0, 1, At, B1); PG8_BAR;
            PG8_LDA(At, 1, 1); PG8_STAGE(PG8_SA(1, 0), a3, voffA);
            PG8_BAR; PG8_WAIT_L(0); PG8_MMA(1, 0, At, B0); PG8_BAR; PG8_SCHED;
            PG8_STAGE(PG8_SB(1, 1), b3 + hstep, voffB);
            PG8_WAIT_V(6); PG8_BAR; PG8_MMA(1, 1, At, B1); PG8_BAR;
            }
        }
        if constexpr (ALIGN_EPI) { if (wr == 0) PG8_BAR; }
        if constexpr (!Epi::AFTER_DRAIN) { E(acc, cur, wr, wc, fr, fq, ui & 1); S.done(cur); }
        if (!has_next) break;
#pragma unroll
        for (int a = 0; a < 2; ++a)
#pragma unroll
            for (int b = 0; b < 2; ++b)
#pragma unroll
                for (int m = 0; m < 4; ++m)
#pragma unroll
                    for (int n = 0; n < 2; ++n) acc[a][b][m][n] = (f32x4){0.f, 0.f, 0.f, 0.f};
        cur = nxt; cA = nA; cB = nB; ++ui;
        if constexpr (ALIGN_EPI) { if (wr == 1) PG8_BAR; }
    }
    PG8_WAIT_V(0);
    if constexpr (!ALIGN_EPI) { if (wr == 0) PG8_BAR; }
    PG8_BAR;
    if constexpr (Epi::AFTER_DRAIN) { E.fused(acc, cur, wr, wc, fr, fq, lds, wid, lane); S.done(cur); }
#undef PG8_SA
#undef PG8_SB
#undef PG8_STAGE
#undef PG8_LDA
#undef PG8_LDB
#undef PG8_MMA
#undef PG8_WAIT_V
#undef PG8_WAIT_L
#undef PG8_BAR
#undef PG8_SCHED
}
}
#define GAS __attribute__((address_space(1)))
#define LAS __attribute__((address_space(3)))
typedef unsigned short bf16;
typedef unsigned v4u __attribute__((ext_vector_type(4)));
typedef float f32x4 __attribute__((ext_vector_type(4)));
typedef float f32x2 __attribute__((ext_vector_type(2)));
typedef short bf16x8 __attribute__((ext_vector_type(8)));
typedef GAS unsigned gu32;
typedef GAS unsigned long long gu64;
#define RLX_AGENT __ATOMIC_RELAXED, __HIP_MEMORY_SCOPE_AGENT
#define LDS_WAIT() asm volatile("s_waitcnt lgkmcnt(0)" ::: "memory")
#define VM_WAIT() asm volatile("s_waitcnt vmcnt(0)" ::: "memory")
__device__ __forceinline__ unsigned long long rt() { return __builtin_amdgcn_s_memrealtime(); }
__device__ __forceinline__ unsigned f2bf(float f) { unsigned u = __builtin_bit_cast(unsigned, f); return (u + 0x7fffu + ((u >> 16) & 1u)) >> 16; }
__device__ __forceinline__ unsigned pk2(float lo, float hi) { unsigned r; asm("v_cvt_pk_bf16_f32 %0, %1, %2" : "=v"(r) : "v"(lo), "v"(hi)); return r; }

#define XB_TMO      128
#define XB_XCNT(j)  (256  + 64 * (j))
#define XB_XSUB(j)  (1280 + 64 * (j))
#define XB_XGEN(j)  (2304 + 64 * (j))
#define XB_TOP      3328
#define XB_TOPGEN   3392
#define XCD_BAR_WORDS 3456
#define XB_SPIN_CAP (1u << 18)

__device__ __forceinline__ unsigned xb_ld(unsigned* p)              { return __hip_atomic_load(p, __ATOMIC_RELAXED, __HIP_MEMORY_SCOPE_AGENT); }
__device__ __forceinline__ unsigned xb_add(unsigned* p, unsigned v) { return __hip_atomic_fetch_add(p, v, __ATOMIC_RELAXED, __HIP_MEMORY_SCOPE_AGENT); }
__device__ __forceinline__ unsigned xb_xcc_id() { return (unsigned)__builtin_amdgcn_s_getreg((3 << 11) | 20) & 0xFu; }
#define XB_SPIN(cond, bar) do { unsigned _sp = 0; while (cond) { __builtin_amdgcn_s_sleep(1); \
    if ((++_sp & 255u) == 0u) { if (xb_ld(&(bar)[XB_TMO])) break; if (_sp > XB_SPIN_CAP) { atomicAdd(&(bar)[XB_TMO], 1u); break; } } } } while (0)

struct XcdBarrier {
    unsigned* bar; unsigned x;
    volatile LAS unsigned* st;
};

__device__ __forceinline__ XcdBarrier xcd_barrier_post(unsigned* bar, volatile LAS unsigned* st) {
    XcdBarrier b; b.bar = bar; b.x = xb_xcc_id(); b.st = st;
    if (threadIdx.x == 0) (void)xb_add(&bar[XB_XCNT(b.x)], 1u);
    return b;
}
__device__ __forceinline__ void xcd_barrier_complete(unsigned* bar, unsigned x, unsigned& nloc, unsigned& nx) {
    const unsigned G = gridDim.x * gridDim.y * gridDim.z;
    unsigned sum, cnt, mine, sp = 0u;
    for (;;) {
        sum = 0u; cnt = 0u; mine = 0u;
#pragma unroll
        for (unsigned j = 0; j < 16; ++j) { const unsigned c = xb_ld(&bar[XB_XCNT(j)]); sum += c; cnt += (c > 0u) ? 1u : 0u; mine = (j == x) ? c : mine; }
        if (sum == G) break;
        __builtin_amdgcn_s_sleep(1);
        if ((++sp & 255u) == 0u) { if (xb_ld(&bar[XB_TMO])) break; if (sp > XB_SPIN_CAP) { atomicAdd(&bar[XB_TMO], 1u); break; } }
    }
    nloc = mine > 0u ? mine : 1u; nx = cnt > 0u ? cnt : 1u;
}

__device__ __forceinline__ void xcd_barrier(const XcdBarrier& b) {
    asm volatile("s_waitcnt vmcnt(0)" ::: "memory");
    __syncthreads();
    if (threadIdx.x == 0) {
        unsigned* bar = b.bar;
        __builtin_amdgcn_s_waitcnt(0);
        unsigned nloc = b.st[0], nx = b.st[1];
        if (nloc == 0u) { xcd_barrier_complete(bar, b.x, nloc, nx); b.st[0] = nloc; b.st[1] = nx; }
        const unsigned old = xb_add(&bar[XB_XSUB(b.x)], 1u);
        const unsigned gen = old / nloc;
        if (old + 1u == (gen + 1u) * nloc) {
            __builtin_amdgcn_fence(__ATOMIC_RELEASE, "agent");
            asm volatile("s_waitcnt vmcnt(0)" ::: "memory");
            const unsigned og = xb_add(&bar[XB_TOP], 1u);
            const unsigned tg = og / nx;
            if (og + 1u == (tg + 1u) * nx) xb_add(&bar[XB_TOPGEN], 1u);
            else XB_SPIN(xb_ld(&bar[XB_TOPGEN]) == tg, bar);
            __builtin_amdgcn_fence(__ATOMIC_ACQUIRE, "agent");
            xb_add(&bar[XB_XGEN(b.x)], 1u);
            asm volatile("s_waitcnt vmcnt(0)" ::: "memory");
        } else {
            XB_SPIN(xb_ld(&bar[XB_XGEN(b.x)]) == gen, bar);
            __builtin_amdgcn_fence(__ATOMIC_ACQUIRE, "agent");
            asm volatile("s_waitcnt vmcnt(0)" ::: "memory");
        }
    }
    __syncthreads();
}
constexpr int DM = 1024, NB = 8, SEQ = 4096, NS = 128, SSQ = 4;
constexpr int DL = 512, NH = 8, HD = 64, DIN = 2560, DFF = 3072;
constexpr int MP = NB * SEQ, MS = NS * SSQ, M = MP + MS;
constexpr float EPS = 1e-6f;
constexpr float C2 = 0.125f * 1.4426950408889634f;
constexpr int NWAVES = 8, NTHR = 512;
#ifndef N_LAUNCH
#define N_LAUNCH 1
#endif
constexpr int NPH = 9;

constexpr size_t O_Y = 0;
constexpr size_t O_PCA = (size_t)M * DM;
constexpr size_t O_PLH = O_PCA + (size_t)NB * 3 * DL;
constexpr size_t O_PWK = O_PLH + (size_t)NB * DL;
constexpr size_t O_PWV = O_PWK + (size_t)NB * 2048 * 512;
constexpr size_t O_PCF = O_PWV + (size_t)NB * 2048 * 512;
constexpr size_t O_SCA = O_PCF + (size_t)NB * 2 * DFF;
constexpr size_t O_SLH = O_SCA + (size_t)NS * 3 * DL;
constexpr size_t O_SWK = O_SLH + (size_t)NS * DL;
constexpr size_t O_SWV = O_SWK + (size_t)NS * 4 * 512;
constexpr size_t O_SCF = O_SWV + (size_t)NS * 4 * 512;
constexpr size_t O_END = O_SCF + (size_t)NS * 2 * DFF;
static_assert(O_END == 52494336, "output size");

constexpr size_t MiB = 1u << 20;
constexpr size_t WS_CTL = 0, CTL_ZERO_BYTES = 1 * MiB;
constexpr size_t WS_WIN = 2 * MiB, WS_WOUT = 7 * MiB, WS_WGU = 9 * MiB, WS_WDN = 21 * MiB, WS_WL = 27 * MiB;
constexpr size_t WS_C8 = 28 * MiB, WS_ROPE = 28 * MiB + 65536, WS_RS1 = 29 * MiB, WS_SSP = 30 * MiB, WS_SSP2 = 33 * MiB;
constexpr size_t WS_AGGA = 36 * MiB, WS_AGGB = 37 * MiB, WS_QS = 38 * MiB, WS_LSE = 40 * MiB;
constexpr size_t WS_XN = 48 * MiB, WS_XA = 116 * MiB, WS_GA = 150 * MiB, WS_Q = 184 * MiB, WS_K = 218 * MiB, WS_V = 252 * MiB;
constexpr size_t WS_OP = 288 * MiB, WS_MIX = 384 * MiB + 135424, WS_X1B = 450 * MiB, WS_UFU = 516 * MiB, WS_H = 908 * MiB, WS_END = 1104 * MiB;
constexpr size_t WS_HEADU = 516 * MiB, WS_HEADP = 520 * MiB, WS_TAIL = 524 * MiB;
constexpr size_t WS_PART4 = 540 * MiB;
constexpr size_t WS_XBUF = 548 * MiB;
constexpr size_t WS_PART = 560 * MiB;
constexpr int CW_BAR = 4096;

constexpr int RING_BYTES = 131072, LDSCTL_OFF = 155648, MISC_OFF = LDSCTL_OFF + 320, LDS_BYTES = 163840;

typedef float f32x16 __attribute__((ext_vector_type(16)));
typedef short s16x4 __attribute__((ext_vector_type(4)));
typedef unsigned u32x2 __attribute__((ext_vector_type(2)));

__device__ __forceinline__ float bflo(unsigned w) { return __uint_as_float(w << 16); }
__device__ __forceinline__ float bfhi(unsigned w) { return __uint_as_float(w & 0xffff0000u); }
__device__ __forceinline__ float bf2f(bf16 h) { return __uint_as_float((unsigned)h << 16); }
__device__ __forceinline__ void unpack8(const v4u w, float (&x)[8]) { x[0] = bflo(w.x); x[1] = bfhi(w.x); x[2] = bflo(w.y); x[3] = bfhi(w.y); x[4] = bflo(w.z); x[5] = bfhi(w.z); x[6] = bflo(w.w); x[7] = bfhi(w.w); }
__device__ __forceinline__ v4u pack8(const float (&x)[8]) { v4u w; w.x = pk2(x[0], x[1]); w.y = pk2(x[2], x[3]); w.z = pk2(x[4], x[5]); w.w = pk2(x[6], x[7]); return w; }
__device__ __forceinline__ int crow(int r, int hi) { return (r & 3) + 8 * (r >> 2) + 4 * hi; }
__device__ __forceinline__ float wave_sum(float v) {
#pragma unroll
    for (int o = 1; o < 64; o <<= 1) v += __shfl_xor(v, o);
    return v;
}
__device__ __forceinline__ float sigmoidf_(float x) { return __builtin_amdgcn_rcpf(1.f + __expf(-x)); }
__device__ __forceinline__ float one_minus_exp(float x) {
    float p = 1.f / 720.f; p = p * x + 1.f / 120.f; p = p * x + 1.f / 24.f; p = p * x + 1.f / 6.f; p = p * x + 0.5f; p = p * x + 1.f;
    const float e = 1.f - __expf(x); return x > -0.35f ? -x * p : e; }
__device__ __forceinline__ float gelu_tanh(float x) { const float z = x * (-2.3022082f + -0.10294324f * (x * x));
    return x * __builtin_amdgcn_rcpf(1.f + __builtin_amdgcn_exp2f(z)); }

struct Args { const float* in[24]; float* out; unsigned char* ws; int ph_lo, ph_hi, li, pad; };
enum { I_XP = 0, I_XS, I_SCA, I_SLH, I_CK, I_CV, I_SCF, I_GMIX, I_WIN, I_CAW, I_CAB, I_WR, I_BR, I_WI, I_BI, I_LAM, I_WOUT, I_GFFN, I_WG, I_CFW, I_CFB, I_WU, I_WD, I_GFIN };

__device__ __forceinline__ const float* xrow(const Args& a, int m) { return m < MP ? a.in[I_XP] + (size_t)m * DM : a.in[I_XS] + (size_t)(m - MP) * DM; }

__device__ __forceinline__ void p0_transpose_item(const float* W, const float* gk, int K, int N, bf16* WT, int row_off, LAS float* scr, int item, int lane, int mode = 0) {
    const int nblk = N / 32, kb = item / nblk, nb = item % nblk, k0 = 64 * kb, n0 = 32 * nb;
    const int drow0 = mode == 0 ? row_off + n0 : 256 * (n0 >> 7) + (n0 & 127) + (mode == 2 ? 128 : 0);
    float wv[32], gv[32];
#pragma unroll
    for (int i = 0; i < 32; ++i) { const int kk = 2 * i + (lane >> 5); gv[i] = gk ? gk[k0 + kk] : 1.f; wv[i] = __builtin_nontemporal_load(W + (size_t)(k0 + kk) * N + n0 + (lane & 31)); }
#pragma unroll
    for (int i = 0; i < 32; ++i) { const int kk = 2 * i + (lane >> 5); scr[kk * 33 + (lane & 31)] = wv[i] * gv[i]; }
    LDS_WAIT(); asm volatile("" ::: "memory");
    const int c = lane & 7;
#pragma unroll
    for (int j = 0; j < 4; ++j) { const int n = (lane >> 3) + 8 * j; const LAS float* s = scr + (8 * c) * 33 + n;
        v4u o; o.x = pk2(s[0 * 33], s[1 * 33]); o.y = pk2(s[2 * 33], s[3 * 33]); o.z = pk2(s[4 * 33], s[5 * 33]); o.w = pk2(s[6 * 33], s[7 * 33]);
        *(GAS v4u*)(WT + (size_t)(drow0 + n) * K + k0 + 8 * c) = o; }
    LDS_WAIT(); asm volatile("" ::: "memory");
}

__device__ __forceinline__ void p0_prologue(const Args& a, LAS unsigned char* lds, int tid, int wave, int lane, int wgi, int NW, int part) {
    unsigned char* ws = a.ws;
    LAS float* scr = (LAS float*)(lds + wave * 16384);
    const int gw = wgi * NWAVES + wave, NGW = NW * NWAVES;
    constexpr int I_A = (DM / 64) * (DIN / 32), I_B = (DM / 64) * (DM / 32), I_C = (DM / 64) * (DFF / 32), I_D = (DFF / 64) * (DM / 32);
    constexpr int NITEMS = I_B + 2 * I_C + I_D;
    if (part == 0) for (int it = gw; it < I_A; it += NGW) p0_transpose_item(a.in[I_WIN], a.in[I_GMIX], DM, DIN, (bf16*)(ws + WS_WIN), 0, scr, it, lane);
    else for (int it = gw; it < NITEMS; it += NGW) {
        int r = it;
        if (r < I_B) { p0_transpose_item(a.in[I_WOUT], nullptr, DM, DM, (bf16*)(ws + WS_WOUT), 0, scr, r, lane); continue; } r -= I_B;
        if (r < I_C) { p0_transpose_item(a.in[I_WG], a.in[I_GFFN], DM, DFF, (bf16*)(ws + WS_WGU), 0, scr, r, lane, 1); continue; } r -= I_C;
        if (r < I_C) { p0_transpose_item(a.in[I_WU], a.in[I_GFFN], DM, DFF, (bf16*)(ws + WS_WGU), 0, scr, r, lane, 2); continue; } r -= I_C;
        p0_transpose_item(a.in[I_WD], nullptr, DFF, DM, (bf16*)(ws + WS_WDN), 0, scr, r, lane);
    }
    const int gt = wgi * NTHR + tid, NGT = NW * NTHR;
    if (part == 0) {
    { bf16* WL = (bf16*)(ws + WS_WL);
      for (int e = gt; e < 8 * 192 * 64; e += NGT) { const int i = e & 63, o = (e >> 6) % 192, g = e / (192 * 64); float v;
          if (o < 64) v = a.in[I_WR][(g * 64 + i) * 64 + o]; else if (o < 128) v = a.in[I_WI][(g * 64 + i) * 64 + (o - 64)]; else v = (i == o - 128) ? 1.f : 0.f;
          WL[e] = (bf16)f2bf(v); } }
    { float* c8 = (float*)(ws + WS_C8);
      for (int e = gt; e < DL; e += NGT) { const float lam = a.in[I_LAM][e]; const float sp = (lam < -20.f) ? -lam : log1pf(expf(-lam)); c8[e] = 8.f * sp; } }
    { float* rope = (float*)(ws + WS_ROPE);
      for (int e = gt; e < 4100 * 8; e += NGT) { const int pi = e >> 3, i = e & 7; const double pos = pi < 4096 ? (double)pi : (double)(8192 + (pi - 4096));
          const double inv = pow(500000.0, -(double)i / 8.0), ang = pos * inv; rope[pi * 16 + i] = (float)cos(ang); rope[pi * 16 + 8 + i] = (float)sin(ang); } }
    }
    { bf16* XN = (bf16*)(ws + WS_XN); float* RS1 = (float*)(ws + WS_RS1);
      const int M_lo = part == 0 ? MP : 0, M = part == 0 ? ::M : MP;
#pragma unroll 1
      for (int m0 = M_lo + gw; m0 < M; m0 += 8 * NGW) {
          f32x4 v[8][4];
#pragma unroll
          for (int q = 0; q < 8; ++q) { const int m = m0 + q * NGW; if (m < M) { const GAS f32x4* xr = (const GAS f32x4*)xrow(a, m) + lane;
#pragma unroll
                  for (int j = 0; j < 4; ++j) v[q][j] = __builtin_nontemporal_load((const f32x4*)(xr + 64 * j)); } }
#pragma unroll
          for (int q = 0; q < 8; ++q) { const int m = m0 + q * NGW; if (m < M) { float s = 0.f;
#pragma unroll
                  for (int j = 0; j < 4; ++j) s += (v[q][j].x * v[q][j].x + v[q][j].y * v[q][j].y) + (v[q][j].z * v[q][j].z + v[q][j].w * v[q][j].w);
                  s = wave_sum(s); if (lane == 0) RS1[m] = 1.f / sqrtf(s * (1.f / DM) + EPS);
                  GAS unsigned long long* o8 = (GAS unsigned long long*)(XN + (size_t)m * DM) + lane;
#pragma unroll
                  for (int j = 0; j < 4; ++j) o8[64 * j] = (unsigned long long)pk2(v[q][j].x, v[q][j].y) | ((unsigned long long)pk2(v[q][j].z, v[q][j].w) << 32); } }
      } }
}

__device__ __forceinline__ void load8_bf16(const bf16* p, float (&x)[8]) { unpack8(*(const v4u*)p, x); }
__device__ __forceinline__ void load8_f32(const float* p, float (&x)[8]) { const f32x4 a = *(const f32x4*)p, b = *(const f32x4*)(p + 4); x[0] = a[0]; x[1] = a[1]; x[2] = a[2]; x[3] = a[3]; x[4] = b[0]; x[5] = b[1]; x[6] = b[2]; x[7] = b[3]; }
struct EpiZ {
    static constexpr bool PERM = true, AFTER_DRAIN = false;
    const float* rs1; const float* rope; bf16 *XA, *GA, *Q, *K, *V; float* QS; float* out; LAS float* ex;
    __device__ __forceinline__ void pre(const pg8::Unit& u, int par, int tid) const {
        const int w = __builtin_amdgcn_readfirstlane(tid >> 6), lane = tid & 63;
        if (w < 4) __builtin_amdgcn_global_load_lds((const unsigned*)(rs1 + u.pm * 256 + w * 64 + lane), (LAS unsigned*)(ex + 1024 + par * 256 + w * 64), 4, 0, 0);
    }
    __device__ __forceinline__ void mid(const pg8::Unit&, int, int) const {}
    __device__ __forceinline__ void operator()(const pg8::f32x4 (&acc)[2][2][4][2], const pg8::Unit& u, int wr, int wc, int fr, int fq, int par) const {
        const int type = u.pn >> 1;
        const int cbase = (u.pn & 1) * 256 + wc * 32 + 8 * fq;
        float rsv[2][4];
#pragma unroll
        for (int ai = 0; ai < 2; ++ai)
#pragma unroll
            for (int m = 0; m < 4; ++m) rsv[ai][m] = ex[1024 + par * 256 + ai * 128 + wr * 64 + m * 16 + fr];
        const bool do_rope = (type == 2 || type == 3) && (wc & 1) == 0;
#pragma unroll
        for (int ai = 0; ai < 2; ++ai) {
            f32x4 rc[4][4];
#pragma unroll
            for (int m = 0; m < 4; ++m) {
                if ((m & 1) == 0 && do_rope && fq < 2) {
#pragma unroll
                    for (int mm = m; mm < m + 2; ++mm) { const int row = u.pm * 256 + ai * 128 + wr * 64 + mm * 16 + fr; const int pi = row >= MP ? 4096 + (row & 3) : (row & 4095);
                        const f32x4* rp = (const f32x4*)(rope + (size_t)pi * 16); rc[mm][0] = rp[0]; rc[mm][1] = rp[1]; rc[mm][2] = rp[2]; rc[mm][3] = rp[3]; }
                }
                const int row = u.pm * 256 + ai * 128 + wr * 64 + m * 16 + fr;
                const float rs = rsv[ai][m];
                const bool samp = row >= MP;
                const int b = samp ? ((row - MP) >> 2) : (row >> 12), t = samp ? (row & 3) : (row & 4095);
#pragma unroll
                for (int bj = 0; bj < 2; ++bj) {
                    const int ct = cbase + 128 * bj;
                    float v[8];
#pragma unroll
                    for (int i = 0; i < 4; ++i) { v[i] = acc[ai][bj][m][0][i] * rs; v[4 + i] = acc[ai][bj][m][1][i] * rs; }
                    if (do_rope) {
                        float pv[8];
#pragma unroll
                        for (int i = 0; i < 8; ++i) pv[i] = __shfl_xor(v[i], 16);
                        if (fq < 2) { const float sg = fq == 0 ? -1.f : 1.f;
                            const f32x4 c0 = rc[m][0], c1 = rc[m][1], s0 = rc[m][2], s1 = rc[m][3];
#pragma unroll
                            for (int i = 0; i < 4; ++i) { v[i] = v[i] * c0[i] + sg * pv[i] * s0[i]; v[4 + i] = v[4 + i] * c1[i] + sg * pv[4 + i] * s1[i]; } }
                    }
                    float* so = nullptr;
                    bf16* dst;
                    if (type == 0) { dst = XA; if (!samp) { if (t >= SEQ - 3) so = out + O_PCA + (size_t)(b * 3 + (t - (SEQ - 3))) * DL + ct; } else if (t >= 1) so = out + O_SCA + (size_t)(b * 3 + t - 1) * DL + ct; }
                    else if (type == 1) dst = GA;
                    else if (type == 2) { dst = Q;
#pragma unroll
                        for (int i = 0; i < 8; ++i) v[i] *= C2;
                        if (samp) so = QS + (size_t)(row - MP) * 512 + ct; }
                    else if (type == 3) { dst = K; if (!samp) { if (t >= 2048) so = out + O_PWK + (size_t)(b * 2048 + t - 2048) * 512 + ct; } else so = out + O_SWK + (size_t)(b * 4 + t) * 512 + ct; }
                    else { dst = V; if (!samp) { if (t >= 2048) so = out + O_PWV + (size_t)(b * 2048 + t - 2048) * 512 + ct; } else so = out + O_SWV + (size_t)(b * 4 + t) * 512 + ct; }
                    *(v4u*)(dst + (size_t)row * 512 + ct) = pack8(v);
                    if (so) { *(f32x4*)so = (f32x4){v[0], v[1], v[2], v[3]}; *(f32x4*)(so + 4) = (f32x4){v[4], v[5], v[6], v[7]}; }
                }
            }
        }
    }
};
struct EpiX1 {
    static constexpr bool PERM = true, AFTER_DRAIN = false;
    __device__ __forceinline__ void pre(const pg8::Unit&, int, int) const {}
    __device__ __forceinline__ void mid(const pg8::Unit&, int, int) const {}
    const float* xp; const float* xs; float* Y; bf16* X1B; float* SSP;
    __device__ __forceinline__ void operator()(const pg8::f32x4 (&acc)[2][2][4][2], const pg8::Unit& u, int wr, int wc, int fr, int fq, int par) const {
        const int cbase = u.pn * 256 + wc * 32 + 8 * fq;
#pragma unroll
        for (int ai = 0; ai < 2; ++ai) {
            f32x4 xv[4][2][2];
#pragma unroll
            for (int m = 0; m < 4; ++m) { const int row = u.pm * 256 + ai * 128 + wr * 64 + m * 16 + fr;
                const float* xr = row < MP ? xp + (size_t)row * DM : xs + (size_t)(row - MP) * DM;
#pragma unroll
                for (int bj = 0; bj < 2; ++bj) { xv[m][bj][0] = __builtin_nontemporal_load((const f32x4*)(xr + cbase + 128 * bj)); xv[m][bj][1] = __builtin_nontemporal_load((const f32x4*)(xr + cbase + 128 * bj + 4)); } }
#pragma unroll
            for (int m = 0; m < 4; ++m) {
                const int row = u.pm * 256 + ai * 128 + wr * 64 + m * 16 + fr;
                float ss = 0.f;
#pragma unroll
                for (int bj = 0; bj < 2; ++bj) {
                    const int ct = cbase + 128 * bj;
                    const f32x4 o0 = xv[m][bj][0] + acc[ai][bj][m][0], o1 = xv[m][bj][1] + acc[ai][bj][m][1];
                    if (u.pm >= MP / 256) { *(f32x4*)(Y + (size_t)row * DM + ct) = o0; *(f32x4*)(Y + (size_t)row * DM + ct + 4) = o1; }
                    const float v[8] = {o0[0], o0[1], o0[2], o0[3], o1[0], o1[1], o1[2], o1[3]};
                    *(v4u*)(X1B + (size_t)row * DM + ct) = pack8(v);
#pragma unroll
                    for (int i = 0; i < 8; ++i) ss += v[i] * v[i];
                }
                ss += __shfl_xor(ss, 16); ss += __shfl_xor(ss, 32);
                if (fq == 0) SSP[(size_t)row * 16 + u.pn * 4 + wc] = ss;
            }
        }
    }
};
__device__ __forceinline__ float row_rs(const float* SSP, int row) {
    const f32x4* p = (const f32x4*)(SSP + (size_t)row * 16); const f32x4 a = p[0], b = p[1], c = p[2], d = p[3];
    const float s = ((a[0] + a[1]) + (a[2] + a[3])) + ((b[0] + b[1]) + (b[2] + b[3])) + ((c[0] + c[1]) + (c[2] + c[3])) + ((d[0] + d[1]) + (d[2] + d[3]));
    return 1.f / sqrtf(s * (1.f / DM) + EPS);
}
template <int CTRL> __device__ __forceinline__ float dpp_t(float v) { return __builtin_bit_cast(float, __builtin_amdgcn_update_dpp(0, __builtin_bit_cast(int, v), CTRL, 0xf, 0xf, false)); }
#define dpp_f(v, ctrl) dpp_t<ctrl>(v)
template <int CTRL> __device__ __forceinline__ float dpp_b(float v) { return __builtin_bit_cast(float, __builtin_amdgcn_update_dpp(0, __builtin_bit_cast(int, v), CTRL, 0xf, 0xf, true)); }
__device__ __forceinline__ float dpp_ror1(float v) { return __builtin_bit_cast(float, __builtin_amdgcn_update_dpp(0, __builtin_bit_cast(int, v), 0x121, 0xf, 0xf, false)); }
__device__ __forceinline__ float dpp_ror2(float v) { return __builtin_bit_cast(float, __builtin_amdgcn_update_dpp(0, __builtin_bit_cast(int, v), 0x122, 0xf, 0xf, false)); }
struct EpiGU {
    static constexpr bool PERM = true, AFTER_DRAIN = false;
    const float* SSP; bf16* H; const float* cw; const float* cb; const float* scf; float* out; float* HEADU; float* HEADP; float* TAIL; LAS float* ex; LAS float* cwl;
    __device__ __forceinline__ void pre(const pg8::Unit& u, int par, int tid) const {
        const int w = __builtin_amdgcn_readfirstlane(tid >> 6), lane = tid & 63;
        asm volatile("" ::: "memory");
        const char* src = (const char*)(SSP + (size_t)u.pm * 256 * 16) + w * 2048 + lane * 16; LAS unsigned char* dst = (LAS unsigned char*)cwl + 4096 + w * 2048;
        __builtin_amdgcn_global_load_lds((const unsigned*)src, (LAS unsigned*)dst, 16, 0, 0);
        __builtin_amdgcn_global_load_lds((const unsigned*)(src + 1024), (LAS unsigned*)(dst + 1024), 16, 0, 0);
        if (w >= 4) { const int arr = w - 4; const float* sc = (arr < 3 ? cw + arr * DFF : cb) + u.pn * 128 + lane; LAS float* d = cwl + par * 512 + arr * 128;
            __builtin_amdgcn_global_load_lds((const unsigned*)sc, (LAS unsigned*)d, 4, 0, 0);
            __builtin_amdgcn_global_load_lds((const unsigned*)(sc + 64), (LAS unsigned*)(d + 64), 4, 0, 0); }
    }
    __device__ __forceinline__ void mid(const pg8::Unit& u, int par, int tid) const {
        const int w = __builtin_amdgcn_readfirstlane(tid >> 6), lane = tid & 63;
        const LAS f32x4* p = (const LAS f32x4*)((const LAS unsigned char*)cwl + 4096 + w * 2048 + (lane >> 1) * 64 + (lane & 1) * 32);
        const f32x4 a = p[0], b = p[1];
        float s = ((a[0] + a[1]) + (a[2] + a[3])) + ((b[0] + b[1]) + (b[2] + b[3]));
        s += dpp_f(s, 0xB1);
        const float rs = 1.f / sqrtf(s * (1.f / DM) + EPS);
        if (!(lane & 1)) ex[1024 + par * 256 + w * 32 + (lane >> 1)] = rs;
        asm volatile("" ::: "memory");
    }
    __device__ __forceinline__ void operator()(const pg8::f32x4 (&acc)[2][2][4][2], const pg8::Unit& u, int wr, int wc, int fr, int fq, int par) const {
        if (u.pm >= MP / 256) sample_body(acc, u, wr, wc, fr, fq, par); else prompt_body(acc, u, wr, wc, fr, fq, par);
    }
    __device__ __forceinline__ void prompt_body(const pg8::f32x4 (&acc)[2][2][4][2], const pg8::Unit& u, int wr, int wc, int fr, int fq, int par) const {
        const int j0 = u.pn * 128 + wc * 32 + 8 * fq;
        const int wave = wr * 4 + wc;
        float w0[8], w1[8], w2[8], bb[8];
        { const LAS float* cl = cwl + par * 512 + wc * 32 + 8 * fq;
#pragma unroll
          for (int h = 0; h < 2; ++h) { const f32x4 a0 = *(const LAS f32x4*)(cl + 4 * h), a1 = *(const LAS f32x4*)(cl + 128 + 4 * h), a2 = *(const LAS f32x4*)(cl + 256 + 4 * h), a3 = *(const LAS f32x4*)(cl + 384 + 4 * h);
#pragma unroll
              for (int e = 0; e < 4; ++e) { w0[4 * h + e] = a0[e]; w1[4 * h + e] = a1[e]; w2[4 * h + e] = a2[e]; bb[4 * h + e] = a3[e]; } } }
        const bool l15 = fr == 15, l14 = fr >= 14;
#pragma unroll
        for (int ai = 0; ai < 2; ++ai) {
            const float rs = ex[1024 + par * 256 + ai * 128 + wr * 64 + 48 + fr];
            if (fr >= 14) { LAS float* e = ex + ((wave * 2 + ai) * 2 + (fr - 14)) * 32 + 8 * fq;
                *(LAS f32x4*)e = acc[ai][0][3][0] * rs; *(LAS f32x4*)(e + 4) = acc[ai][0][3][1] * rs; }
        }
        asm volatile("s_waitcnt lgkmcnt(0)\n\ts_barrier" ::: "memory");
#pragma unroll
        for (int ai = 0; ai < 2; ++ai) {
            float gp[8];
            bool pending = false;
            if (wr == 0 && ai == 0) {
#pragma unroll
                for (int e = 0; e < 8; ++e) gp[e] = 0.f;
                pending = (u.pm & 15) != 0;
            } else {
                const int sw = (wr == 1) ? wc : 4 + wc, sa = (wr == 1) ? ai : 0;
                const LAS float* e2 = ex + ((sw * 2 + sa) * 2 + (fr & 1)) * 32 + 8 * fq;
                const f32x4 b0 = *(const LAS f32x4*)e2, b1 = *(const LAS f32x4*)(e2 + 4);
#pragma unroll
                for (int e = 0; e < 4; ++e) { gp[e] = b0[e]; gp[4 + e] = b1[e]; }
            }
            float rsv[4];
#pragma unroll
            for (int m = 0; m < 4; ++m) rsv[m] = ex[1024 + par * 256 + ai * 128 + wr * 64 + m * 16 + fr];
#pragma unroll
            for (int m = 0; m < 4; ++m) {
                const int row = u.pm * 256 + ai * 128 + wr * 64 + m * 16 + fr;
                const float rs = rsv[m];
                float g[8], up[8]; unsigned yw[4];
#pragma unroll
                for (int e = 0; e < 4; ++e) { g[e] = acc[ai][0][m][0][e] * rs; g[4 + e] = acc[ai][0][m][1][e] * rs; up[e] = acc[ai][1][m][0][e] * rs; up[4 + e] = acc[ai][1][m][1][e] * rs; }
#pragma unroll
                for (int e2 = 0; e2 < 4; ++e2) {
                    f32x2 x;
#pragma unroll
                    for (int q = 0; q < 2; ++q) { const int e = 2 * e2 + q;
                        const float h1 = l15 ? gp[e] : g[e], h2 = l14 ? gp[e] : g[e];
                        float uc = fmaf(w2[e], g[e], bb[e]);
                        uc = fmaf(dpp_b<0x121>(h1), w1[e], uc); uc = fmaf(dpp_b<0x122>(h2), w0[e], uc);
                        x[q] = uc; }
                    f32x2 t = x * x; t = t * (f32x2){-0.10294324f, -0.10294324f} + (f32x2){-2.3022082f, -2.3022082f}; t = t * x;
                    f32x2 d = (f32x2){__builtin_amdgcn_exp2f(t[0]), __builtin_amdgcn_exp2f(t[1])} + (f32x2){1.f, 1.f};
                    const f32x2 r = (f32x2){__builtin_amdgcn_rcpf(d[0]), __builtin_amdgcn_rcpf(d[1])};
                    const f32x2 y = (x * r) * (f32x2){up[2 * e2], up[2 * e2 + 1]};
                    yw[e2] = pk2(y[0], y[1]);
                }
                const bool hold = pending && m == 0 && fr < 2;
                if (!hold) *(v4u*)(H + (size_t)row * DFF + j0) = (v4u){yw[0], yw[1], yw[2], yw[3]};
                else { float* hu = HEADU + (size_t)(u.pm * 2 + fr) * DFF + j0; float* hp = HEADP + (size_t)(u.pm * 2 + fr) * DFF + j0;
                    *(f32x4*)hu = (f32x4){g[0], g[1], g[2], g[3]}; *(f32x4*)(hu + 4) = (f32x4){g[4], g[5], g[6], g[7]};
                    *(f32x4*)hp = (f32x4){up[0], up[1], up[2], up[3]}; *(f32x4*)(hp + 4) = (f32x4){up[4], up[5], up[6], up[7]}; }
                if (ai == 1 && wr == 1 && m == 3 && fr >= 14) { float* so = TAIL + (size_t)(u.pm * 2 + (fr - 14)) * DFF + j0;
                    if ((u.pm & 15) == 15) { float* so2 = out + O_PCF + (size_t)((u.pm >> 4) * 2 + (fr - 14)) * DFF + j0;
                        *(f32x4*)so2 = (f32x4){g[0], g[1], g[2], g[3]}; *(f32x4*)(so2 + 4) = (f32x4){g[4], g[5], g[6], g[7]}; }
                    *(f32x4*)so = (f32x4){g[0], g[1], g[2], g[3]}; *(f32x4*)(so + 4) = (f32x4){g[4], g[5], g[6], g[7]}; }
#pragma unroll
                for (int e = 0; e < 8; ++e) gp[e] = g[e];
            }
        }
    }
    __device__ __forceinline__ void sample_body(const pg8::f32x4 (&acc)[2][2][4][2], const pg8::Unit& u, int wr, int wc, int fr, int fq, int par) const {
        const int j0 = u.pn * 128 + wc * 32 + 8 * fq;
        constexpr bool samp = true;
        const int wave = wr * 4 + wc;
        float w0[8], w1[8], w2[8], bb[8];
        { const LAS float* cl = cwl + par * 512 + wc * 32 + 8 * fq;
#pragma unroll
          for (int h = 0; h < 2; ++h) { const f32x4 a0 = *(const LAS f32x4*)(cl + 4 * h), a1 = *(const LAS f32x4*)(cl + 128 + 4 * h), a2 = *(const LAS f32x4*)(cl + 256 + 4 * h), a3 = *(const LAS f32x4*)(cl + 384 + 4 * h);
#pragma unroll
              for (int e = 0; e < 4; ++e) { w0[4 * h + e] = a0[e]; w1[4 * h + e] = a1[e]; w2[4 * h + e] = a2[e]; bb[4 * h + e] = a3[e]; } } }
        if (!samp) {
#pragma unroll
            for (int ai = 0; ai < 2; ++ai) {
                const float rs = ex[1024 + par * 256 + ai * 128 + wr * 64 + 48 + fr];
                if (fr >= 14) { LAS float* e = ex + ((wave * 2 + ai) * 2 + (fr - 14)) * 32 + 8 * fq;
                    *(LAS f32x4*)e = acc[ai][0][3][0] * rs; *(LAS f32x4*)(e + 4) = acc[ai][0][3][1] * rs; }
            }
            asm volatile("s_waitcnt lgkmcnt(0)\n\ts_barrier" ::: "memory");
        }
#pragma unroll
        for (int ai = 0; ai < 2; ++ai) {
            float pR1[8], pR2[8];
            bool pending = false;
            if (!samp) {
                if (wr == 0 && ai == 0) {
#pragma unroll
                    for (int e = 0; e < 8; ++e) { pR1[e] = 0.f; pR2[e] = 0.f; }
                    pending = (u.pm & 15) != 0;
                } else {
                    const int sw = (wr == 1) ? wc : 4 + wc, sa = (wr == 1) ? ai : 0;
                    const LAS float* e1 = ex + ((sw * 2 + sa) * 2 + 1) * 32 + 8 * fq; const LAS float* e2 = ex + ((sw * 2 + sa) * 2 + (fr & 1)) * 32 + 8 * fq;
                    const f32x4 a0 = *(const LAS f32x4*)e1, a1 = *(const LAS f32x4*)(e1 + 4), b0 = *(const LAS f32x4*)e2, b1 = *(const LAS f32x4*)(e2 + 4);
#pragma unroll
                    for (int e = 0; e < 4; ++e) { pR1[e] = a0[e]; pR1[4 + e] = a1[e]; pR2[e] = b0[e]; pR2[4 + e] = b1[e]; }
                }
            }
            float rsv[4];
#pragma unroll
            for (int m = 0; m < 4; ++m) rsv[m] = ex[1024 + par * 256 + ai * 128 + wr * 64 + m * 16 + fr];
#pragma unroll
            for (int m = 0; m < 4; ++m) {
                const int row = u.pm * 256 + ai * 128 + wr * 64 + m * 16 + fr;
                const float rs = rsv[m];
                float g[8], up[8]; unsigned yw[4];
#pragma unroll
                for (int e = 0; e < 4; ++e) { g[e] = acc[ai][0][m][0][e] * rs; g[4 + e] = acc[ai][0][m][1][e] * rs; up[e] = acc[ai][1][m][0][e] * rs; up[4 + e] = acc[ai][1][m][1][e] * rs; }
#pragma unroll
                for (int hf = 0; hf < 2; ++hf) {
                    float yh[4];
                    f32x4 s0 = (f32x4){0.f, 0.f, 0.f, 0.f}, s1 = s0; int sq = 3;
                    if (samp) { const int n = (row - MP) >> 2; sq = fr & 3; s0 = *(const f32x4*)(scf + (size_t)(n * 2) * DFF + j0 + 4 * hf); s1 = *(const f32x4*)(scf + (size_t)(n * 2 + 1) * DFF + j0 + 4 * hf); }
#pragma unroll
                    for (int e4 = 0; e4 < 4; ++e4) { const int e = 4 * hf + e4;
                        const float R1 = dpp_ror1(g[e]), R2 = dpp_ror2(g[e]);
                        float p1, p2;
                        if (!samp) { p1 = fr >= 1 ? R1 : pR1[e]; p2 = fr >= 2 ? R2 : pR2[e]; }
                        else { p1 = sq >= 1 ? R1 : s1[e4]; p2 = sq >= 2 ? R2 : (sq == 1 ? s1[e4] : s0[e4]); }
                        const float uc = bb[e] + w0[e] * p2 + w1[e] * p1 + w2[e] * g[e]; yh[e4] = gelu_tanh(uc) * up[e]; pR1[e] = R1; pR2[e] = R2; }
                    yw[2 * hf] = pk2(yh[0], yh[1]); yw[2 * hf + 1] = pk2(yh[2], yh[3]);
                }
                const bool hold = pending && m == 0 && fr < 2;
                if (!hold) *(v4u*)(H + (size_t)row * DFF + j0) = (v4u){yw[0], yw[1], yw[2], yw[3]};
                else { float* hu = HEADU + (size_t)(u.pm * 2 + fr) * DFF + j0; float* hp = HEADP + (size_t)(u.pm * 2 + fr) * DFF + j0;
                    *(f32x4*)hu = (f32x4){g[0], g[1], g[2], g[3]}; *(f32x4*)(hu + 4) = (f32x4){g[4], g[5], g[6], g[7]};
                    *(f32x4*)hp = (f32x4){up[0], up[1], up[2], up[3]}; *(f32x4*)(hp + 4) = (f32x4){up[4], up[5], up[6], up[7]}; }
                float* so = nullptr;
                if (!samp) { if (ai == 1 && wr == 1 && m == 3 && fr >= 14) { so = TAIL + (size_t)(u.pm * 2 + (fr - 14)) * DFF + j0;
                        if ((u.pm & 15) == 15) { float* so2 = out + O_PCF + (size_t)((u.pm >> 4) * 2 + (fr - 14)) * DFF + j0;
                            *(f32x4*)so2 = (f32x4){g[0], g[1], g[2], g[3]}; *(f32x4*)(so2 + 4) = (f32x4){g[4], g[5], g[6], g[7]}; } } }
                else if ((fr & 3) >= 2) so = out + O_SCF + (size_t)(((row - MP) >> 2) * 2 + ((fr & 3) - 2)) * DFF + j0;
                if (so) { *(f32x4*)so = (f32x4){g[0], g[1], g[2], g[3]}; *(f32x4*)(so + 4) = (f32x4){g[4], g[5], g[6], g[7]}; }
            }
        }
    }
};
struct EpiX2 {
    static constexpr bool PERM = true, AFTER_DRAIN = false;
    __device__ __forceinline__ void pre(const pg8::Unit&, int, int) const {}
    __device__ __forceinline__ void mid(const pg8::Unit&, int, int) const {}
    float* Y; const bf16* X1B;
    __device__ __forceinline__ void operator()(const pg8::f32x4 (&acc)[2][2][4][2], const pg8::Unit& u, int wr, int wc, int fr, int fq, int par) const {
        const int cbase = u.pn * 256 + wc * 32 + 8 * fq;
#pragma unroll
        for (int ai = 0; ai < 2; ++ai) {
            v4u xv[4][2];
#pragma unroll
            for (int m = 0; m < 4; ++m) { const bf16* xr = X1B + (size_t)(u.pm * 256 + ai * 128 + wr * 64 + m * 16 + fr) * DM + cbase;
#pragma unroll
                for (int bj = 0; bj < 2; ++bj) xv[m][bj] = *(const v4u*)(xr + 128 * bj); }
#pragma unroll
            for (int m = 0; m < 4; ++m) {
                const int row = u.pm * 256 + ai * 128 + wr * 64 + m * 16 + fr;
#pragma unroll
                for (int bj = 0; bj < 2; ++bj) { float* yp = Y + (size_t)row * DM + cbase + 128 * bj; float x[8]; unpack8(xv[m][bj], x);
                    *(f32x4*)yp = (f32x4){x[0], x[1], x[2], x[3]} + acc[ai][bj][m][0]; *(f32x4*)(yp + 4) = (f32x4){x[4], x[5], x[6], x[7]} + acc[ai][bj][m][1]; }
            }
        }
    }
};
constexpr int CW_X2C = 100000;
struct EpiX2F {
    static constexpr bool PERM = true, AFTER_DRAIN = true;
    __device__ __forceinline__ void pre(const pg8::Unit&, int, int) const {}
    __device__ __forceinline__ void mid(const pg8::Unit&, int, int) const {}
    float* Y; const bf16* X1B; const float* gfin; float* xbuf; unsigned* cnt;
    __device__ __forceinline__ void operator()(const pg8::f32x4 (&)[2][2][4][2], const pg8::Unit&, int, int, int, int, int) const {}
    __device__ __forceinline__ void fused(pg8::f32x4 (&acc)[2][2][4][2], const pg8::Unit& u, int wr, int wc, int fr, int fq, LAS unsigned char* lds, int wid, int lane) const {
        const int cbase = u.pn * 256 + wc * 32 + 8 * fq, tid = wid * 64 + lane;
        LAS float* P = (LAS float*)lds; LAS float* S = P + 1024; LAS unsigned* flag = (LAS unsigned*)(S + 256);
        { v4u xv[2][4][2];
#pragma unroll
          for (int ai = 0; ai < 2; ++ai)
#pragma unroll
            for (int m = 0; m < 4; ++m) { const bf16* xr = X1B + (size_t)(u.pm * 256 + ai * 128 + wr * 64 + m * 16 + fr) * DM + cbase;
#pragma unroll
                for (int bj = 0; bj < 2; ++bj) xv[ai][m][bj] = *(const v4u*)(xr + 128 * bj); }
#pragma unroll
          for (int ai = 0; ai < 2; ++ai)
#pragma unroll
            for (int m = 0; m < 4; ++m) { float ss = 0.f;
#pragma unroll
                for (int bj = 0; bj < 2; ++bj) { float x[8]; unpack8(xv[ai][m][bj], x);
#pragma unroll
                    for (int i = 0; i < 4; ++i) { acc[ai][bj][m][0][i] += x[i]; acc[ai][bj][m][1][i] += x[4 + i]; ss += acc[ai][bj][m][0][i] * acc[ai][bj][m][0][i] + acc[ai][bj][m][1][i] * acc[ai][bj][m][1][i]; } }
                ss += __shfl_xor(ss, 16); ss += __shfl_xor(ss, 32);
                if (fq == 0) P[(ai * 128 + wr * 64 + m * 16 + fr) * 4 + wc] = ss; } }
        asm volatile("s_waitcnt lgkmcnt(0)" ::: "memory"); __builtin_amdgcn_s_barrier(); asm volatile("" ::: "memory");
        if (tid < 256) { const pg8::f32x4 p4 = *(const LAS pg8::f32x4*)(P + tid * 4);
            __hip_atomic_store(xbuf + ((size_t)u.pm * 256 + tid) * 4 + u.pn, (p4[0] + p4[1]) + (p4[2] + p4[3]), __ATOMIC_RELAXED, __HIP_MEMORY_SCOPE_AGENT); }
        asm volatile("s_waitcnt vmcnt(0)" ::: "memory");
        if (lane == 0 && wid < 4) __hip_atomic_fetch_add(cnt + u.pm * 16, 1u, __ATOMIC_RELAXED, __HIP_MEMORY_SCOPE_AGENT);
        if (wid == 0) { unsigned spins = 0;
            while ((unsigned)__builtin_amdgcn_readfirstlane(__hip_atomic_load(cnt + u.pm * 16, __ATOMIC_RELAXED, __HIP_MEMORY_SCOPE_AGENT)) < 16u) { if (++spins > (1u << 20)) break; __builtin_amdgcn_s_sleep(2); }
            __builtin_amdgcn_fence(__ATOMIC_ACQUIRE, "agent"); }
        asm volatile("s_waitcnt vmcnt(0) lgkmcnt(0)" ::: "memory"); __builtin_amdgcn_s_barrier(); asm volatile("" ::: "memory");
        if (tid < 256) { const float* sl = xbuf + ((size_t)u.pm * 256 + tid) * 4; float t = 0.f;
#pragma unroll
            for (int k = 0; k < 4; ++k) t += __hip_atomic_load(sl + k, __ATOMIC_RELAXED, __HIP_MEMORY_SCOPE_AGENT);
            S[tid] = 1.f / sqrtf(t * (1.f / DM) + EPS); }
        asm volatile("s_waitcnt vmcnt(0) lgkmcnt(0)" ::: "memory"); __builtin_amdgcn_s_barrier(); asm volatile("" ::: "memory");
        pg8::f32x4 gv[2][2];
#pragma unroll
        for (int bj = 0; bj < 2; ++bj) { gv[bj][0] = *(const pg8::f32x4*)(gfin + cbase + 128 * bj); gv[bj][1] = *(const pg8::f32x4*)(gfin + cbase + 128 * bj + 4); }
#pragma unroll
        for (int ai = 0; ai < 2; ++ai)
#pragma unroll
            for (int m = 0; m < 4; ++m) { const int rl = ai * 128 + wr * 64 + m * 16 + fr; const float rs = S[rl]; float* yp = Y + (size_t)(u.pm * 256 + rl) * DM + cbase;
#pragma unroll
                for (int bj = 0; bj < 2; ++bj) { *(pg8::f32x4*)(yp + 128 * bj) = acc[ai][bj][m][0] * rs * gv[bj][0]; *(pg8::f32x4*)(yp + 128 * bj + 4) = acc[ai][bj][m][1] * rs * gv[bj][1]; } }
    }
};
struct SampleUnitOrder {
    int c, nw;
    __device__ __forceinline__ bool next(int i, pg8::Unit& u) const { const int L = i * nw + c; if (L >= 2 * (DIN / 256)) return false; u.pm = MP / 256 + L / (DIN / 256); u.pn = L % (DIN / 256); u.ko = 0; return true; }
    __device__ __forceinline__ void a_ready(const pg8::Unit&) const {}
    __device__ __forceinline__ void done(const pg8::Unit&) const {}
};
struct OneUnitOrder : pg8::StaticOrder {
    int i0;
    __device__ __forceinline__ bool next(int i, pg8::Unit& u) const { return i == 0 && pg8::StaticOrder::next(i0, u); }
};
constexpr int KSPLIT = 6, KSPLIT4 = 4;
struct EpiPart {
    static constexpr bool PERM = true, AFTER_DRAIN = false;
    __device__ __forceinline__ void pre(const pg8::Unit&, int, int) const {}
    __device__ __forceinline__ void mid(const pg8::Unit&, int, int) const {}
    float* PART; int kw;
    __device__ __forceinline__ void operator()(const pg8::f32x4 (&acc)[2][2][4][2], const pg8::Unit& u, int wr, int wc, int fr, int fq, int par) const {
        const int cbase = u.pn * 256 + wc * 32 + 8 * fq; float* P = PART + (size_t)(u.ko / kw) * MS * DM;
#pragma unroll
        for (int ai = 0; ai < 2; ++ai)
#pragma unroll
            for (int m = 0; m < 4; ++m) { const int rS = (u.pm - MP / 256) * 256 + ai * 128 + wr * 64 + m * 16 + fr;
#pragma unroll
                for (int bj = 0; bj < 2; ++bj) { float* pp = P + (size_t)rS * DM + cbase + 128 * bj; *(f32x4*)pp = acc[ai][bj][m][0]; *(f32x4*)(pp + 4) = acc[ai][bj][m][1]; } }
    }
};
struct SplitOrder {
    int G, c, ns, kw;
    __device__ __forceinline__ bool next(int i, pg8::Unit& u) const { const int idx = c + i * G; if (idx >= 8 * ns) return false;
        const int sl = idx >> 3, r = idx & 7; u.pm = MP / 256 + (r >> 2); u.pn = r & 3; u.ko = sl * kw; return true; }
    __device__ __forceinline__ void a_ready(const pg8::Unit&) const {}
    __device__ __forceinline__ void done(const pg8::Unit&) const {}
};
struct GatedOrder : pg8::StaticOrder {
    const unsigned* cnt; unsigned need;
    __device__ __forceinline__ void a_ready(const pg8::Unit& u) const {
        if (u.pm < MP / 256) return;
        if (threadIdx.x < 64) { unsigned spins = 0;
            while ((unsigned)__builtin_amdgcn_readfirstlane(__hip_atomic_load(cnt, __ATOMIC_RELAXED, __HIP_MEMORY_SCOPE_AGENT)) < need) { if (++spins > (1u << 20)) break; __builtin_amdgcn_s_sleep(2); }
            __builtin_amdgcn_fence(__ATOMIC_ACQUIRE, "agent");
            asm volatile("s_waitcnt vmcnt(0)" ::: "memory"); }
        asm volatile("" ::: "memory"); __builtin_amdgcn_s_barrier(); asm volatile("" ::: "memory");
    }
};
constexpr int CW_P0A = 90064;
constexpr int CW_CNT4 = 90000;
__device__ __forceinline__ void finalize_x1_sample(const Args& a, int bx, int G, int wave, int lane) {
    unsigned char* ws = a.ws; const float* PART4 = (const float*)(ws + WS_PART4); float* Y = a.out + O_Y; bf16* X1B = (bf16*)(ws + WS_X1B); float* SSP = (float*)(ws + WS_SSP);
    unsigned* cnt = (unsigned*)(ws + WS_CTL) + CW_CNT4;
    for (int r = bx + G * wave; r < MS; r += G * NWAVES) {
        const int row = MP + r; f32x4 v[4]; float ss = 0.f;
#pragma unroll
        for (int j = 0; j < 4; ++j) { v[j] = ((const GAS f32x4*)(a.in[I_XS] + (size_t)r * DM) + lane)[64 * j];
#pragma unroll
            for (int sl = 0; sl < KSPLIT4; ++sl) v[j] += ((const GAS f32x4*)(PART4 + ((size_t)sl * MS + r) * DM) + lane)[64 * j];
            ss += (v[j].x * v[j].x + v[j].y * v[j].y) + (v[j].z * v[j].z + v[j].w * v[j].w); }
        ss = wave_sum(ss);
#pragma unroll
        for (int j = 0; j < 4; ++j) { const size_t e = (size_t)row * DM + 4 * (lane + 64 * j);
            __hip_atomic_store((unsigned long long*)(Y + e), ((unsigned long long)__float_as_uint(v[j].y) << 32) | __float_as_uint(v[j].x), __ATOMIC_RELAXED, __HIP_MEMORY_SCOPE_AGENT);
            __hip_atomic_store((unsigned long long*)(Y + e + 2), ((unsigned long long)__float_as_uint(v[j].w) << 32) | __float_as_uint(v[j].z), __ATOMIC_RELAXED, __HIP_MEMORY_SCOPE_AGENT);
            __hip_atomic_store((unsigned long long*)(X1B + e), ((unsigned long long)pk2(v[j].z, v[j].w) << 32) | pk2(v[j].x, v[j].y), __ATOMIC_RELAXED, __HIP_MEMORY_SCOPE_AGENT); }
        if (lane < 8) __hip_atomic_store((unsigned long long*)(SSP + (size_t)row * 16 + 2 * lane), lane == 0 ? (unsigned long long)__float_as_uint(ss) : 0ull, __ATOMIC_RELAXED, __HIP_MEMORY_SCOPE_AGENT);
        asm volatile("s_waitcnt vmcnt(0)" ::: "memory");
        if (lane == 0) __hip_atomic_fetch_add(cnt, 1u, __ATOMIC_RELAXED, __HIP_MEMORY_SCOPE_AGENT);
    }
}

constexpr int LRU_CS = 64 * 16 + 16;
template <int MODE> __device__ __forceinline__ void lru_item(const Args& a, int item, LAS unsigned char* lds, int wid, int lane) {
    unsigned char* ws = a.ws;
    const bf16* XA = (const bf16*)(ws + WS_XA); const bf16* GAb = (const bf16*)(ws + WS_GA); const bf16* WL = (const bf16*)(ws + WS_WL);
    const float* C8 = (const float*)(ws + WS_C8); float* AGGA = (float*)(ws + WS_AGGA); float* AGGB = (float*)(ws + WS_AGGB); bf16* MIX = (bf16*)(ws + WS_MIX);
    const int seq = item >> 6, chunk = item & 63, g = wid;
    const int row0 = (MODE == 2) ? MP + item * 64 : seq * SEQ + chunk * 64;
    {
        float w[4][8], bb[8];
#pragma unroll
        for (int j = 0; j < 4; ++j) load8_f32(a.in[I_CAW] + j * DL + 8 * lane, w[j]);
        load8_f32(a.in[I_CAB] + 8 * lane, bb);
        if (MODE != 2) {
            v4u xr[11];
#pragma unroll
            for (int k = 0; k < 11; ++k) { const int t = chunk * 64 + wid * 8 - 3 + k;
                if (t >= 0) xr[k] = *(const v4u*)(XA + (size_t)(seq * SEQ + t) * DL + 8 * lane); else xr[k] = (v4u){0u, 0u, 0u, 0u}; }
#pragma unroll
            for (int it = 0; it < 8; ++it) {
                float s[8];
#pragma unroll
                for (int i = 0; i < 8; ++i) s[i] = bb[i];
#pragma unroll
                for (int j = 0; j < 4; ++j) { float x[8]; unpack8(xr[it + j], x);
#pragma unroll
                    for (int i = 0; i < 8; ++i) s[i] += w[j][i] * x[i]; }
                *(LAS v4u*)(lds + lane * LRU_CS + (wid * 8 + it) * 16) = pack8(s);
            }
        } else {
#pragma unroll 1
            for (int it = 0; it < 8; ++it) {
                const int tok = it * 8 + wid;
                float s[8];
#pragma unroll
                for (int i = 0; i < 8; ++i) s[i] = bb[i];
#pragma unroll
                for (int j = 0; j < 4; ++j) {
                    float x[8];
                    const int n = item * 16 + (tok >> 2), e = (tok & 3) + j;
                    if (e < 3) load8_f32(a.in[I_SCA] + (size_t)(n * 3 + e) * DL + 8 * lane, x); else load8_bf16(XA + (size_t)(MP + 4 * n + e - 3) * DL + 8 * lane, x);
#pragma unroll
                    for (int i = 0; i < 8; ++i) s[i] += w[j][i] * x[i];
                }
                *(LAS v4u*)(lds + lane * LRU_CS + tok * 16) = pack8(s);
            }
        }
    }
    __syncthreads();
    const int r32 = lane & 31, hi = lane >> 5;
    float hc0 = 0.f, hc1 = 0.f, At0 = 1.f, At1 = 1.f;
    if (MODE == 1) {
#pragma unroll 1
        for (int c0 = 0; c0 < chunk; c0 += 16) {
            float ca0[16], cb0[16], ca1[16], cb1[16];
#pragma unroll
            for (int u = 0; u < 16; ++u) { const int c = c0 + u; const size_t o = (size_t)(seq * 64 + (c < chunk ? c : 0)) * DL + 64 * g + r32;
                ca0[u] = AGGA[o]; cb0[u] = AGGB[o]; ca1[u] = AGGA[o + 32]; cb1[u] = AGGB[o + 32]; }
#pragma unroll
            for (int u = 0; u < 16; ++u) if (c0 + u < chunk) { hc0 = ca0[u] * hc0 + cb0[u]; hc1 = ca1[u] * hc1 + cb1[u]; }
        }
    }
#pragma unroll 1
    for (int mc = 0; mc < 4; ++mc) {
        const int mt = mc >> 1, ct = mc & 1;
        const int ch = 64 * g + 32 * ct + r32;
        float hcur = ct ? hc1 : hc0, Atc = ct ? At1 : At0;
        bf16x8 af[4];
#pragma unroll
        for (int ks = 0; ks < 4; ++ks) af[ks] = *(const LAS bf16x8*)(lds + (8 * g + 2 * ks + hi) * LRU_CS + (32 * mt + r32) * 16);
        f32x16 D[3];
        const bf16* wlp = WL + (size_t)((g * 192 + 32 * ct + r32) * 64 + 8 * hi);
#pragma unroll
        for (int o = 0; o < 3; ++o) {
            D[o] = f32x16{};
#pragma unroll
            for (int ks = 0; ks < 4; ++ks) {
                const bf16x8 bfr = *(const bf16x8*)(wlp + o * 64 * 64 + 16 * ks);
                D[o] = __builtin_amdgcn_mfma_f32_32x32x16_bf16(af[ks], bfr, D[o], 0, 0, 0);
            }
        }
        const float br = a.in[I_BR][ch], bi = a.in[I_BI][ch], c8 = C8[ch];
        float av[16], uv[16];
#pragma unroll
        for (int r = 0; r < 16; ++r) {
            const float rr = sigmoidf_(D[0][r] + br), gi = sigmoidf_(D[1][r] + bi);
            const float la = -c8 * rr; av[r] = __expf(la); uv[r] = __builtin_amdgcn_sqrtf(one_minus_exp(2.f * la)) * gi * D[2][r];
        }
        if (MODE == 2) {
#pragma unroll
            for (int k = 0; k < 4; ++k) {
                const int n = item * 16 + 8 * mt + 2 * k + hi;
                float hh = a.in[I_SLH][(size_t)n * DL + ch];
#pragma unroll
                for (int i = 0; i < 4; ++i) { hh = av[4 * k + i] * hh + uv[4 * k + i]; uv[4 * k + i] = hh; }
                a.out[O_SLH + (size_t)n * DL + ch] = hh;
            }
        } else {
#pragma unroll
            for (int k = 0; k < 4; ++k) {
                const float a0 = av[4 * k], a1 = av[4 * k + 1], a2 = av[4 * k + 2], a3 = av[4 * k + 3];
                const float GAm = (a0 * a1) * (a2 * a3), GBm = ((uv[4 * k] * a1 + uv[4 * k + 1]) * a2 + uv[4 * k + 2]) * a3 + uv[4 * k + 3];
                const float Ao = __shfl_xor(GAm, 32), Bo = __shfl_xor(GBm, 32);
                const float A1 = hi ? Ao : GAm, B1 = hi ? Bo : GBm, A2 = hi ? GAm : Ao, B2 = hi ? GBm : Bo;
                const float hin1 = hcur; hcur = A1 * hcur + B1; const float hin2 = hcur; hcur = A2 * hcur + B2; Atc *= A1 * A2;
                if (MODE == 1) { float hh = hi ? hin2 : hin1;
#pragma unroll
                    for (int i = 0; i < 4; ++i) { hh = av[4 * k + i] * hh + uv[4 * k + i]; uv[4 * k + i] = hh; } }
            }
        }
        if (MODE != 0) {
            const bf16* gap = GAb + (size_t)(row0 + 32 * mt + 4 * hi) * DL + ch; bf16* mxp = MIX + (size_t)(row0 + 32 * mt + 4 * hi) * DM + ch;
            bf16 gv[16];
#pragma unroll
            for (int r = 0; r < 16; ++r) gv[r] = gap[((r & 3) + 8 * (r >> 2)) * DL];
#pragma unroll
            for (int r = 0; r < 16; ++r) { const int ro = (r & 3) + 8 * (r >> 2); mxp[ro * DM] = (bf16)f2bf(uv[r] * gelu_tanh(bf2f(gv[r]))); }
        }
        if (ct) { hc1 = hcur; At1 = Atc; } else { hc0 = hcur; At0 = Atc; }
    }
#pragma unroll
    for (int ct = 0; ct < 2; ++ct) {
        const int ch = 64 * g + 32 * ct + r32; const float Af = ct ? At1 : At0, hf = ct ? hc1 : hc0;
        if (MODE == 0) { if (hi == 0) { AGGA[(size_t)(seq * 64 + chunk) * DL + ch] = Af; AGGB[(size_t)(seq * 64 + chunk) * DL + ch] = hf; } }
        if (MODE == 1) { if (chunk == 63 && hi == 0) a.out[O_PLH + (size_t)seq * DL + ch] = hf; }
    }
    __syncthreads();
}

constexpr int CW_LRUF = 16384;
constexpr int LRF_CS = 1024, LRF_GA = 64 * LRF_CS;
__device__ __forceinline__ void lru_fused_item(const Args& a, int item, LAS unsigned char* lds, int wid, int lane) {
    unsigned char* ws = a.ws;
    const bf16* XA = (const bf16*)(ws + WS_XA); const bf16* GAb = (const bf16*)(ws + WS_GA); const bf16* WL = (const bf16*)(ws + WS_WL);
    const float* C8 = (const float*)(ws + WS_C8); unsigned long long* AGG2 = (unsigned long long*)(ws + WS_AGGA); bf16* MIX = (bf16*)(ws + WS_MIX);
    unsigned* flags = (unsigned*)(ws + WS_CTL) + CW_LRUF;
    asm volatile("" : "+v"(lane));
    const int seq = item >> 6, chunk = item & 63, g = wid;
    const int row0 = seq * SEQ + chunk * 64;
    {
        float w[4][8], bb[8];
#pragma unroll
        for (int j = 0; j < 4; ++j) load8_f32(a.in[I_CAW] + j * DL + 8 * lane, w[j]);
        load8_f32(a.in[I_CAB] + 8 * lane, bb);
        v4u xr[11];
#pragma unroll
        for (int k = 0; k < 11; ++k) { const int t = chunk * 64 + wid * 8 - 3 + k;
            if (t >= 0) xr[k] = *(const v4u*)(XA + (size_t)(seq * SEQ + t) * DL + 8 * lane); else xr[k] = (v4u){0u, 0u, 0u, 0u}; }
#pragma unroll
        for (int it = 0; it < 8; ++it) {
            float s8[8];
#pragma unroll
            for (int i = 0; i < 8; ++i) s8[i] = bb[i];
#pragma unroll
            for (int j = 0; j < 4; ++j) { float x[8]; unpack8(xr[it + j], x);
#pragma unroll
                for (int i = 0; i < 8; ++i) s8[i] += w[j][i] * x[i]; }
            *(LAS v4u*)(lds + lane * LRF_CS + (wid * 8 + it) * 16) = pack8(s8);
        }
#pragma unroll
        for (int it = 0; it < 8; ++it) xr[it] = *(const v4u*)(GAb + (size_t)(row0 + wid * 8 + it) * DL + 8 * lane);
#pragma unroll
        for (int it = 0; it < 8; ++it) *(LAS v4u*)(lds + LRF_GA + (wid * 8 + it) * 1024 + lane * 16) = xr[it];
    }
    __syncthreads();
    int r32 = lane & 31, hi = lane >> 5;
    unsigned pk[4][16];
    float At0 = 1.f, At1 = 1.f, Bt0 = 0.f, Bt1 = 0.f;
    bf16x8 bw[2][4];
#pragma unroll
    for (int mc = 0; mc < 4; ++mc) {
        const int ct = mc >> 1, mt = mc & 1;
        if (mt == 0) {
#pragma unroll
            for (int o = 0; o < 2; ++o)
#pragma unroll
                for (int ks = 0; ks < 4; ++ks) bw[o][ks] = *(const bf16x8*)(WL + (size_t)((g * 192 + 64 * o + 32 * ct + r32) * 64 + 16 * ks + 8 * hi));
        }
        const int ch = 64 * g + 32 * ct + r32;
        bf16x8 af[4];
#pragma unroll
        for (int ks = 0; ks < 4; ++ks) af[ks] = *(const LAS bf16x8*)(lds + (8 * g + 2 * ks + hi) * LRF_CS + (32 * mt + r32) * 16);
        f32x16 D[3];
#pragma unroll
        for (int o = 0; o < 2; ++o) {
            D[o] = f32x16{};
#pragma unroll
            for (int ks = 0; ks < 4; ++ks) D[o] = __builtin_amdgcn_mfma_f32_32x32x16_bf16(af[ks], bw[o][ks], D[o], 0, 0, 0);
        }
        {
            const LAS unsigned short* xp = (const LAS unsigned short*)(lds + (8 * g + 4 * ct + (r32 >> 3)) * LRF_CS + (32 * mt + 4 * hi) * 16 + (r32 & 7) * 2);
#pragma unroll
            for (int r = 0; r < 16; ++r) D[2][r] = bf2f(xp[((r & 3) + 8 * (r >> 2)) * 8]);
        }
        const float br = a.in[I_BR][ch], bi = a.in[I_BI][ch], c8 = C8[ch];
#pragma unroll
        for (int r = 0; r < 16; ++r) {
            const float rr = sigmoidf_(D[0][r] + br), gi = sigmoidf_(D[1][r] + bi);
            const float la = -c8 * rr, oma = one_minus_exp(la); pk[2 * mt + ct][r] = pk2(oma, __builtin_amdgcn_sqrtf(oma * (2.f - oma)) * gi * D[2][r]);
        }
        float Atc = ct ? At1 : At0, Btc = ct ? Bt1 : Bt0;
#pragma unroll
        for (int k = 0; k < 4; ++k) {
            const float a0 = 1.f - bflo(pk[2 * mt + ct][4 * k]), a1 = 1.f - bflo(pk[2 * mt + ct][4 * k + 1]), a2 = 1.f - bflo(pk[2 * mt + ct][4 * k + 2]), a3 = 1.f - bflo(pk[2 * mt + ct][4 * k + 3]);
            const float GAm = (a0 * a1) * (a2 * a3), GBm = ((bfhi(pk[2 * mt + ct][4 * k]) * a1 + bfhi(pk[2 * mt + ct][4 * k + 1])) * a2 + bfhi(pk[2 * mt + ct][4 * k + 2])) * a3 + bfhi(pk[2 * mt + ct][4 * k + 3]);
            const float Ao = __shfl_xor(GAm, 32), Bo = __shfl_xor(GBm, 32);
            const float A1 = hi ? Ao : GAm, B1 = hi ? Bo : GBm, A2 = hi ? GAm : Ao, B2 = hi ? GBm : Bo;
            Btc = A1 * Btc + B1; Btc = A2 * Btc + B2; Atc *= A1 * A2;
        }
        if (ct) { At1 = Atc; Bt1 = Btc; } else { At0 = Atc; Bt0 = Btc; }
        asm volatile("" ::: "memory");
    }
    if (hi == 0) {
        __hip_atomic_store(AGG2 + (size_t)(seq * 64 + chunk) * DL + 64 * g + r32, ((unsigned long long)__float_as_uint(Bt0) << 32) | __float_as_uint(At0), __ATOMIC_RELAXED, __HIP_MEMORY_SCOPE_AGENT);
        __hip_atomic_store(AGG2 + (size_t)(seq * 64 + chunk) * DL + 64 * g + 32 + r32, ((unsigned long long)__float_as_uint(Bt1) << 32) | __float_as_uint(At1), __ATOMIC_RELAXED, __HIP_MEMORY_SCOPE_AGENT);
    }
    asm volatile("s_waitcnt vmcnt(0)" ::: "memory");
    if (lane == 0) __hip_atomic_store(flags + (size_t)((seq * 64 + chunk) * 8 + g) * 16, 1u, __ATOMIC_RELAXED, __HIP_MEMORY_SCOPE_AGENT);
    {
        const unsigned* fp = flags + (size_t)((seq * 64 + (lane < chunk ? lane : 0)) * 8 + g) * 16;
        unsigned spins = 0;
        for (;;) {
            const unsigned v = (lane < chunk) ? __hip_atomic_load(fp, __ATOMIC_RELAXED, __HIP_MEMORY_SCOPE_AGENT) : 1u;
            if (__all(v != 0u)) break;
            if (++spins > (1u << 20)) break;
            __builtin_amdgcn_s_sleep(2);
        }
        asm volatile("" ::: "memory");
    }
    float hc0, hc1;
    {
        const int cmid = chunk >> 1, cb = hi ? cmid : 0, ce = hi ? chunk : cmid;
        float A0 = 1.f, B0 = 0.f, A1 = 1.f, B1 = 0.f;
#pragma unroll 1
        for (int c0 = cb; c0 < ce; c0 += 12) {
            unsigned long long p0[12], p1[12];
#pragma unroll
            for (int u = 0; u < 12; ++u) { const int c = c0 + u; const size_t o = (size_t)(seq * 64 + (c < ce ? c : cb)) * DL + 64 * g + r32;
                p0[u] = __hip_atomic_load(AGG2 + o, __ATOMIC_RELAXED, __HIP_MEMORY_SCOPE_AGENT); p1[u] = __hip_atomic_load(AGG2 + o + 32, __ATOMIC_RELAXED, __HIP_MEMORY_SCOPE_AGENT); }
#pragma unroll
            for (int u = 0; u < 12; ++u) if (c0 + u < ce) {
                const float a0 = __uint_as_float((unsigned)p0[u]), b0 = __uint_as_float((unsigned)(p0[u] >> 32)), a1 = __uint_as_float((unsigned)p1[u]), b1 = __uint_as_float((unsigned)(p1[u] >> 32));
                B0 = a0 * B0 + b0; A0 *= a0; B1 = a1 * B1 + b1; A1 *= a1; }
        }
        const float Bl0 = __shfl_xor(B0, 32), Bl1 = __shfl_xor(B1, 32);
        const float lo0 = hi ? Bl0 : B0, lo1 = hi ? Bl1 : B1;
        const float Ah0 = __shfl_xor(A0, 32), Ah1 = __shfl_xor(A1, 32);
        const float uA0 = hi ? A0 : Ah0, uA1 = hi ? A1 : Ah1, uB0 = hi ? B0 : Bl0, uB1 = hi ? B1 : Bl1;
        hc0 = uA0 * lo0 + uB0; hc1 = uA1 * lo1 + uB1;
    }
#pragma unroll
    for (int mc = 0; mc < 4; ++mc) {
        const int mt = mc >> 1, ct = mc & 1;
        asm volatile("" : "+v"(r32), "+v"(hi));
        const int ch = 64 * g + 32 * ct + r32;
        float hcur = ct ? hc1 : hc0;
        LAS unsigned short* gy = (LAS unsigned short*)(lds + LRF_GA + (32 * mt + 4 * hi) * 1024 + (32 * ct + 64 * g + r32) * 2);
#pragma unroll
        for (int k = 0; k < 4; ++k) {
            const float a0 = 1.f - bflo(pk[mc][4 * k]), a1 = 1.f - bflo(pk[mc][4 * k + 1]), a2 = 1.f - bflo(pk[mc][4 * k + 2]), a3 = 1.f - bflo(pk[mc][4 * k + 3]);
            const float GAm = (a0 * a1) * (a2 * a3), GBm = ((bfhi(pk[mc][4 * k]) * a1 + bfhi(pk[mc][4 * k + 1])) * a2 + bfhi(pk[mc][4 * k + 2])) * a3 + bfhi(pk[mc][4 * k + 3]);
            const float Ao = __shfl_xor(GAm, 32), Bo = __shfl_xor(GBm, 32);
            const float A1 = hi ? Ao : GAm, B1 = hi ? Bo : GBm, A2 = hi ? GAm : Ao, B2 = hi ? GBm : Bo;
            const float hin1 = hcur; hcur = A1 * hcur + B1; const float hin2 = hcur; hcur = A2 * hcur + B2;
            float hh = hi ? hin2 : hin1;
#pragma unroll
            for (int i = 0; i < 4; ++i) { hh = (1.f - bflo(pk[mc][4 * k + i])) * hh + bfhi(pk[mc][4 * k + i]); pk[mc][4 * k + i] = __float_as_uint(hh); }
        }
#pragma unroll
        for (int r = 0; r < 16; ++r) { const int ro = (r & 3) + 8 * (r >> 2); gy[ro * 512] = (unsigned short)(pk2(__uint_as_float(pk[mc][r]) * gelu_tanh(bf2f(gy[ro * 512])), 0.f) & 0xffffu); }
        if (ct) hc1 = hcur; else hc0 = hcur;
        asm volatile("" ::: "memory");
    }
    __syncthreads();
    {
        const int tid_ = wid * 64 + lane;
#pragma unroll
        for (int i = 0; i < 8; ++i) { const int pc = tid_ + NTHR * i, tok = pc >> 6, c16 = pc & 63;
            *(v4u*)(MIX + (size_t)(row0 + tok) * DM + c16 * 8) = *(const LAS v4u*)(lds + LRF_GA + tok * 1024 + c16 * 16); }
    }
    if (chunk == 63 && hi == 0) { a.out[O_PLH + (size_t)seq * DL + 64 * g + r32] = hc0; a.out[O_PLH + (size_t)seq * DL + 64 * g + 32 + r32] = hc1; }
    __syncthreads();
}

constexpr int NK = 384, KCS = NK * 16 + 16, VDS = NK * 64 + 64, ATT_K = 0, ATT_V = 8 * KCS, ATT_WS = ATT_V + 2 * VDS;
static_assert(ATT_WS + NWAVES * 256 <= RING_BYTES, "attention LDS");
__device__ __forceinline__ s16x4 vtr(const LAS unsigned char* p) { typedef short v4i16_t __attribute__((ext_vector_type(4))); return __builtin_bit_cast(s16x4, __builtin_amdgcn_ds_read_tr16_b64_v4i16((LAS v4i16_t*)p)); }

__device__ __forceinline__ void attn_prompt_unit(const Args& a, int unit, LAS unsigned char* lds, int tid, int wid, int lane) {
    unsigned char* ws = a.ws;
    const bf16* Qb = (const bf16*)(ws + WS_Q); const bf16* Kb = (const bf16*)(ws + WS_K); const bf16* Vb = (const bf16*)(ws + WS_V);
    bf16* OP = (bf16*)(ws + WS_OP); float* LSE = (float*)(ws + WS_LSE);
    const int u16 = unit & 15, p = (unit >> 4) % 3, bh = unit / 48, b = bh >> 3, h = bh & 7;
    const int ld = 2 * p, d = 1 << ld;
    const int lnb = 4 - ld, blk = u16 & ((1 << lnb) - 1), r = u16 >> lnb;
    const int j0 = 256 * blk - 128;
    const int kk_min = (blk == 0) ? 128 : 0;
    const size_t rowb = (size_t)b * SEQ;
#pragma unroll
    for (int i = 0; i < 6; ++i) {
        const int piece = tid + NTHR * i, kk = piece >> 3, c = piece & 7;
        if (kk >= kk_min) {
            const size_t row = rowb + (size_t)(r + d * (j0 + kk));
            const v4u kv = *(const v4u*)(Kb + row * 512 + h * 64 + c * 8), vv = *(const v4u*)(Vb + row * 512 + h * 64 + c * 8);
            *(LAS v4u*)(lds + ATT_K + c * KCS + kk * 16) = kv;
            *(LAS v4u*)(lds + ATT_V + (c >> 2) * VDS + kk * 64 + (c & 3) * 16) = vv;
        }
    }
    const int r32 = lane & 31, hi = lane >> 5;
    bf16x8 qr[4];
    { const size_t qrow = rowb + (size_t)(r + d * (256 * blk + 32 * wid + r32));
#pragma unroll
      for (int ks = 0; ks < 4; ++ks) qr[ks] = *(const bf16x8*)(Qb + qrow * 512 + h * 64 + 16 * ks + 8 * hi); }
    __syncthreads();
    const int kt0 = (blk == 0 && wid < 4) ? 4 - wid : 0;
    f32x16 pt[5];
#pragma unroll
    for (int kt = 0; kt < 5; ++kt) {
        if (kt >= kt0) {
            const int T = wid + kt; f32x16 acc = f32x16{};
#pragma unroll
            for (int ks = 0; ks < 4; ++ks) { const bf16x8 kf = *(const LAS bf16x8*)(lds + ATT_K + (2 * ks + hi) * KCS + (32 * T + r32) * 16);
                acc = __builtin_amdgcn_mfma_f32_32x32x16_bf16(kf, qr[ks], acc, 0, 0, 0); }
            if (kt == 0) {
#pragma unroll
                for (int rg = 0; rg < 16; ++rg) if (crow(rg, hi) < r32) acc[rg] = -INFINITY; }
            if (kt == 4) {
#pragma unroll
                for (int rg = 0; rg < 16; ++rg) if (crow(rg, hi) > r32) acc[rg] = -INFINITY; }
            pt[kt] = acc;
        } else {
#pragma unroll
            for (int rg = 0; rg < 16; ++rg) pt[kt][rg] = -INFINITY;
        }
    }
    float mx = -INFINITY;
#pragma unroll
    for (int kt = 0; kt < 5; ++kt)
#pragma unroll
        for (int rg = 0; rg < 16; ++rg) mx = fmaxf(mx, pt[kt][rg]);
    mx = fmaxf(mx, __shfl_xor(mx, 32));
    float lsum = 0.f;
#pragma unroll
    for (int kt = 0; kt < 5; ++kt)
#pragma unroll
        for (int rg = 0; rg < 16; ++rg) { const float e = __builtin_amdgcn_exp2f(pt[kt][rg] - mx); pt[kt][rg] = e; lsum += e; }
    lsum += __shfl_xor(lsum, 32);
    f32x16 o[2]; o[0] = f32x16{}; o[1] = f32x16{};
    const LAS unsigned char* vb = lds + ATT_V + ((lane >> 4) & 1) * 32 + (lane & 3) * 8 + (4 * hi + ((lane & 15) >> 2)) * 64;
#pragma unroll
    for (int kt = 0; kt < 5; ++kt) {
        if (kt >= kt0) {
            const int T = wid + kt;
#pragma unroll
            for (int s = 0; s < 2; ++s) {
                v4u pw; pw.x = pg8::cvt_pk_bf16(pt[kt][8 * s], pt[kt][8 * s + 1]); pw.y = pg8::cvt_pk_bf16(pt[kt][8 * s + 2], pt[kt][8 * s + 3]);
                pw.z = pg8::cvt_pk_bf16(pt[kt][8 * s + 4], pt[kt][8 * s + 5]); pw.w = pg8::cvt_pk_bf16(pt[kt][8 * s + 6], pt[kt][8 * s + 7]);
                const bf16x8 pa = __builtin_bit_cast(bf16x8, pw);
#pragma unroll
                for (int d0 = 0; d0 < 2; ++d0) {
                    const LAS unsigned char* vp = vb + d0 * VDS + (32 * T + 16 * s) * 64;
                    const s16x4 lo = vtr(vp), hh = vtr(vp + 512);
                    const bf16x8 vf = (bf16x8){lo[0], lo[1], lo[2], lo[3], hh[0], hh[1], hh[2], hh[3]};
                    o[d0] = __builtin_amdgcn_mfma_f32_32x32x16_bf16(pa, vf, o[d0], 0, 0, 0);
                }
            }
        }
    }
    LAS float* wsf = (LAS float*)(lds + ATT_WS) + wid * 64;
    if (hi == 0) wsf[r32] = __builtin_amdgcn_rcpf(lsum);
    const size_t qrow_l = rowb + (size_t)(r + d * (256 * blk + 32 * wid + r32));
    if (hi == 0) LSE[((size_t)p * MP + qrow_l) * 8 + h] = mx + __builtin_amdgcn_logf(lsum);
    LDS_WAIT(); asm volatile("" ::: "memory");
#pragma unroll
    for (int rg = 0; rg < 16; ++rg) {
        const int qi = crow(rg, hi); const float rl = wsf[qi];
        const size_t orow = rowb + (size_t)(r + d * (256 * blk + 32 * wid + qi));
        bf16* op = OP + ((size_t)p * MP + orow) * 512 + h * 64 + r32;
        { const unsigned w2 = pk2(o[0][rg] * rl, o[1][rg] * rl); op[0] = (bf16)(w2 & 0xffffu); op[32] = (bf16)(w2 >> 16); }
    }
    __syncthreads();
}

constexpr int AP_K = 0, AP_KCS = NK * 16, AP_V = 8 * AP_KCS, AP_VDS = NK * 64, AP_VBUF = 2 * AP_VDS, AP_WS = AP_V + 2 * AP_VBUF;
static_assert(AP_WS + NWAVES * 256 <= LDSCTL_OFF, "pipelined attention LDS");
struct APUnit { int b, h, p, d, r, blk; };
__device__ __forceinline__ APUnit ap_decode(int unit) { APUnit u; const int u16 = unit & 15; u.p = (unit >> 4) % 3; const int bh = unit / 48; u.b = bh >> 3; u.h = bh & 7;
    const int ld = 2 * u.p; u.d = 1 << ld; const int lnb = 4 - ld; u.blk = u16 & ((1 << lnb) - 1); u.r = u16 >> lnb; return u; }
__device__ __forceinline__ void ap_issue_k(const APUnit& u, const bf16* Kb, LAS unsigned char* lds, int wid, int lane) {
#pragma unroll
    for (int i = 0; i < 6; ++i) { const int j = wid + 8 * i, c = j & 7, kb = j >> 3;
        if (u.blk == 0 && kb < 2) continue;
        const size_t row = (size_t)u.b * SEQ + (size_t)(u.r + u.d * (256 * u.blk - 128 + 64 * kb + lane));
        __builtin_amdgcn_global_load_lds((const unsigned*)(Kb + row * 512 + u.h * 64 + c * 8), (LAS unsigned*)(lds + AP_K + c * AP_KCS + kb * 1024), 16, 0, 0); }
}
__device__ __forceinline__ void ap_issue_v(const APUnit& u, const bf16* Vb, LAS unsigned char* lds, int vbuf, int wid, int lane) {
#pragma unroll
    for (int i = 0; i < 6; ++i) { const int j = wid + 8 * i, dh = j & 1, kb16 = j >> 1;
        if (u.blk == 0 && kb16 < 8) continue;
        const size_t row = (size_t)u.b * SEQ + (size_t)(u.r + u.d * (256 * u.blk - 128 + 16 * kb16 + (lane >> 2)));
        __builtin_amdgcn_global_load_lds((const unsigned*)(Vb + row * 512 + u.h * 64 + dh * 32 + (lane & 3) * 8), (LAS unsigned*)(lds + AP_V + vbuf * AP_VBUF + dh * AP_VDS + kb16 * 1024), 16, 0, 0); }
}
__device__ __forceinline__ void ap_load_q(const APUnit& u, const bf16* Qb, bf16x8 (&qr)[4], int wid, int lane) {
    const int r32 = lane & 31, hi = lane >> 5;
    const size_t qrow = (size_t)u.b * SEQ + (size_t)(u.r + u.d * (256 * u.blk + 32 * wid + r32));
#pragma unroll
    for (int ks = 0; ks < 4; ++ks) qr[ks] = *(const bf16x8*)(Qb + qrow * 512 + u.h * 64 + 16 * ks + 8 * hi);
}
__device__ __forceinline__ void attn_prompt_phase(const Args& a, LAS unsigned char* lds, int bx, int G, int n_units, int tid, int wid, int lane) {
    unsigned char* ws = a.ws;
    const bf16* Qb = (const bf16*)(ws + WS_Q); const bf16* Kb = (const bf16*)(ws + WS_K); const bf16* Vb = (const bf16*)(ws + WS_V);
    bf16* OP = (bf16*)(ws + WS_OP); float* LSE = (float*)(ws + WS_LSE);
    const int r32 = lane & 31, hi = lane >> 5;
    if (bx >= n_units) return;
    APUnit cur = ap_decode(bx);
    bf16x8 qn[4];
    ap_issue_k(cur, Kb, lds, wid, lane); ap_issue_v(cur, Vb, lds, 0, wid, lane); ap_load_q(cur, Qb, qn, wid, lane);
    int vb_i = 0;
#pragma unroll 1
    for (int unit = bx; unit < n_units; unit += G, vb_i ^= 1) {
        const bool has_next = unit + G < n_units;
        APUnit nxt = cur; if (has_next) nxt = ap_decode(unit + G);
        asm volatile("s_waitcnt vmcnt(0)" ::: "memory"); __syncthreads();
        if (has_next) ap_issue_v(nxt, Vb, lds, vb_i ^ 1, wid, lane);
        bf16x8 qr[4];
#pragma unroll
        for (int ks = 0; ks < 4; ++ks) qr[ks] = qn[ks];
        const int kt0 = (cur.blk == 0 && wid < 4) ? 4 - wid : 0;
        f32x16 pt[5];
#pragma unroll
        for (int kt = 0; kt < 5; ++kt) {
            if (kt >= kt0) {
                const int T = wid + kt; f32x16 acc = f32x16{};
#pragma unroll
                for (int ks = 0; ks < 4; ++ks) { const bf16x8 kf = *(const LAS bf16x8*)(lds + AP_K + (2 * ks + hi) * AP_KCS + (32 * T + r32) * 16);
                    acc = __builtin_amdgcn_mfma_f32_32x32x16_bf16(kf, qr[ks], acc, 0, 0, 0); }
                if (kt == 0) {
#pragma unroll
                    for (int rg = 0; rg < 16; ++rg) if (crow(rg, hi) < r32) acc[rg] = -INFINITY; }
                if (kt == 4) {
#pragma unroll
                    for (int rg = 0; rg < 16; ++rg) if (crow(rg, hi) > r32) acc[rg] = -INFINITY; }
                pt[kt] = acc;
            } else {
#pragma unroll
                for (int rg = 0; rg < 16; ++rg) pt[kt][rg] = -INFINITY;
            }
        }
        asm volatile("s_waitcnt lgkmcnt(0)" ::: "memory"); __syncthreads();
        if (has_next) { ap_issue_k(nxt, Kb, lds, wid, lane); ap_load_q(nxt, Qb, qn, wid, lane); }
        float mx = -INFINITY;
#pragma unroll
        for (int kt = 0; kt < 5; ++kt)
#pragma unroll
            for (int rg = 0; rg < 16; ++rg) mx = fmaxf(mx, pt[kt][rg]);
        mx = fmaxf(mx, __shfl_xor(mx, 32));
        float lsum = 0.f;
#pragma unroll
        for (int kt = 0; kt < 5; ++kt)
#pragma unroll
            for (int rg = 0; rg < 16; ++rg) { const float e = __builtin_amdgcn_exp2f(pt[kt][rg] - mx); pt[kt][rg] = e; lsum += e; }
        lsum += __shfl_xor(lsum, 32);
        f32x16 o[2]; o[0] = f32x16{}; o[1] = f32x16{};
        const LAS unsigned char* vb = lds + AP_V + vb_i * AP_VBUF + ((lane >> 4) & 1) * 32 + (lane & 3) * 8 + (4 * hi + ((lane & 15) >> 2)) * 64;
#pragma unroll
        for (int kt = 0; kt < 5; ++kt) {
            if (kt >= kt0) {
                const int T = wid + kt;
#pragma unroll
                for (int s2 = 0; s2 < 2; ++s2) {
                    v4u pw; pw.x = pg8::cvt_pk_bf16(pt[kt][8 * s2], pt[kt][8 * s2 + 1]); pw.y = pg8::cvt_pk_bf16(pt[kt][8 * s2 + 2], pt[kt][8 * s2 + 3]);
                    pw.z = pg8::cvt_pk_bf16(pt[kt][8 * s2 + 4], pt[kt][8 * s2 + 5]); pw.w = pg8::cvt_pk_bf16(pt[kt][8 * s2 + 6], pt[kt][8 * s2 + 7]);
                    const bf16x8 pa = __builtin_bit_cast(bf16x8, pw);
#pragma unroll
                    for (int d0 = 0; d0 < 2; ++d0) {
                        const LAS unsigned char* vp = vb + d0 * AP_VDS + (32 * T + 16 * s2) * 64;
                        const s16x4 lo = vtr(vp), hh = vtr(vp + 512);
                        const bf16x8 vf = (bf16x8){lo[0], lo[1], lo[2], lo[3], hh[0], hh[1], hh[2], hh[3]};
                        o[d0] = __builtin_amdgcn_mfma_f32_32x32x16_bf16(pa, vf, o[d0], 0, 0, 0);
                    }
                }
            }
        }
        LAS float* wsf = (LAS float*)(lds + AP_WS) + wid * 64;
        if (hi == 0) wsf[r32] = __builtin_amdgcn_rcpf(lsum);
        const size_t rowb = (size_t)cur.b * SEQ;
        const size_t qrow_l = rowb + (size_t)(cur.r + cur.d * (256 * cur.blk + 32 * wid + r32));
        if (hi == 0) LSE[((size_t)cur.p * MP + qrow_l) * 8 + cur.h] = mx + __builtin_amdgcn_logf(lsum);
        LDS_WAIT(); asm volatile("" ::: "memory");
#pragma unroll
        for (int rg = 0; rg < 16; ++rg) {
            const int qi = crow(rg, hi); const float rl = wsf[qi];
            const size_t orow = rowb + (size_t)(cur.r + cur.d * (256 * cur.blk + 32 * wid + qi));
            bf16* op = OP + ((size_t)cur.p * MP + orow) * 512 + cur.h * 64 + r32;
            { const unsigned w2 = pk2(o[0][rg] * rl, o[1][rg] * rl); op[0] = (bf16)(w2 & 0xffffu); op[32] = (bf16)(w2 >> 16); }
        }
        cur = nxt;
    }
    asm volatile("s_waitcnt vmcnt(0) lgkmcnt(0)" ::: "memory"); __syncthreads();
}

__device__ __forceinline__ void attn_sample_item(const Args& a, int item, LAS unsigned char* lds, int tid, int wid, int lane) {
    unsigned char* ws = a.ws;
    const float* QS = (const float*)(ws + WS_QS); bf16* MIX = (bf16*)(ws + WS_MIX);
    const float* CK = a.in[I_CK]; const float* CV = a.in[I_CV];
    asm volatile("" : "+v"(lane));
    const int n = item >> 3, h = item & 7, sub = lane & 15, grp = lane >> 4;
    f32x4 q[4];
#pragma unroll
    for (int s = 0; s < 4; ++s) q[s] = *(const f32x4*)(QS + (size_t)(4 * n + s) * 512 + h * 64 + 4 * sub);
    float m[4], l[4]; f32x4 O[4];
#pragma unroll
    for (int s = 0; s < 4; ++s) { m[s] = -1e30f; l[s] = 0.f; O[s] = (f32x4){0.f, 0.f, 0.f, 0.f}; }
#define SA_ROW(t_) (((t_) < 16) ? 1536 + (t_) * 32 + wid * 4 + grp : 16 * ((((t_) - 16) * 32 + wid * 4 + grp) >> 2) + (grp & 3))
#define SA_OFF(idx_) ((((size_t)n * 2048 + (idx_)) * 8 + h) * 64 + 4 * sub)
    const f32x4 qo = grp == 0 ? q[0] : grp == 1 ? q[1] : grp == 2 ? q[2] : q[3];
    const float cown = (wid & 3) == 0 ? 2.f : 1.f;
    float mo = -1e30f, lo = 0.f; f32x4 Oo = (f32x4){0.f, 0.f, 0.f, 0.f};
    LAS unsigned char* ring = lds + wid * 16384;
#define SA_DMA(j_) do { const int t_ = (j_) < 12 ? (j_) : (j_) + 4; const size_t o_ = SA_OFF(SA_ROW(t_)); \
        __builtin_amdgcn_global_load_lds((const unsigned*)(CK + o_), (LAS unsigned*)(ring + ((j_) & 7) * 2048), 16, 0, 2); \
        __builtin_amdgcn_global_load_lds((const unsigned*)(CV + o_), (LAS unsigned*)(ring + ((j_) & 7) * 2048 + 1024), 16, 0, 2); } while (0)
#pragma unroll
    for (int j = 0; j < 8; ++j) SA_DMA(j);
#define SA_GEN(NU, kv, vv, idxs) do { float d[NU][4]; int c[NU][4]; \
        _Pragma("unroll") for (int u = 0; u < NU; ++u) { const int idx = idxs[u]; \
            _Pragma("unroll") for (int s = 0; s < 4; ++s) { \
                float dt = (q[s][0] * kv[u][0] + q[s][1] * kv[u][1]) + (q[s][2] * kv[u][2] + q[s][3] * kv[u][3]); \
                dt += dpp_f(dt, 0xB1); dt += dpp_f(dt, 0x4E); dt += dpp_f(dt, 0x141); dt += dpp_f(dt, 0x140); \
                int cc; \
                if (idx < 2048) cc = (idx >= 1920 + s ? 1 : 0) + ((idx >= 1536 && (idx & 3) == s) ? 1 : 0) + ((idx & 15) == s ? 1 : 0); \
                else { const int sp = idx - 2048; cc = (s >= sp ? 1 : 0) + (s == sp ? 2 : 0); } \
                if (idx < 0) cc = 0; \
                d[u][s] = dt; c[u][s] = cc; } } \
        _Pragma("unroll") for (int s = 0; s < 4; ++s) { float mn = m[s]; \
            _Pragma("unroll") for (int u = 0; u < NU; ++u) mn = c[u][s] > 0 ? fmaxf(mn, d[u][s]) : mn; \
            const float sc = __builtin_amdgcn_exp2f(m[s] - mn); l[s] *= sc; O[s] = O[s] * sc; m[s] = mn; \
            _Pragma("unroll") for (int u = 0; u < NU; ++u) { const float pe = (float)c[u][s] * __builtin_amdgcn_exp2f(fminf(d[u][s] - mn, 0.f)); l[s] += pe; O[s] = O[s] + vv[u] * pe; } } } while (0)
    {
        f32x4 kv[4], vv[4]; int idxs[4];
#pragma unroll
        for (int u = 0; u < 4; ++u) { idxs[u] = SA_ROW(12 + u); const size_t o_ = SA_OFF(idxs[u]); kv[u] = *(const f32x4*)(CK + o_); vv[u] = *(const f32x4*)(CV + o_); }
        f32x4 kn[1], vn[1]; int idn[1];
        { const size_t o_ = (size_t)(n * 4 + grp) * 512 + h * 64 + 4 * sub; kn[0] = *(const f32x4*)(a.out + O_SWK + o_); vn[0] = *(const f32x4*)(a.out + O_SWV + o_); idn[0] = wid == 0 ? 2048 + grp : -1; }
        SA_GEN(4, kv, vv, idxs);
        asm volatile("" ::: "memory");
        SA_GEN(1, kn, vn, idn);
    }
#pragma unroll 1
    for (int b = 0; b < 6; ++b) {
        f32x4 kv[4], vv[4];
#pragma unroll
        for (int u = 0; u < 4; ++u) { const int j = 4 * b + u;
            asm volatile("s_waitcnt vmcnt(14)" ::: "memory");
            kv[u] = *(const LAS f32x4*)(ring + (j & 7) * 2048 + lane * 16); vv[u] = *(const LAS f32x4*)(ring + (j & 7) * 2048 + 1024 + lane * 16);
            asm volatile("s_waitcnt lgkmcnt(0)" ::: "memory");
            SA_DMA(j + 8 < 24 ? j + 8 : 23); }
        const float cm = b < 3 ? cown : 1.f;
        float d[4];
#pragma unroll
        for (int u = 0; u < 4; ++u) { float dt = (qo[0] * kv[u][0] + qo[1] * kv[u][1]) + (qo[2] * kv[u][2] + qo[3] * kv[u][3]);
            dt += dpp_f(dt, 0xB1); dt += dpp_f(dt, 0x4E); dt += dpp_f(dt, 0x141); dt += dpp_f(dt, 0x140); d[u] = dt; }
        const float mn = fmaxf(fmaxf(mo, fmaxf(d[0], d[1])), fmaxf(d[2], d[3]));
        const float sc = __builtin_amdgcn_exp2f(mo - mn); lo *= sc; Oo = Oo * sc; mo = mn;
#pragma unroll
        for (int u = 0; u < 4; ++u) { const float pe = cm * __builtin_amdgcn_exp2f(d[u] - mn); lo += pe; Oo = Oo + vv[u] * pe; }
    }
    asm volatile("s_waitcnt vmcnt(0)" ::: "memory");
#undef SA_DMA
#define SA_LD4(x)
#undef SA_LD4
#pragma unroll
    for (int s = 0; s < 4; ++s) if (grp == s) { const float mn = fmaxf(m[s], mo), sa = __builtin_amdgcn_exp2f(m[s] - mn), sb = __builtin_amdgcn_exp2f(mo - mn); l[s] = l[s] * sa + lo * sb; O[s] = O[s] * sa + Oo * sb; m[s] = mn; }
#undef SA_GEN
#undef SA_ROW
#undef SA_OFF
#pragma unroll
    for (int s = 0; s < 4; ++s)
#pragma unroll
        for (int off = 16; off <= 32; off <<= 1) {
            const float mo = __shfl_xor(m[s], off), lo = __shfl_xor(l[s], off);
            f32x4 Oo; Oo[0] = __shfl_xor(O[s][0], off); Oo[1] = __shfl_xor(O[s][1], off); Oo[2] = __shfl_xor(O[s][2], off); Oo[3] = __shfl_xor(O[s][3], off);
            const float mn = fmaxf(m[s], mo); const float sa = (m[s] == mn) ? 1.f : __builtin_amdgcn_exp2f(m[s] - mn), sb = (mo == mn) ? 1.f : __builtin_amdgcn_exp2f(mo - mn);
            l[s] = l[s] * sa + lo * sb; O[s] = O[s] * sa + Oo * sb; m[s] = mn;
        }
    LAS float* red = (LAS float*)(lds + 131072);
    if (grp == 0) {
#pragma unroll
        for (int s = 0; s < 4; ++s) { LAS float* rp = red + (wid * 4 + s) * 68; *(LAS f32x4*)(rp + 4 * sub) = O[s]; if (sub == 0) { rp[64] = m[s]; rp[65] = l[s]; } }
    }
    __syncthreads();
    if (tid < 256) { const int s = tid >> 6, dim = tid & 63; float mm = -1e30f;
#pragma unroll
        for (int w = 0; w < 8; ++w) mm = fmaxf(mm, red[(w * 4 + s) * 68 + 64]);
        float L = 0.f, Ov = 0.f;
#pragma unroll
        for (int w = 0; w < 8; ++w) { const LAS float* rp = red + (w * 4 + s) * 68; const float mw = rp[64]; const float f = __builtin_amdgcn_exp2f(mw - mm); L += rp[65] * f; Ov += rp[dim] * f; }
        MIX[(size_t)(MP + 4 * n + s) * DM + 512 + h * 64 + dim] = (bf16)f2bf(Ov / L); }
    __syncthreads();
}

__device__ __forceinline__ void combine_item(const Args& a, int item, int tid) {
    unsigned char* ws = a.ws;
    const bf16* OP = (const bf16*)(ws + WS_OP); const float* LSE = (const float*)(ws + WS_LSE); bf16* MIX = (bf16*)(ws + WS_MIX);
#pragma unroll 1
    for (int i0 = 0; i0 < 8; i0 += 4) {
        float l[4][3]; v4u xw[4][3];
#pragma unroll
        for (int i = 0; i < 4; ++i) { const int e = tid + NTHR * (i0 + i), row = item * 64 + (e >> 6), hc = e & 63, h = hc >> 3;
#pragma unroll
            for (int p = 0; p < 3; ++p) { l[i][p] = LSE[((size_t)p * MP + row) * 8 + h]; xw[i][p] = *(const v4u*)(OP + ((size_t)p * MP + row) * 512 + hc * 8); } }
#pragma unroll
        for (int i = 0; i < 4; ++i) { const int e = tid + NTHR * (i0 + i), row = item * 64 + (e >> 6), hc = e & 63;
            const float mx = fmaxf(l[i][0], fmaxf(l[i][1], l[i][2])); float w0 = __builtin_amdgcn_exp2f(l[i][0] - mx), w1 = __builtin_amdgcn_exp2f(l[i][1] - mx), w2 = __builtin_amdgcn_exp2f(l[i][2] - mx);
            const float inv = __builtin_amdgcn_rcpf(w0 + w1 + w2); w0 *= inv; w1 *= inv; w2 *= inv;
            float x0[8], x1[8], x2[8], y[8]; unpack8(xw[i][0], x0); unpack8(xw[i][1], x1); unpack8(xw[i][2], x2);
#pragma unroll
            for (int k = 0; k < 8; ++k) y[k] = w0 * x0[k] + w1 * x1[k] + w2 * x2[k];
            *(v4u*)(MIX + (size_t)row * DM + 512 + hc * 8) = pack8(y); }
    }
}

__device__ __forceinline__ void ffn_fixup_phase(const Args& a, int gt, int NGT) {
    unsigned char* ws = a.ws;
    const float* HEADU = (const float*)(ws + WS_HEADU); const float* HEADP = (const float*)(ws + WS_HEADP); const float* TAIL = (const float*)(ws + WS_TAIL); bf16* Hb = (bf16*)(ws + WS_H);
    const float* cw = a.in[I_CFW]; const float* cb = a.in[I_CFB];
    for (int e = gt; e < (MP / 256) * 2 * (DFF / 8); e += NGT) {
        const int pm = e / (2 * (DFF / 8)), rem = e % (2 * (DFF / 8)), j = rem / (DFF / 8), c = (rem % (DFF / 8)) * 8;
        if ((pm & 15) == 0) continue;
        float p2[8], p1[8], cur[8], up[8], w0[8], w1[8], w2[8], bb[8], y[8];
        load8_f32(TAIL + (size_t)((pm - 1) * 2 + j) * DFF + c, p2);
        if (j == 0) load8_f32(TAIL + (size_t)((pm - 1) * 2 + 1) * DFF + c, p1); else load8_f32(HEADU + (size_t)(pm * 2) * DFF + c, p1);
        load8_f32(HEADU + (size_t)(pm * 2 + j) * DFF + c, cur); load8_f32(HEADP + (size_t)(pm * 2 + j) * DFF + c, up);
        load8_f32(cw + c, w0); load8_f32(cw + DFF + c, w1); load8_f32(cw + 2 * DFF + c, w2); load8_f32(cb + c, bb);
#pragma unroll
        for (int i = 0; i < 8; ++i) { const float uc = bb[i] + w0[i] * p2[i] + w1[i] * p1[i] + w2[i] * cur[i]; y[i] = gelu_tanh(uc) * up[i]; }
        *(v4u*)(Hb + (size_t)(pm * 256 + j) * DFF + c) = pack8(y);
    }
}
__device__ __forceinline__ void final_norm_phase(const Args& a, int gw, int NGW, int lane, bool prompt_too) {
    float* Y = a.out + O_Y; const float* PART = (const float*)(a.ws + WS_PART); const GAS f32x4* gf = (const GAS f32x4*)a.in[I_GFIN] + lane;
    f32x4 g[4];
#pragma unroll
    for (int j = 0; j < 4; ++j) g[j] = gf[64 * j];
#pragma unroll 1
    for (int m0 = gw; prompt_too && m0 < MP; m0 += 4 * NGW) {
        f32x4 v[4][4];
#pragma unroll
        for (int q = 0; q < 4; ++q) { const int m = m0 + q * NGW; if (m < MP) { const GAS f32x4* yr = (const GAS f32x4*)(Y + (size_t)m * DM) + lane;
#pragma unroll
                for (int j = 0; j < 4; ++j) v[q][j] = yr[64 * j]; } }
#pragma unroll
        for (int q = 0; q < 4; ++q) { const int m = m0 + q * NGW; if (m < MP) { float ss = 0.f;
#pragma unroll
                for (int j = 0; j < 4; ++j) ss += (v[q][j].x * v[q][j].x + v[q][j].y * v[q][j].y) + (v[q][j].z * v[q][j].z + v[q][j].w * v[q][j].w);
                const float rs = 1.f / sqrtf(wave_sum(ss) * (1.f / DM) + EPS); GAS f32x4* yr = (GAS f32x4*)(Y + (size_t)m * DM) + lane;
#pragma unroll
                for (int j = 0; j < 4; ++j) yr[64 * j] = v[q][j] * rs * g[j]; } }
    }
    for (int r = gw; r < MS; r += NGW) {
        GAS f32x4* yr = (GAS f32x4*)(Y + (size_t)(MP + r) * DM) + lane; f32x4 v[4]; float ss = 0.f;
#pragma unroll
        for (int j = 0; j < 4; ++j) v[j] = yr[64 * j];
#pragma unroll 1
        for (int sl = 0; sl < KSPLIT; sl += 2) {
            const GAS f32x4* p0 = (const GAS f32x4*)(PART + ((size_t)sl * MS + r) * DM) + lane; const GAS f32x4* p1 = (const GAS f32x4*)(PART + ((size_t)(sl + 1) * MS + r) * DM) + lane;
            f32x4 t0[4], t1[4];
#pragma unroll
            for (int j = 0; j < 4; ++j) { t0[j] = p0[64 * j]; t1[j] = p1[64 * j]; }
#pragma unroll
            for (int j = 0; j < 4; ++j) v[j] += t0[j] + t1[j];
        }
#pragma unroll
        for (int j = 0; j < 4; ++j) ss += (v[j].x * v[j].x + v[j].y * v[j].y) + (v[j].z * v[j].z + v[j].w * v[j].w);
        const float rs = 1.f / sqrtf(wave_sum(ss) * (1.f / DM) + EPS);
#pragma unroll
        for (int j = 0; j < 4; ++j) yr[64 * j] = v[j] * rs * g[j];
    }
}

__global__ void __launch_bounds__(NTHR, 2) hymba_fwd(Args args) {
    extern __shared__ __attribute__((aligned(16))) unsigned char lds_raw[];
    LAS unsigned char* lds = (LAS unsigned char*)lds_raw;
    volatile LAS unsigned* MISC = (volatile LAS unsigned*)(lds + MISC_OFF);
    const int tid = threadIdx.x, lane = tid & 63, wave = __builtin_amdgcn_readfirstlane(tid >> 6);
    const int G = gridDim.x, bx = blockIdx.x; const int vcu = (G % 8 == 0) ? (bx % 8) * (G / 8) + bx / 8 : bx;
    unsigned char* ws = args.ws;
    unsigned* ctl = (unsigned*)(ws + WS_CTL);
    for (int u = tid; u < (LDS_BYTES - LDSCTL_OFF) / 4; u += NTHR) ((LAS unsigned*)(lds + LDSCTL_OFF))[u] = 0u;
    __syncthreads();
    XcdBarrier bar; bar.bar = ctl + CW_BAR + args.li * XCD_BAR_WORDS; bar.x = 0; bar.st = nullptr;
    if (N_LAUNCH == 1) bar = xcd_barrier_post(ctl + CW_BAR + args.li * XCD_BAR_WORDS, MISC + 8);
    const int lo = args.ph_lo, hi = args.ph_hi;
#ifndef REP_MASK
#define REP_MASK 0
#endif
#define REPS(k) for (int rep_ = 0; rep_ < 1 + ((REP_MASK >> (k)) & 1); ++rep_)
#ifndef STAG1
#define STAG1 0
#endif
#ifndef STAG4
#define STAG4 0
#endif
#ifndef STAG7
#define STAG7 0
#endif
#ifndef STAG_G
#define STAG_G 3
#endif
#define STAGGER(ticks) do { if ((ticks) > 0) { const int g_ = (bx / 8) % STAG_G; if (g_) { const unsigned long long t0_ = rt(); while (rt() - t0_ < (unsigned long long)(g_ * (ticks))) __builtin_amdgcn_s_sleep(8); } } } while (0)
#ifndef IT_MASK
#define IT_MASK 63
#endif
#ifndef PH_MASK
#define PH_MASK 0x1ff
#endif
#define IN(k) (((PH_MASK >> (k)) & 1) && lo <= (k) && (k) < hi)
#define SEAM(k) do { if (N_LAUNCH == 1 && IN(k) && IN((k) + 1)) xcd_barrier(bar); } while (0)

    constexpr int NP1S = 2 * (DIN / 256);
    if (IN(0)) REPS(0) {
        const int ns = (G >= 4 * NP1S && N_LAUNCH == 1) ? NP1S : 0;
        p0_prologue(args, lds, tid, wave, lane, vcu, G, 0);
        if (ns) {
            __builtin_amdgcn_fence(__ATOMIC_RELEASE, "agent"); __syncthreads();
            if (tid == 0) __hip_atomic_fetch_add(ctl + CW_P0A, 1u, __ATOMIC_RELAXED, __HIP_MEMORY_SCOPE_AGENT);
            if (bx < ns) {
                if (tid < 64) { unsigned spins = 0;
                    while ((unsigned)__builtin_amdgcn_readfirstlane(__hip_atomic_load(ctl + CW_P0A, __ATOMIC_RELAXED, __HIP_MEMORY_SCOPE_AGENT)) < (unsigned)G) { if (++spins > (1u << 22)) break; __builtin_amdgcn_s_sleep(2); } }
                __syncthreads(); __builtin_amdgcn_fence(__ATOMIC_ACQUIRE, "agent");
            }
        } else if (N_LAUNCH == 1) xcd_barrier(bar);
        if (bx >= ns) p0_prologue(args, lds, tid, wave, lane, bx - ns, G - ns, 1);
        if (ns == 0 || bx < ns) {
            if (ns == 0) __syncthreads();
            pg8::Gemm g{(const bf16*)(ws + WS_XN), (const bf16*)(ws + WS_WIN), M, DIN, DM, DM}; SampleUnitOrder S{bx, ns ? ns : G};
            EpiZ E{(const float*)(ws + WS_RS1), (const float*)(ws + WS_ROPE), (bf16*)(ws + WS_XA), (bf16*)(ws + WS_GA), (bf16*)(ws + WS_Q), (bf16*)(ws + WS_K), (bf16*)(ws + WS_V), (float*)(ws + WS_QS), args.out, (LAS float*)(lds + MISC_OFF + 256)};
            pg8::gemm_phase<EpiZ, SampleUnitOrder, true, true>(lds, g, S, E);
        }
        SEAM(0);
    }

    if (IN(1)) REPS(1) {
        STAGGER(STAG1);
        pg8::Gemm g{(const bf16*)(ws + WS_XN), (const bf16*)(ws + WS_WIN), MP, DIN, DM, DM}; pg8::StaticOrder S; S.init(MP, DIN, G, bx);
        EpiZ E{(const float*)(ws + WS_RS1), (const float*)(ws + WS_ROPE), (bf16*)(ws + WS_XA), (bf16*)(ws + WS_GA), (bf16*)(ws + WS_Q), (bf16*)(ws + WS_K), (bf16*)(ws + WS_V), (float*)(ws + WS_QS), args.out, (LAS float*)(lds + MISC_OFF + 256)};
        pg8::gemm_phase<EpiZ, pg8::StaticOrder, true, true>(lds, g, S, E);
        SEAM(1);
    }
    if (IN(2)) REPS(2) {
        constexpr int NA = NB * NH * 48, NSA = NS * NH, NL = NB * 64;
        if (args.pad & 4) for (int it = bx; it < NL; it += G) lru_fused_item(args, it, lds, wave, lane);
        if (bx & 1) { if (args.pad & 2) for (int it = bx; it < NSA; it += G) attn_sample_item(args, it, lds, tid, wave, lane); }
        if (args.pad & 1) attn_prompt_phase(args, lds, bx, G, NA, tid, wave, lane);
        if (!(bx & 1)) { if (args.pad & 2) for (int it = bx; it < NSA; it += G) attn_sample_item(args, it, lds, tid, wave, lane); }
        SEAM(2);
    }
    if (IN(3)) REPS(3) {
        constexpr int NLS = MS / 64, NC = MP / 64;
        if (bx < NLS && G > NLS) lru_item<2>(args, bx, lds, wave, lane);
        else if (G > NLS) { for (int it = bx - NLS; it < NC; it += G - NLS) combine_item(args, it, tid); }
        else for (int it = bx; it < NLS + NC; it += G) { if (it < NLS) lru_item<2>(args, it, lds, wave, lane); else combine_item(args, it - NLS, tid); }
        SEAM(3);
    }
    if (IN(4)) REPS(4) {
        STAGGER(STAG4);
        { pg8::Gemm g{(const bf16*)(ws + WS_MIX), (const bf16*)(ws + WS_WOUT), MP, DM, DM, DM}; pg8::StaticOrder S; S.init(MP, DM, G, bx);
          EpiX1 E{args.in[I_XP], args.in[I_XS], args.out + O_Y, (bf16*)(ws + WS_X1B), (float*)(ws + WS_SSP)};
          pg8::gemm_phase<EpiX1, pg8::StaticOrder, true, true>(lds, g, S, E); }
        { pg8::Gemm g{(const bf16*)(ws + WS_MIX), (const bf16*)(ws + WS_WOUT), M, DM, DM / KSPLIT4, DM}; SplitOrder S{G, bx, KSPLIT4, DM / KSPLIT4};
          EpiPart E{(float*)(ws + WS_PART4), DM / KSPLIT4};
          pg8::gemm_phase<EpiPart, SplitOrder, true, true>(lds, g, S, E); }
        SEAM(4);
    }
    if (IN(5)) REPS(5) {
        finalize_x1_sample(args, bx, G, wave, lane);
        pg8::Gemm g{(const bf16*)(ws + WS_X1B), (const bf16*)(ws + WS_WGU), M, 2 * DFF, DM, DM}; GatedOrder S; S.init(M, 2 * DFF, G, bx); S.cnt = (const unsigned*)(ws + WS_CTL) + CW_CNT4; S.need = MS;
        EpiGU E{(const float*)(ws + WS_SSP), (bf16*)(ws + WS_H), args.in[I_CFW], args.in[I_CFB], args.in[I_SCF], args.out, (float*)(ws + WS_HEADU), (float*)(ws + WS_HEADP), (float*)(ws + WS_TAIL), (LAS float*)(lds + MISC_OFF + 256), (LAS float*)(lds + RING_BYTES)};
        pg8::gemm_phase<EpiGU, GatedOrder, true, true>(lds, g, S, E);
        SEAM(5);
    }
    if (IN(6)) REPS(6) {
        if (G == 256) {
            if (bx < 8 * KSPLIT) { pg8::Gemm g{(const bf16*)(ws + WS_H), (const bf16*)(ws + WS_WDN), M, DM, DFF / KSPLIT, DFF}; SplitOrder S{G, bx, KSPLIT, DFF / KSPLIT};
                EpiPart E{(float*)(ws + WS_PART), DFF / KSPLIT};
                pg8::gemm_phase<EpiPart, SplitOrder, true, true>(lds, g, S, E); }
            else ffn_fixup_phase(args, (bx - 8 * KSPLIT) * NTHR + tid, (G - 8 * KSPLIT) * NTHR);
        } else ffn_fixup_phase(args, vcu * NTHR + tid, G * NTHR);
        SEAM(6);
    }
    if (IN(7)) {
        STAGGER(STAG7);
        if (G == 256) {
            final_norm_phase(args, vcu * NWAVES + wave, G * NWAVES, lane, false);
            pg8::Gemm g{(const bf16*)(ws + WS_H), (const bf16*)(ws + WS_WDN), MP, DM, DFF, DFF};
            EpiX2F E{args.out + O_Y, (const bf16*)(ws + WS_X1B), args.in[I_GFIN], (float*)(ws + WS_XBUF), (unsigned*)(ws + WS_CTL) + CW_X2C};
            { OneUnitOrder S; S.init(MP, DM, G, bx); S.i0 = 0; pg8::gemm_phase<EpiX2F, OneUnitOrder, false, true>(lds, g, S, E); }
            __syncthreads();
            { OneUnitOrder S; S.init(MP, DM, G, bx); S.i0 = 1; pg8::gemm_phase<EpiX2F, OneUnitOrder, false, true>(lds, g, S, E); }
            __syncthreads();
        } else {
            pg8::Gemm g{(const bf16*)(ws + WS_H), (const bf16*)(ws + WS_WDN), MP, DM, DFF, DFF}; pg8::StaticOrder S; S.init(MP, DM, G, bx);
            EpiX2 E{args.out + O_Y, (const bf16*)(ws + WS_X1B)};
            pg8::gemm_phase<EpiX2, pg8::StaticOrder, true, true>(lds, g, S, E);
        }
        if (G != 256) { pg8::Gemm g{(const bf16*)(ws + WS_H), (const bf16*)(ws + WS_WDN), M, DM, DFF / KSPLIT, DFF}; SplitOrder S{G, bx, KSPLIT, DFF / KSPLIT};
          EpiPart E{(float*)(ws + WS_PART), DFF / KSPLIT};
          pg8::gemm_phase<EpiPart, SplitOrder, true, true>(lds, g, S, E); }
        if (G != 256) SEAM(7);
    }
    if (IN(8) && G != 256) final_norm_phase(args, vcu * NWAVES + wave, G * NWAVES, lane, true);
#undef IN
#undef SEAM
}

extern "C" void kernel_launch(void* const* d_in, const int* in_sizes, int n_in, void* d_out, int out_size, void* d_ws, size_t ws_size, hipStream_t stream) {
    static int grid = 0;
    if (grid == 0) {
        if (n_in != 24 || out_size != (int)O_END || ws_size < WS_END) { fprintf(stderr, "kernel_launch: unexpected shapes (n_in %d, out %d, ws %zu)\n", n_in, out_size, ws_size); grid = -1; return; }
        int dev = 0, cus = 0, per_cu = 0;
        if (hipGetDevice(&dev) != hipSuccess || hipDeviceGetAttribute(&cus, hipDeviceAttributeMultiprocessorCount, dev) != hipSuccess) { grid = -1; return; }
        if (hipFuncSetAttribute((const void*)hymba_fwd, hipFuncAttributeMaxDynamicSharedMemorySize, LDS_BYTES) != hipSuccess) { fprintf(stderr, "kernel_launch: hipFuncSetAttribute failed\n"); grid = -1; return; }
        if (hipOccupancyMaxActiveBlocksPerMultiprocessor(&per_cu, (const void*)hymba_fwd, NTHR, LDS_BYTES) != hipSuccess || per_cu < 1) fprintf(stderr, "kernel_launch: occupancy query reports %d blocks per CU\n", per_cu);
        (void)hipGetLastError();
        grid = cus;
    }
    if (grid < 0) return;
    if (hipMemsetAsync((char*)d_ws + WS_CTL, 0, CTL_ZERO_BYTES, stream) != hipSuccess) return;
    Args a{};
    for (int i = 0; i < 24; ++i) a.in[i] = (const float*)d_in[i];
    a.out = (float*)d_out; a.ws = (unsigned char*)d_ws; a.pad = 7;
#if defined(PROBE_PH)
    a.ph_lo = 0; a.ph_hi = PROBE_PH + 1; a.li = 0; hipLaunchKernelGGL(hymba_fwd, dim3(grid), dim3(NTHR), LDS_BYTES, stream, a);
    a.ph_lo = PROBE_PH; a.ph_hi = NPH; a.li = 1;
#if defined(PROBE_ITEMS)
    a.pad = PROBE_ITEMS; a.ph_hi = PROBE_PH + 1; hipLaunchKernelGGL(hymba_fwd, dim3(grid), dim3(NTHR), LDS_BYTES, stream, a); a.pad = 7; a.ph_lo = PROBE_PH + 1; a.ph_hi = NPH; a.li = 2;
#endif
    hipLaunchKernelGGL(hymba_fwd, dim3(grid), dim3(NTHR), LDS_BYTES, stream, a);
    return;
#endif
    if (N_LAUNCH == 1) { a.ph_lo = 0; a.ph_hi = NPH; hipLaunchKernelGGL(hymba_fwd, dim3(grid), dim3(NTHR), LDS_BYTES, stream, a); }
    else for (int k = 0; k < NPH; ++k) { a.ph_lo = k; a.ph_hi = k + 1; hipLaunchKernelGGL(hymba_fwd, dim3(grid), dim3(NTHR), LDS_BYTES, stream, a); }
}
```

```cpp
#include <hip/hip_runtime.h>
#include <cstdio>
#include <cstdint>
#include <cmath>
namespace pg8 {
#define PG8_LAS __attribute__((address_space(3)))
typedef unsigned short bf16_t;
typedef short bf16x8 __attribute__((ext_vector_type(8)));
typedef float f32x4 __attribute__((ext_vector_type(4)));
typedef unsigned u32x4 __attribute__((ext_vector_type(4)));
constexpr int BM = 256, BK = 64, HALF = 128, HTB = HALF * BK * 2  , STAGE_BYTES = 8 * HTB, NXCD = 8, WGM = 8;

__host__ __device__ __forceinline__ int lds_byte(int r, int c) { const int st = (r >> 4) * 2 + (c >> 5), rr = r & 15, cc = c & 31, ob = rr * 64 + cc * 2; return st * 1024 + (ob ^ (((ob >> 9) & 1) << 5)); }
__host__ __device__ __forceinline__ void stage_rc(int b, int& R, int& C) { const int st = b / 1024, sb = b % 1024, swz = sb ^ (((sb >> 9) & 1) << 5); R = (st >> 1) * 16 + swz / 64; C = (st & 1) * 32 + (swz % 64) / 2; }
__host__ __device__ __forceinline__ int perm32(int rho) { const int n = rho >> 4, i = rho & 15; return 8 * (i >> 2) + 4 * n + (i & 3); }

struct Unit { int pm, pn, ko; };
struct Gemm { const bf16_t* A; const bf16_t* Bt; int M, N, K, ld; };

struct StaticOrder {
    int nM, nN, nwg, G, c;
    __host__ __device__ void init(int M, int N, int G_, int c_) { nM = M / BM; nN = N / BM; nwg = nM * nN; G = G_; c = c_; }
    __host__ __device__ bool next(int i, Unit& u) const {
        const long L = (long)i * G + c; if (L >= nwg) return false;
        int wgid = (int)L; { const int q = nwg / NXCD, r = nwg % NXCD, xcd = wgid % NXCD, off = wgid / NXCD; wgid = (xcd < r ? xcd * (q + 1) : r * (q + 1) + (xcd - r) * q) + off; }
        const int nig = WGM * nN, gid = wgid / nig, fm = gid * WGM, gsz = (nM - fm) < WGM ? (nM - fm) : WGM;
        u.pm = fm + ((wgid % nig) % gsz); u.pn = (wgid % nig) / gsz; u.ko = 0; return true;
    }
    __device__ __forceinline__ void a_ready(const Unit&) const {}
    __device__ __forceinline__ void done(const Unit&) const {}
};

__device__ __forceinline__ unsigned cvt_pk_bf16(float lo, float hi) { unsigned r; asm volatile("v_cvt_pk_bf16_f32 %0, %1, %2" : "=v"(r) : "v"(lo), "v"(hi)); return r; }
template <class Epi, class Sched, bool ALIGN_EPI = false, bool SP2 = false>
__device__ __forceinline__ void gemm_phase(PG8_LAS unsigned char* lds, const Gemm g, const Sched& S, const Epi& E) {
    const int tid = threadIdx.x, wid = __builtin_amdgcn_readfirstlane(tid >> 6), lane = tid & 63, wr = wid >> 2, wc = wid & 3, fr = lane & 15, fq = lane >> 4;
    const int K = g.K, nt = K / BK;
    unsigned voffA[2], voffB[2];
#pragma unroll
    for (int i = 0; i < 2; ++i) { int R, C; stage_rc(tid * 16 + i * 8192, R, C); const int Rb = Epi::PERM ? ((R & ~31) + perm32(R & 31)) : R;
        voffA[i] = (unsigned)(R * g.ld + C) * 2u; voffB[i] = (unsigned)(Rb * g.ld + C) * 2u; }
    const size_t kstep = (size_t)(BK * 2);
    const size_t hstep = (size_t)HALF * g.ld * 2;
    const size_t tstep = 2 * hstep;
    const unsigned ldsw = (unsigned)wid * 1024u;
    const int aoff = lds_byte(wr * 64 + fr, fq * 8), boff = lds_byte(wc * 32 + fr, fq * 8);
#define PG8_SA(b, h) (((b) * 2 + (h)) * HTB)
#define PG8_SB(b, h) ((4 + (b) * 2 + (h)) * HTB)
#define PG8_STAGE(bufoff, gbase, voff) do { _Pragma("unroll") for (int _i = 0; _i < 2; ++_i) \
        __builtin_amdgcn_global_load_lds((const unsigned*)((const char*)(gbase) + (voff)[_i]), (PG8_LAS unsigned*)(lds + (bufoff) + ldsw + _i * 8192), 16, 0, 0); } while (0)
#define PG8_LDA(dst, b, h) do { _Pragma("unroll") for (int m = 0; m < 4; ++m) _Pragma("unroll") for (int k = 0; k < 2; ++k) dst[m][k] = *(const PG8_LAS bf16x8*)(lds + PG8_SA(b, h) + aoff + m * 2048 + k * 1024); } while (0)
#define PG8_LDB(dst, b, h) do { _Pragma("unroll") for (int n = 0; n < 2; ++n) _Pragma("unroll") for (int k = 0; k < 2; ++k) dst[n][k] = *(const PG8_LAS bf16x8*)(lds + PG8_SB(b, h) + boff + n * 2048 + k * 1024); } while (0)
#define PG8_MMA(ai, bj, At, Bt) do { __builtin_amdgcn_s_setprio(1); _Pragma("unroll") for (int m = 0; m < 4; ++m) _Pragma("unroll") for (int n = 0; n < 2; ++n) _Pragma("unroll") for (int k = 0; k < 2; ++k) \
        acc[ai][bj][m][n] = __builtin_amdgcn_mfma_f32_16x16x32_bf16(Bt[n][k], At[m][k], acc[ai][bj][m][n], 0, 0, 0); __builtin_amdgcn_s_setprio(0); } while (0)
#define PG8_WAIT_V(n) asm volatile("s_waitcnt vmcnt(" #n ")" ::: "memory")
#define PG8_WAIT_L(n) asm volatile("s_waitcnt lgkmcnt(" #n ")" ::: "memory")
#define PG8_BAR __builtin_amdgcn_s_barrier()
#define PG8_SCHED __builtin_amdgcn_sched_barrier(0)
    Unit cur, nxt; int ui = 0;
    if (!S.next(0, cur)) return;
    f32x4 acc[2][2][4][2];
#pragma unroll
    for (int a = 0; a < 2; ++a)
#pragma unroll
        for (int b = 0; b < 2; ++b)
#pragma unroll
            for (int m = 0; m < 4; ++m)
#pragma unroll
                for (int n = 0; n < 2; ++n) acc[a][b][m][n] = (f32x4){0.f, 0.f, 0.f, 0.f};
    bf16x8 At[4][2], B0[2][2], B1[2][2];
    const char* cA = (const char*)g.A + (size_t)cur.pm * tstep + (size_t)cur.ko * 2; const char* cB = (const char*)g.Bt + (size_t)cur.pn * tstep + (size_t)cur.ko * 2;
    S.a_ready(cur); E.pre(cur, 0, tid);
    if constexpr (SP2) {
        PG8_STAGE(PG8_SB(0, 0), cB, voffB); PG8_STAGE(PG8_SB(0, 1), cB + hstep, voffB); PG8_STAGE(PG8_SA(0, 0), cA, voffA); PG8_STAGE(PG8_SA(0, 1), cA + hstep, voffA);
        if (wr == 1) PG8_BAR;
        PG8_WAIT_V(2); PG8_BAR;
        PG8_STAGE(PG8_SB(1, 0), cB + kstep, voffB); PG8_STAGE(PG8_SA(1, 0), cA + kstep, voffA); PG8_STAGE(PG8_SB(1, 1), cB + hstep + kstep, voffB);
        PG8_WAIT_V(6); PG8_BAR;
    } else {
        PG8_STAGE(PG8_SB(0, 0), cB, voffB); PG8_STAGE(PG8_SA(0, 0), cA, voffA); PG8_STAGE(PG8_SB(0, 1), cB + hstep, voffB); PG8_STAGE(PG8_SA(0, 1), cA + hstep, voffA);
        if (wr == 1) PG8_BAR;
        PG8_WAIT_V(4); PG8_BAR;
        PG8_STAGE(PG8_SB(1, 0), cB + kstep, voffB); PG8_STAGE(PG8_SA(1, 0), cA + kstep, voffA); PG8_STAGE(PG8_SB(1, 1), cB + hstep + kstep, voffB);
        PG8_WAIT_V(6); PG8_BAR;
    }
    for (;;) {
        const bool has_next = S.next(ui + 1, nxt);
        const char* nA = has_next ? (const char*)g.A + (size_t)nxt.pm * tstep + (size_t)nxt.ko * 2 : cA; const char* nB = has_next ? (const char*)g.Bt + (size_t)nxt.pn * tstep + (size_t)nxt.ko * 2 : cB;
        for (int t = 0; t < nt; t += 2) {
            const bool last = (t == nt - 2);
            const char* a1 = cA + (size_t)(t + 1) * kstep;
            const char* a2 = last ? nA : cA + (size_t)(t + 2) * kstep; const char* b2 = last ? nB : cB + (size_t)(t + 2) * kstep;
            const char* a3 = a2 + kstep; const char* b3 = b2 + kstep;
            if (last && has_next) { S.a_ready(nxt); E.pre(nxt, (ui + 1) & 1, tid); }
            if constexpr (SP2) {
            PG8_LDB(B0, 0, 0); PG8_LDB(B1, 0, 1); PG8_SCHED; PG8_LDA(At, 0, 0); PG8_STAGE(PG8_SA(1, 1), a1 + hstep, voffA);
            PG8_WAIT_V(8); PG8_WAIT_L(0); PG8_BAR; PG8_MMA(0, 0, At, B0); PG8_MMA(0, 1, At, B1); PG8_BAR; PG8_SCHED;
            PG8_LDA(At, 0, 1); PG8_STAGE(PG8_SB(0, 0), b2, voffB); PG8_STAGE(PG8_SB(0, 1), b2 + hstep, voffB); PG8_STAGE(PG8_SA(0, 0), a2, voffA);
            PG8_WAIT_V(8); PG8_WAIT_L(0); PG8_BAR; PG8_MMA(1, 0, At, B0); PG8_MMA(1, 1, At, B1); PG8_BAR; PG8_SCHED;
            PG8_LDB(B0, 1, 0); PG8_LDB(B1, 1, 1); PG8_SCHED; PG8_LDA(At, 1, 0); PG8_STAGE(PG8_SA(0, 1), a2 + hstep, voffA);
            PG8_WAIT_V(8); PG8_WAIT_L(0); PG8_BAR; PG8_MMA(0, 0, At, B0); PG8_MMA(0, 1, At, B1); PG8_BAR; PG8_SCHED;
            PG8_LDA(At, 1, 1); PG8_STAGE(PG8_SB(1, 0), b3, voffB); PG8_STAGE(PG8_SB(1, 1), b3 + hstep, voffB); PG8_STAGE(PG8_SA(1, 0), a3, voffA);
            PG8_WAIT_V(8); PG8_WAIT_L(0); PG8_BAR; PG8_MMA(1, 0, At, B0); PG8_MMA(1, 1, At, B1); PG8_BAR; PG8_SCHED;
            } else {
            PG8_LDB(B0, 0, 0); PG8_SCHED; PG8_LDA(At, 0, 0); PG8_STAGE(PG8_SA(1, 1), a1 + hstep, voffA);
            PG8_WAIT_L(8); PG8_BAR; PG8_WAIT_L(0); PG8_MMA(0, 0, At, B0); PG8_BAR; PG8_SCHED;
            PG8_LDB(B1, 0, 1); PG8_STAGE(PG8_SB(0, 0), b2, voffB);
            PG8_BAR; PG8_WAIT_L(0); PG8_MMA(0, 1, At, B1); PG8_BAR;
            PG8_LDA(At, 0, 1); PG8_STAGE(PG8_SA(0, 0), a2, voffA);
            PG8_BAR; PG8_WAIT_L(0); PG8_MMA(1, 0, At, B0); PG8_BAR; PG8_SCHED;
            PG8_STAGE(PG8_SB(0, 1), b2 + hstep, voffB);
            PG8_WAIT_V(6); PG8_BAR; PG8_MMA(1, 1, At, B1); PG8_BAR;
            PG8_LDB(B0, 1, 0); PG8_SCHED; PG8_LDA(At, 1, 0); PG8_STAGE(PG8_SA(0, 1), a2 + hstep, voffA);
            PG8_WAIT_L(8); PG8_BAR; PG8_WAIT_L(0); PG8_MMA(0, 0, At, B0); PG8_BAR; PG8_SCHED;
            PG8_LDB(B1, 1, 1); PG8_STAGE(PG8_SB(1, 0), b3, voffB);
            PG8_BAR; PG8_WAIT_L(0); PG8_MMA(0, 1, At, B1); PG8_BAR;
            PG8_LDA(At, 1, 1); PG8_STAGE(PG8_SA(1, 0), a3, voffA);
            PG8_BAR; PG8_WAIT_L(0); PG8_MMA(1, 0, At, B0); PG8_BAR; PG8_SCHED;
            PG8_STAGE(PG8_SB(1, 1), b3 + hstep, voffB);
            PG8_WAIT_V(6); PG8_BAR; PG8_MMA(1, 1, At, B1); PG8_BAR;
            }
        }
        if constexpr (ALIGN_EPI) { if (wr == 0) PG8_BAR; }
        if constexpr (!Epi::AFTER_DRAIN) { E(acc, cur, wr, wc, fr, fq, ui & 1); S.done(cur); }
        if (!has_next) break;
#pragma unroll
        for (int a = 0; a < 2; ++a)
#pragma unroll
            for (int b = 0; b < 2; ++b)
#pragma unroll
                for (int m = 0; m < 4; ++m)
#pragma unroll
                    for (int n = 0; n < 2; ++n) acc[a][b][m][n] = (f32x4){0.f, 0.f, 0.f, 0.f};
        cur = nxt; cA = nA; cB = nB; ++ui;
        if constexpr (ALIGN_EPI) { if (wr == 1) PG8_BAR; }
    }
    PG8_WAIT_V(0);
    if constexpr (!ALIGN_EPI) { if (wr == 0) PG8_BAR; }
    PG8_BAR;
    if constexpr (Epi::AFTER_DRAIN) { E.fused(acc, cur, wr, wc, fr, fq, lds, wid, lane); S.done(cur); }
#undef PG8_SA
#undef PG8_SB
#undef PG8_STAGE
#undef PG8_LDA
#undef PG8_LDB
#undef PG8_MMA
#undef PG8_WAIT_V
#undef PG8_WAIT_L
#undef PG8_BAR
#undef PG8_SCHED
}
}
#define GAS __attribute__((address_space(1)))
#define LAS __attribute__((address_space(3)))
typedef unsigned short bf16;
typedef unsigned v4u __attribute__((ext_vector_type(4)));
typedef float f32x4 __attribute__((ext_vector_type(4)));
typedef float f32x2 __attribute__((ext_vector_type(2)));
typedef short bf16x8 __attribute__((ext_vector_type(8)));
typedef GAS unsigned gu32;
typedef GAS unsigned long long gu64;
#define RLX_AGENT __ATOMIC_RELAXED, __HIP_MEMORY_SCOPE_AGENT
#define LDS_WAIT() asm volatile("s_waitcnt lgkmcnt(0)" ::: "memory")
#define VM_WAIT() asm volatile("s_waitcnt vmcnt(0)" ::: "memory")
__device__ __forceinline__ unsigned long long rt() { return __builtin_amdgcn_s_memrealtime(); }
__device__ __forceinline__ unsigned f2bf(float f) { unsigned u = __builtin_bit_cast(unsigned, f); return (u + 0x7fffu + ((u >> 16) & 1u)) >> 16; }
__device__ __forceinline__ unsigned pk2(float lo, float hi) { unsigned r; asm("v_cvt_pk_bf16_f32 %0, %1, %2" : "=v"(r) : "v"(lo), "v"(hi)); return r; }

#define XB_TMO      128
#define XB_XCNT(j)  (256  + 64 * (j))
#define XB_XSUB(j)  (1280 + 64 * (j))
#define XB_XGEN(j)  (2304 + 64 * (j))
#define XB_TOP      3328
#define XB_TOPGEN   3392
#define XCD_BAR_WORDS 3456
#define XB_SPIN_CAP (1u << 18)

__device__ __forceinline__ unsigned xb_ld(unsigned* p)              { return __hip_atomic_load(p, __ATOMIC_RELAXED, __HIP_MEMORY_SCOPE_AGENT); }
__device__ __forceinline__ unsigned xb_add(unsigned* p, unsigned v) { return __hip_atomic_fetch_add(p, v, __ATOMIC_RELAXED, __HIP_MEMORY_SCOPE_AGENT); }
__device__ __forceinline__ unsigned xb_xcc_id() { return (unsigned)__builtin_amdgcn_s_getreg((3 << 11) | 20) & 0xFu; }
#define XB_SPIN(cond, bar) do { unsigned _sp = 0; while (cond) { __builtin_amdgcn_s_sleep(1); \
    if ((++_sp & 255u) == 0u) { if (xb_ld(&(bar)[XB_TMO])) break; if (_sp > XB_SPIN_CAP) { atomicAdd(&(bar)[XB_TMO], 1u); break; } } } } while (0)

struct XcdBarrier {
    unsigned* bar; unsigned x;
    volatile LAS unsigned* st;
};

__device__ __forceinline__ XcdBarrier xcd_barrier_post(unsigned* bar, volatile LAS unsigned* st) {
    XcdBarrier b; b.bar = bar; b.x = xb_xcc_id(); b.st = st;
    if (threadIdx.x == 0) (void)xb_add(&bar[XB_XCNT(b.x)], 1u);
    return b;
}
__device__ __forceinline__ void xcd_barrier_complete(unsigned* bar, unsigned x, unsigned& nloc, unsigned& nx) {
    const unsigned G = gridDim.x * gridDim.y * gridDim.z;
    unsigned sum, cnt, mine, sp = 0u;
    for (;;) {
        sum = 0u; cnt = 0u; mine = 0u;
#pragma unroll
        for (unsigned j = 0; j < 16; ++j) { const unsigned c = xb_ld(&bar[XB_XCNT(j)]); sum += c; cnt += (c > 0u) ? 1u : 0u; mine = (j == x) ? c : mine; }
        if (sum == G) break;
        __builtin_amdgcn_s_sleep(1);
        if ((++sp & 255u) == 0u) { if (xb_ld(&bar[XB_TMO])) break; if (sp > XB_SPIN_CAP) { atomicAdd(&bar[XB_TMO], 1u); break; } }
    }
    nloc = mine > 0u ? mine : 1u; nx = cnt > 0u ? cnt : 1u;
}

__device__ __forceinline__ void xcd_barrier(const XcdBarrier& b) {
    asm volatile("s_waitcnt vmcnt(0)" ::: "memory");
    __syncthreads();
    if (threadIdx.x == 0) {
        unsigned* bar = b.bar;
        __builtin_amdgcn_s_waitcnt(0);
        unsigned nloc = b.st[0], nx = b.st[1];
        if (nloc == 0u) { xcd_barrier_complete(bar, b.x, nloc, nx); b.st[0] = nloc; b.st[1] = nx; }
        const unsigned old = xb_add(&bar[XB_XSUB(b.x)], 1u);
        const unsigned gen = old / nloc;
        if (old + 1u == (gen + 1u) * nloc) {
            __builtin_amdgcn_fence(__ATOMIC_RELEASE, "agent");
            asm volatile("s_waitcnt vmcnt(0)" ::: "memory");
            const unsigned og = xb_add(&bar[XB_TOP], 1u);
            const unsigned tg = og / nx;
            if (og + 1u == (tg + 1u) * nx) xb_add(&bar[XB_TOPGEN], 1u);
            else XB_SPIN(xb_ld(&bar[XB_TOPGEN]) == tg, bar);
            __builtin_amdgcn_fence(__ATOMIC_ACQUIRE, "agent");
            xb_add(&bar[XB_XGEN(b.x)], 1u);
            asm volatile("s_waitcnt vmcnt(0)" ::: "memory");
        } else {
            XB_SPIN(xb_ld(&bar[XB_XGEN(b.x)]) == gen, bar);
            __builtin_amdgcn_fence(__ATOMIC_ACQUIRE, "agent");
            asm volatile("s_waitcnt vmcnt(0)" ::: "memory");
        }
    }
    __syncthreads();
}
constexpr int DM = 1024, NB = 8, SEQ = 4096, NS = 128, SSQ = 4;
constexpr int DL = 512, NH = 8, HD = 64, DIN = 2560, DFF = 3072;
constexpr int MP = NB * SEQ, MS = NS * SSQ, M = MP + MS;
constexpr float EPS = 1e-6f;
constexpr float C2 = 0.125f * 1.4426950408889634f;
constexpr int NWAVES = 8, NTHR = 512;
#ifndef N_LAUNCH
#define N_LAUNCH 1
#endif
constexpr int NPH = 9;

constexpr size_t O_Y = 0;
constexpr size_t O_PCA = (size_t)M * DM;
constexpr size_t O_PLH = O_PCA + (size_t)NB * 3 * DL;
constexpr size_t O_PWK = O_PLH + (size_t)NB * DL;
constexpr size_t O_PWV = O_PWK + (size_t)NB * 2048 * 512;
constexpr size_t O_PCF = O_PWV + (size_t)NB * 2048 * 512;
constexpr size_t O_SCA = O_PCF + (size_t)NB * 2 * DFF;
constexpr size_t O_SLH = O_SCA + (size_t)NS * 3 * DL;
constexpr size_t O_SWK = O_SLH + (size_t)NS * DL;
constexpr size_t O_SWV = O_SWK + (size_t)NS * 4 * 512;
constexpr size_t O_SCF = O_SWV + (size_t)NS * 4 * 512;
constexpr size_t O_END = O_SCF + (size_t)NS * 2 * DFF;
static_assert(O_END == 52494336, "output size");

constexpr size_t MiB = 1u << 20;
constexpr size_t WS_CTL = 0, CTL_ZERO_BYTES = 1 * MiB;
constexpr size_t WS_WIN = 2 * MiB, WS_WOUT = 7 * MiB, WS_WGU = 9 * MiB, WS_WDN = 21 * MiB, WS_WL = 27 * MiB;
constexpr size_t WS_C8 = 28 * MiB, WS_ROPE = 28 * MiB + 65536, WS_RS1 = 29 * MiB, WS_SSP = 30 * MiB, WS_SSP2 = 33 * MiB;
constexpr size_t WS_AGGA = 36 * MiB, WS_AGGB = 37 * MiB, WS_QS = 38 * MiB, WS_LSE = 40 * MiB;
constexpr size_t WS_XN = 48 * MiB, WS_XA = 116 * MiB, WS_GA = 150 * MiB, WS_Q = 184 * MiB, WS_K = 218 * MiB, WS_V = 252 * MiB;
constexpr size_t WS_OP = 288 * MiB, WS_MIX = 384 * MiB + 135424, WS_X1B = 450 * MiB, WS_UFU = 516 * MiB, WS_H = 908 * MiB, WS_END = 1104 * MiB;
constexpr size_t WS_HEADU = 516 * MiB, WS_HEADP = 520 * MiB, WS_TAIL = 524 * MiB;
constexpr size_t WS_PART4 = 540 * MiB;
constexpr size_t WS_XBUF = 548 * MiB;
constexpr size_t WS_PART = 528 * MiB;
constexpr int CW_BAR = 4096;

constexpr int RING_BYTES = 131072, LDSCTL_OFF = 155648, MISC_OFF = LDSCTL_OFF + 320, LDS_BYTES = 163840;

typedef float f32x16 __attribute__((ext_vector_type(16)));
typedef short s16x4 __attribute__((ext_vector_type(4)));
typedef unsigned u32x2 __attribute__((ext_vector_type(2)));

__device__ __forceinline__ float bflo(unsigned w) { return __uint_as_float(w << 16); }
__device__ __forceinline__ float bfhi(unsigned w) { return __uint_as_float(w & 0xffff0000u); }
__device__ __forceinline__ float bf2f(bf16 h) { return __uint_as_float((unsigned)h << 16); }
__device__ __forceinline__ void unpack8(const v4u w, float (&x)[8]) { x[0] = bflo(w.x); x[1] = bfhi(w.x); x[2] = bflo(w.y); x[3] = bfhi(w.y); x[4] = bflo(w.z); x[5] = bfhi(w.z); x[6] = bflo(w.w); x[7] = bfhi(w.w); }
__device__ __forceinline__ v4u pack8(const float (&x)[8]) { v4u w; w.x = pk2(x[0], x[1]); w.y = pk2(x[2], x[3]); w.z = pk2(x[4], x[5]); w.w = pk2(x[6], x[7]); return w; }
__device__ __forceinline__ int crow(int r, int hi) { return (r & 3) + 8 * (r >> 2) + 4 * hi; }
__device__ __forceinline__ float wave_sum(float v) {
#pragma unroll
    for (int o = 1; o < 64; o <<= 1) v += __shfl_xor(v, o);
    return v;
}
__device__ __forceinline__ float sigmoidf_(float x) { return __builtin_amdgcn_rcpf(1.f + __expf(-x)); }
__device__ __forceinline__ float one_minus_exp(float x) {
    float p = 1.f / 720.f; p = p * x + 1.f / 120.f; p = p * x + 1.f / 24.f; p = p * x + 1.f / 6.f; p = p * x + 0.5f; p = p * x + 1.f;
    const float e = 1.f - __expf(x); return x > -0.35f ? -x * p : e; }
__device__ __forceinline__ float gelu_tanh(float x) { const float z = x * (-2.3022082f + -0.10294324f * (x * x));
    return x * __builtin_amdgcn_rcpf(1.f + __builtin_amdgcn_exp2f(z)); }

struct Args { const float* in[24]; float* out; unsigned char* ws; int ph_lo, ph_hi, li, pad; };
enum { I_XP = 0, I_XS, I_SCA, I_SLH, I_CK, I_CV, I_SCF, I_GMIX, I_WIN, I_CAW, I_CAB, I_WR, I_BR, I_WI, I_BI, I_LAM, I_WOUT, I_GFFN, I_WG, I_CFW, I_CFB, I_WU, I_WD, I_GFIN };

__device__ __forceinline__ const float* xrow(const Args& a, int m) { return m < MP ? a.in[I_XP] + (size_t)m * DM : a.in[I_XS] + (size_t)(m - MP) * DM; }

__device__ __forceinline__ void p0_transpose_item(const float* W, const float* gk, int K, int N, bf16* WT, int row_off, LAS float* scr, int item, int lane, int mode = 0) {
    const int nblk = N / 32, kb = item / nblk, nb = item % nblk, k0 = 64 * kb, n0 = 32 * nb;
    const int drow0 = mode == 0 ? row_off + n0 : 256 * (n0 >> 7) + (n0 & 127) + (mode == 2 ? 128 : 0);
    float wv[32], gv[32];
#pragma unroll
    for (int i = 0; i < 32; ++i) { const int kk = 2 * i + (lane >> 5); gv[i] = gk ? gk[k0 + kk] : 1.f; wv[i] = __builtin_nontemporal_load(W + (size_t)(k0 + kk) * N + n0 + (lane & 31)); }
#pragma unroll
    for (int i = 0; i < 32; ++i) { const int kk = 2 * i + (lane >> 5); scr[kk * 33 + (lane & 31)] = wv[i] * gv[i]; }
    LDS_WAIT(); asm volatile("" ::: "memory");
    const int c = lane & 7;
#pragma unroll
    for (int j = 0; j < 4; ++j) { const int n = (lane >> 3) + 8 * j; const LAS float* s = scr + (8 * c) * 33 + n;
        v4u o; o.x = pk2(s[0 * 33], s[1 * 33]); o.y = pk2(s[2 * 33], s[3 * 33]); o.z = pk2(s[4 * 33], s[5 * 33]); o.w = pk2(s[6 * 33], s[7 * 33]);
        *(GAS v4u*)(WT + (size_t)(drow0 + n) * K + k0 + 8 * c) = o; }
    LDS_WAIT(); asm volatile("" ::: "memory");
}

__device__ __forceinline__ void p0_prologue(const Args& a, LAS unsigned char* lds, int tid, int wave, int lane, int wgi, int NW, int part) {
    unsigned char* ws = a.ws;
    LAS float* scr = (LAS float*)(lds + wave * 16384);
    const int gw = wgi * NWAVES + wave, NGW = NW * NWAVES;
    constexpr int I_A = (DM / 64) * (DIN / 32), I_B = (DM / 64) * (DM / 32), I_C = (DM / 64) * (DFF / 32), I_D = (DFF / 64) * (DM / 32);
    if (part == 0) for (int it = gw; it < I_A; it += NGW) p0_transpose_item(a.in[I_WIN], a.in[I_GMIX], DM, DIN, (bf16*)(ws + WS_WIN), 0, scr, it, lane);
    else for (int it = gw; it < I_B; it += NGW) p0_transpose_item(a.in[I_WOUT], nullptr, DM, DM, (bf16*)(ws + WS_WOUT), 0, scr, it, lane);
    const int gt = wgi * NTHR + tid, NGT = NW * NTHR;
    if (part == 0) {
    { bf16* WL = (bf16*)(ws + WS_WL);
      for (int e = gt; e < 8 * 192 * 64; e += NGT) { const int i = e & 63, o = (e >> 6) % 192, g = e / (192 * 64); float v;
          if (o < 64) v = a.in[I_WR][(g * 64 + i) * 64 + o]; else if (o < 128) v = a.in[I_WI][(g * 64 + i) * 64 + (o - 64)]; else v = (i == o - 128) ? 1.f : 0.f;
          WL[e] = (bf16)f2bf(v); } }
    { float* c8 = (float*)(ws + WS_C8);
      for (int e = gt; e < DL; e += NGT) { const float lam = a.in[I_LAM][e]; const float sp = (lam < -20.f) ? -lam : log1pf(expf(-lam)); c8[e] = 8.f * sp; } }
    { float* rope = (float*)(ws + WS_ROPE);
      for (int e = gt; e < 4100 * 8; e += NGT) { const int pi = e >> 3, i = e & 7; const double pos = pi < 4096 ? (double)pi : (double)(8192 + (pi - 4096));
          const double inv = pow(500000.0, -(double)i / 8.0), ang = pos * inv; rope[pi * 16 + i] = (float)cos(ang); rope[pi * 16 + 8 + i] = (float)sin(ang); } }
    }
    { bf16* XN = (bf16*)(ws + WS_XN); float* RS1 = (float*)(ws + WS_RS1);
      const int M_lo = part == 0 ? MP : 0, M = part == 0 ? ::M : MP;
#pragma unroll 1
      for (int m0 = M_lo + gw; m0 < M; m0 += 8 * NGW) {
          f32x4 v[8][4];
#pragma unroll
          for (int q = 0; q < 8; ++q) { const int m = m0 + q * NGW; if (m < M) { const GAS f32x4* xr = (const GAS f32x4*)xrow(a, m) + lane;
#pragma unroll
                  for (int j = 0; j < 4; ++j) v[q][j] = __builtin_nontemporal_load((const f32x4*)(xr + 64 * j)); } }
#pragma unroll
          for (int q = 0; q < 8; ++q) { const int m = m0 + q * NGW; if (m < M) { float s = 0.f;
#pragma unroll
                  for (int j = 0; j < 4; ++j) s += (v[q][j].x * v[q][j].x + v[q][j].y * v[q][j].y) + (v[q][j].z * v[q][j].z + v[q][j].w * v[q][j].w);
                  s = wave_sum(s); if (lane == 0) RS1[m] = 1.f / sqrtf(s * (1.f / DM) + EPS);
                  GAS unsigned long long* o8 = (GAS unsigned long long*)(XN + (size_t)m * DM) + lane;
#pragma unroll
                  for (int j = 0; j < 4; ++j) o8[64 * j] = (unsigned long long)pk2(v[q][j].x, v[q][j].y) | ((unsigned long long)pk2(v[q][j].z, v[q][j].w) << 32); } }
      } }
}

__device__ __forceinline__ void ffn_weights(const Args& a, LAS unsigned char* lds, int wave, int lane, int gw, int NGW, int which) {
    unsigned char* ws = a.ws;
    LAS float* scr = (LAS float*)(lds + wave * 16384);
    constexpr int I_C = (DM / 64) * (DFF / 32), I_D = (DFF / 64) * (DM / 32);
    const int n = which == 1 ? 2 * I_C : I_D;
#pragma unroll 1
    for (int it = gw; it < n; it += NGW) {
        const bool up = which == 1 && it >= I_C; const int r = up ? it - I_C : it;
        const float* W = which == 2 ? a.in[I_WD] : up ? a.in[I_WU] : a.in[I_WG];
        p0_transpose_item(W, which == 2 ? nullptr : a.in[I_GFFN], which == 2 ? DFF : DM, which == 2 ? DM : DFF, (bf16*)(ws + (which == 2 ? WS_WDN : WS_WGU)), 0, scr, r, lane, which == 2 ? 0 : up ? 2 : 1);
    }
}
__device__ __forceinline__ void load8_bf16(const bf16* p, float (&x)[8]) { unpack8(*(const v4u*)p, x); }
__device__ __forceinline__ void load8_f32(const float* p, float (&x)[8]) { const f32x4 a = *(const f32x4*)p, b = *(const f32x4*)(p + 4); x[0] = a[0]; x[1] = a[1]; x[2] = a[2]; x[3] = a[3]; x[4] = b[0]; x[5] = b[1]; x[6] = b[2]; x[7] = b[3]; }
struct EpiZ {
    static constexpr bool PERM = true, AFTER_DRAIN = false;
    const float* rs1; const float* rope; bf16 *XA, *GA, *Q, *K, *V; float* QS; float* out; LAS float* ex;
    __device__ __forceinline__ void pre(const pg8::Unit& u, int par, int tid) const { if (tid < 256) ex[1024 + par * 256 + tid] = rs1[u.pm * 256 + tid]; }
    __device__ __forceinline__ void operator()(const pg8::f32x4 (&acc)[2][2][4][2], const pg8::Unit& u, int wr, int wc, int fr, int fq, int par) const {
        const int type = u.pn >> 1;
        const int cbase = (u.pn & 1) * 256 + wc * 32 + 8 * fq;
        float rsv[2][4];
#pragma unroll
        for (int ai = 0; ai < 2; ++ai)
#pragma unroll
            for (int m = 0; m < 4; ++m) rsv[ai][m] = ex[1024 + par * 256 + ai * 128 + wr * 64 + m * 16 + fr];
        const bool do_rope = (type == 2 || type == 3) && (wc & 1) == 0;
#pragma unroll
        for (int ai = 0; ai < 2; ++ai) {
            f32x4 rc[4][4];
#pragma unroll
            for (int m = 0; m < 4; ++m) {
                if ((m & 1) == 0 && do_rope && fq < 2) {
#pragma unroll
                    for (int mm = m; mm < m + 2; ++mm) { const int row = u.pm * 256 + ai * 128 + wr * 64 + mm * 16 + fr; const int pi = row >= MP ? 4096 + (row & 3) : (row & 4095);
                        const f32x4* rp = (const f32x4*)(rope + (size_t)pi * 16); rc[mm][0] = rp[0]; rc[mm][1] = rp[1]; rc[mm][2] = rp[2]; rc[mm][3] = rp[3]; }
                }
                const int row = u.pm * 256 + ai * 128 + wr * 64 + m * 16 + fr;
                const float rs = rsv[ai][m];
                const bool samp = row >= MP;
                const int b = samp ? ((row - MP) >> 2) : (row >> 12), t = samp ? (row & 3) : (row & 4095);
#pragma unroll
                for (int bj = 0; bj < 2; ++bj) {
                    const int ct = cbase + 128 * bj;
                    float v[8];
#pragma unroll
                    for (int i = 0; i < 4; ++i) { v[i] = acc[ai][bj][m][0][i] * rs; v[4 + i] = acc[ai][bj][m][1][i] * rs; }
                    if (do_rope) {
                        float pv[8];
#pragma unroll
                        for (int i = 0; i < 8; ++i) pv[i] = __shfl_xor(v[i], 16);
                        if (fq < 2) { const float sg = fq == 0 ? -1.f : 1.f;
                            const f32x4 c0 = rc[m][0], c1 = rc[m][1], s0 = rc[m][2], s1 = rc[m][3];
#pragma unroll
                            for (int i = 0; i < 4; ++i) { v[i] = v[i] * c0[i] + sg * pv[i] * s0[i]; v[4 + i] = v[4 + i] * c1[i] + sg * pv[4 + i] * s1[i]; } }
                    }
                    float* so = nullptr;
                    bf16* dst;
                    if (type == 0) { dst = XA; if (!samp) { if (t >= SEQ - 3) so = out + O_PCA + (size_t)(b * 3 + (t - (SEQ - 3))) * DL + ct; } else if (t >= 1) so = out + O_SCA + (size_t)(b * 3 + t - 1) * DL + ct; }
                    else if (type == 1) dst = GA;
                    else if (type == 2) { dst = Q;
#pragma unroll
                        for (int i = 0; i < 8; ++i) v[i] *= C2;
                        if (samp) so = QS + (size_t)(row - MP) * 512 + ct; }
                    else if (type == 3) { dst = K; if (!samp) { if (t >= 2048) so = out + O_PWK + (size_t)(b * 2048 + t - 2048) * 512 + ct; } else so = out + O_SWK + (size_t)(b * 4 + t) * 512 + ct; }
                    else { dst = V; if (!samp) { if (t >= 2048) so = out + O_PWV + (size_t)(b * 2048 + t - 2048) * 512 + ct; } else so = out + O_SWV + (size_t)(b * 4 + t) * 512 + ct; }
                    *(v4u*)(dst + (size_t)row * 512 + ct) = pack8(v);
                    if (so) { *(f32x4*)so = (f32x4){v[0], v[1], v[2], v[3]}; *(f32x4*)(so + 4) = (f32x4){v[4], v[5], v[6], v[7]}; }
                }
            }
        }
    }
};
struct EpiX1 {
    static constexpr bool PERM = true, AFTER_DRAIN = false;
    __device__ __forceinline__ void pre(const pg8::Unit&, int, int) const {}
    const float* xp; const float* xs; float* Y; bf16* X1B; float* SSP;
    __device__ __forceinline__ void operator()(const pg8::f32x4 (&acc)[2][2][4][2], const pg8::Unit& u, int wr, int wc, int fr, int fq, int par) const {
        const int cbase = u.pn * 256 + wc * 32 + 8 * fq;
#pragma unroll
        for (int ai = 0; ai < 2; ++ai) {
            f32x4 xv[4][2][2];
#pragma unroll
            for (int m = 0; m < 4; ++m) { const int row = u.pm * 256 + ai * 128 + wr * 64 + m * 16 + fr;
                const float* xr = row < MP ? xp + (size_t)row * DM : xs + (size_t)(row - MP) * DM;
#pragma unroll
                for (int bj = 0; bj < 2; ++bj) { xv[m][bj][0] = __builtin_nontemporal_load((const f32x4*)(xr + cbase + 128 * bj)); xv[m][bj][1] = __builtin_nontemporal_load((const f32x4*)(xr + cbase + 128 * bj + 4)); } }
#pragma unroll
            for (int m = 0; m < 4; ++m) {
                const int row = u.pm * 256 + ai * 128 + wr * 64 + m * 16 + fr;
                float ss = 0.f;
#pragma unroll
                for (int bj = 0; bj < 2; ++bj) {
                    const int ct = cbase + 128 * bj;
                    const f32x4 o0 = xv[m][bj][0] + acc[ai][bj][m][0], o1 = xv[m][bj][1] + acc[ai][bj][m][1];
                    if (u.pm >= MP / 256) { *(f32x4*)(Y + (size_t)row * DM + ct) = o0; *(f32x4*)(Y + (size_t)row * DM + ct + 4) = o1; }
                    const float v[8] = {o0[0], o0[1], o0[2], o0[3], o1[0], o1[1], o1[2], o1[3]};
                    *(v4u*)(X1B + (size_t)row * DM + ct) = pack8(v);
#pragma unroll
                    for (int i = 0; i < 8; ++i) ss += v[i] * v[i];
                }
                ss += __shfl_xor(ss, 16); ss += __shfl_xor(ss, 32);
                if (fq == 0) SSP[(size_t)row * 16 + u.pn * 4 + wc] = ss;
            }
        }
    }
};
__device__ __forceinline__ float row_rs(const float* SSP, int row) {
    const f32x4* p = (const f32x4*)(SSP + (size_t)row * 16); const f32x4 a = p[0], b = p[1], c = p[2], d = p[3];
    const float s = ((a[0] + a[1]) + (a[2] + a[3])) + ((b[0] + b[1]) + (b[2] + b[3])) + ((c[0] + c[1]) + (c[2] + c[3])) + ((d[0] + d[1]) + (d[2] + d[3]));
    return 1.f / sqrtf(s * (1.f / DM) + EPS);
}
template <int CTRL> __device__ __forceinline__ float dpp_t(float v) { return __builtin_bit_cast(float, __builtin_amdgcn_update_dpp(0, __builtin_bit_cast(int, v), CTRL, 0xf, 0xf, false)); }
#define dpp_f(v, ctrl) dpp_t<ctrl>(v)
template <int CTRL> __device__ __forceinline__ float dpp_b(float v) { return __builtin_bit_cast(float, __builtin_amdgcn_update_dpp(0, __builtin_bit_cast(int, v), CTRL, 0xf, 0xf, true)); }
__device__ __forceinline__ float dpp_ror1(float v) { return __builtin_bit_cast(float, __builtin_amdgcn_update_dpp(0, __builtin_bit_cast(int, v), 0x121, 0xf, 0xf, false)); }
__device__ __forceinline__ float dpp_ror2(float v) { return __builtin_bit_cast(float, __builtin_amdgcn_update_dpp(0, __builtin_bit_cast(int, v), 0x122, 0xf, 0xf, false)); }
struct EpiGU {
    static constexpr bool PERM = true, AFTER_DRAIN = false;
    const float* SSP; bf16* H; const float* cw; const float* cb; const float* scf; float* out; float* HEADU; float* HEADP; float* TAIL; LAS float* ex; LAS float* cwl;
    __device__ __forceinline__ void pre(const pg8::Unit& u, int par, int tid) const {
        if (tid < 256) ex[1024 + par * 256 + tid] = row_rs(SSP, u.pm * 256 + tid);
        else { const int t = tid - 256, arr = t >> 6, c2 = (t & 63) * 2; const float* src = (arr < 3 ? cw + arr * DFF : cb) + u.pn * 128 + c2;
            const f32x2 v = *(const f32x2*)src; *(LAS f32x2*)(cwl + par * 512 + arr * 128 + c2) = v; }
    }
    __device__ __forceinline__ void operator()(const pg8::f32x4 (&acc)[2][2][4][2], const pg8::Unit& u, int wr, int wc, int fr, int fq, int par) const {
        if (u.pm >= MP / 256) sample_body(acc, u, wr, wc, fr, fq, par); else prompt_body(acc, u, wr, wc, fr, fq, par);
    }
    __device__ __forceinline__ void prompt_body(const pg8::f32x4 (&acc)[2][2][4][2], const pg8::Unit& u, int wr, int wc, int fr, int fq, int par) const {
        const int j0 = u.pn * 128 + wc * 32 + 8 * fq;
        const int wave = wr * 4 + wc;
        float w0[8], w1[8], w2[8], bb[8];
        { const LAS float* cl = cwl + par * 512 + wc * 32 + 8 * fq;
#pragma unroll
          for (int h = 0; h < 2; ++h) { const f32x4 a0 = *(const LAS f32x4*)(cl + 4 * h), a1 = *(const LAS f32x4*)(cl + 128 + 4 * h), a2 = *(const LAS f32x4*)(cl + 256 + 4 * h), a3 = *(const LAS f32x4*)(cl + 384 + 4 * h);
#pragma unroll
              for (int e = 0; e < 4; ++e) { w0[4 * h + e] = a0[e]; w1[4 * h + e] = a1[e]; w2[4 * h + e] = a2[e]; bb[4 * h + e] = a3[e]; } } }
        const bool l15 = fr == 15, l14 = fr >= 14;
#pragma unroll
        for (int ai = 0; ai < 2; ++ai) {
            const float rs = ex[1024 + par * 256 + ai * 128 + wr * 64 + 48 + fr];
            if (fr >= 14) { LAS float* e = ex + ((wave * 2 + ai) * 2 + (fr - 14)) * 32 + 8 * fq;
                *(LAS f32x4*)e = acc[ai][0][3][0] * rs; *(LAS f32x4*)(e + 4) = acc[ai][0][3][1] * rs; }
        }
        asm volatile("s_waitcnt lgkmcnt(0)\n\ts_barrier" ::: "memory");
#pragma unroll
        for (int ai = 0; ai < 2; ++ai) {
            float gp[8];
            bool pending = false;
            if (wr == 0 && ai == 0) {
#pragma unroll
                for (int e = 0; e < 8; ++e) gp[e] = 0.f;
                pending = (u.pm & 15) != 0;
            } else {
                const int sw = (wr == 1) ? wc : 4 + wc, sa = (wr == 1) ? ai : 0;
                const LAS float* e2 = ex + ((sw * 2 + sa) * 2 + (fr & 1)) * 32 + 8 * fq;
                const f32x4 b0 = *(const LAS f32x4*)e2, b1 = *(const LAS f32x4*)(e2 + 4);
#pragma unroll
                for (int e = 0; e < 4; ++e) { gp[e] = b0[e]; gp[4 + e] = b1[e]; }
            }
            float rsv[4];
#pragma unroll
            for (int m = 0; m < 4; ++m) rsv[m] = ex[1024 + par * 256 + ai * 128 + wr * 64 + m * 16 + fr];
#pragma unroll
            for (int m = 0; m < 4; ++m) {
                const int row = u.pm * 256 + ai * 128 + wr * 64 + m * 16 + fr;
                const float rs = rsv[m];
                float g[8], up[8]; unsigned yw[4];
#pragma unroll
                for (int e = 0; e < 4; ++e) { g[e] = acc[ai][0][m][0][e] * rs; g[4 + e] = acc[ai][0][m][1][e] * rs; up[e] = acc[ai][1][m][0][e] * rs; up[4 + e] = acc[ai][1][m][1][e] * rs; }
#pragma unroll
                for (int e2 = 0; e2 < 4; ++e2) {
                    f32x2 x;
#pragma unroll
                    for (int q = 0; q < 2; ++q) { const int e = 2 * e2 + q;
                        const float h1 = l15 ? gp[e] : g[e], h2 = l14 ? gp[e] : g[e];
                        float uc = fmaf(w2[e], g[e], bb[e]);
                        uc = fmaf(dpp_b<0x121>(h1), w1[e], uc); uc = fmaf(dpp_b<0x122>(h2), w0[e], uc);
                        x[q] = uc; }
                    f32x2 t = x * x; t = t * (f32x2){-0.10294324f, -0.10294324f} + (f32x2){-2.3022082f, -2.3022082f}; t = t * x;
                    f32x2 d = (f32x2){__builtin_amdgcn_exp2f(t[0]), __builtin_amdgcn_exp2f(t[1])} + (f32x2){1.f, 1.f};
                    const f32x2 r = (f32x2){__builtin_amdgcn_rcpf(d[0]), __builtin_amdgcn_rcpf(d[1])};
                    const f32x2 y = (x * r) * (f32x2){up[2 * e2], up[2 * e2 + 1]};
                    yw[e2] = pk2(y[0], y[1]);
                }
                const bool hold = pending && m == 0 && fr < 2;
                if (!hold) *(v4u*)(H + (size_t)row * DFF + j0) = (v4u){yw[0], yw[1], yw[2], yw[3]};
                else { float* hu = HEADU + (size_t)(u.pm * 2 + fr) * DFF + j0; float* hp = HEADP + (size_t)(u.pm * 2 + fr) * DFF + j0;
                    *(f32x4*)hu = (f32x4){g[0], g[1], g[2], g[3]}; *(f32x4*)(hu + 4) = (f32x4){g[4], g[5], g[6], g[7]};
                    *(f32x4*)hp = (f32x4){up[0], up[1], up[2], up[3]}; *(f32x4*)(hp + 4) = (f32x4){up[4], up[5], up[6], up[7]}; }
                if (ai == 1 && wr == 1 && m == 3 && fr >= 14) { float* so = TAIL + (size_t)(u.pm * 2 + (fr - 14)) * DFF + j0;
                    if ((u.pm & 15) == 15) { float* so2 = out + O_PCF + (size_t)((u.pm >> 4) * 2 + (fr - 14)) * DFF + j0;
                        *(f32x4*)so2 = (f32x4){g[0], g[1], g[2], g[3]}; *(f32x4*)(so2 + 4) = (f32x4){g[4], g[5], g[6], g[7]}; }
                    *(f32x4*)so = (f32x4){g[0], g[1], g[2], g[3]}; *(f32x4*)(so + 4) = (f32x4){g[4], g[5], g[6], g[7]}; }
#pragma unroll
                for (int e = 0; e < 8; ++e) gp[e] = g[e];
            }
        }
    }
    __device__ __forceinline__ void sample_body(const pg8::f32x4 (&acc)[2][2][4][2], const pg8::Unit& u, int wr, int wc, int fr, int fq, int par) const {
        const int j0 = u.pn * 128 + wc * 32 + 8 * fq;
        constexpr bool samp = true;
        const int wave = wr * 4 + wc;
        float w0[8], w1[8], w2[8], bb[8];
        { const LAS float* cl = cwl + par * 512 + wc * 32 + 8 * fq;
#pragma unroll
          for (int h = 0; h < 2; ++h) { const f32x4 a0 = *(const LAS f32x4*)(cl + 4 * h), a1 = *(const LAS f32x4*)(cl + 128 + 4 * h), a2 = *(const LAS f32x4*)(cl + 256 + 4 * h), a3 = *(const LAS f32x4*)(cl + 384 + 4 * h);
#pragma unroll
              for (int e = 0; e < 4; ++e) { w0[4 * h + e] = a0[e]; w1[4 * h + e] = a1[e]; w2[4 * h + e] = a2[e]; bb[4 * h + e] = a3[e]; } } }
        if (!samp) {
#pragma unroll
            for (int ai = 0; ai < 2; ++ai) {
                const float rs = ex[1024 + par * 256 + ai * 128 + wr * 64 + 48 + fr];
                if (fr >= 14) { LAS float* e = ex + ((wave * 2 + ai) * 2 + (fr - 14)) * 32 + 8 * fq;
                    *(LAS f32x4*)e = acc[ai][0][3][0] * rs; *(LAS f32x4*)(e + 4) = acc[ai][0][3][1] * rs; }
            }
            asm volatile("s_waitcnt lgkmcnt(0)\n\ts_barrier" ::: "memory");
        }
#pragma unroll
        for (int ai = 0; ai < 2; ++ai) {
            float pR1[8], pR2[8];
            bool pending = false;
            if (!samp) {
                if (wr == 0 && ai == 0) {
#pragma unroll
                    for (int e = 0; e < 8; ++e) { pR1[e] = 0.f; pR2[e] = 0.f; }
                    pending = (u.pm & 15) != 0;
                } else {
                    const int sw = (wr == 1) ? wc : 4 + wc, sa = (wr == 1) ? ai : 0;
                    const LAS float* e1 = ex + ((sw * 2 + sa) * 2 + 1) * 32 + 8 * fq; const LAS float* e2 = ex + ((sw * 2 + sa) * 2 + (fr & 1)) * 32 + 8 * fq;
                    const f32x4 a0 = *(const LAS f32x4*)e1, a1 = *(const LAS f32x4*)(e1 + 4), b0 = *(const LAS f32x4*)e2, b1 = *(const LAS f32x4*)(e2 + 4);
#pragma unroll
                    for (int e = 0; e < 4; ++e) { pR1[e] = a0[e]; pR1[4 + e] = a1[e]; pR2[e] = b0[e]; pR2[4 + e] = b1[e]; }
                }
            }
            float rsv[4];
#pragma unroll
            for (int m = 0; m < 4; ++m) rsv[m] = ex[1024 + par * 256 + ai * 128 + wr * 64 + m * 16 + fr];
#pragma unroll
            for (int m = 0; m < 4; ++m) {
                const int row = u.pm * 256 + ai * 128 + wr * 64 + m * 16 + fr;
                const float rs = rsv[m];
                float g[8], up[8]; unsigned yw[4];
#pragma unroll
                for (int e = 0; e < 4; ++e) { g[e] = acc[ai][0][m][0][e] * rs; g[4 + e] = acc[ai][0][m][1][e] * rs; up[e] = acc[ai][1][m][0][e] * rs; up[4 + e] = acc[ai][1][m][1][e] * rs; }
#pragma unroll
                for (int hf = 0; hf < 2; ++hf) {
                    float yh[4];
                    f32x4 s0 = (f32x4){0.f, 0.f, 0.f, 0.f}, s1 = s0; int sq = 3;
                    if (samp) { const int n = (row - MP) >> 2; sq = fr & 3; s0 = *(const f32x4*)(scf + (size_t)(n * 2) * DFF + j0 + 4 * hf); s1 = *(const f32x4*)(scf + (size_t)(n * 2 + 1) * DFF + j0 + 4 * hf); }
#pragma unroll
                    for (int e4 = 0; e4 < 4; ++e4) { const int e = 4 * hf + e4;
                        const float R1 = dpp_ror1(g[e]), R2 = dpp_ror2(g[e]);
                        float p1, p2;
                        if (!samp) { p1 = fr >= 1 ? R1 : pR1[e]; p2 = fr >= 2 ? R2 : pR2[e]; }
                        else { p1 = sq >= 1 ? R1 : s1[e4]; p2 = sq >= 2 ? R2 : (sq == 1 ? s1[e4] : s0[e4]); }
                        const float uc = bb[e] + w0[e] * p2 + w1[e] * p1 + w2[e] * g[e]; yh[e4] = gelu_tanh(uc) * up[e]; pR1[e] = R1; pR2[e] = R2; }
                    yw[2 * hf] = pk2(yh[0], yh[1]); yw[2 * hf + 1] = pk2(yh[2], yh[3]);
                }
                const bool hold = pending && m == 0 && fr < 2;
                if (!hold) *(v4u*)(H + (size_t)row * DFF + j0) = (v4u){yw[0], yw[1], yw[2], yw[3]};
                else { float* hu = HEADU + (size_t)(u.pm * 2 + fr) * DFF + j0; float* hp = HEADP + (size_t)(u.pm * 2 + fr) * DFF + j0;
                    *(f32x4*)hu = (f32x4){g[0], g[1], g[2], g[3]}; *(f32x4*)(hu + 4) = (f32x4){g[4], g[5], g[6], g[7]};
                    *(f32x4*)hp = (f32x4){up[0], up[1], up[2], up[3]}; *(f32x4*)(hp + 4) = (f32x4){up[4], up[5], up[6], up[7]}; }
                float* so = nullptr;
                if (!samp) { if (ai == 1 && wr == 1 && m == 3 && fr >= 14) { so = TAIL + (size_t)(u.pm * 2 + (fr - 14)) * DFF + j0;
                        if ((u.pm & 15) == 15) { float* so2 = out + O_PCF + (size_t)((u.pm >> 4) * 2 + (fr - 14)) * DFF + j0;
                            *(f32x4*)so2 = (f32x4){g[0], g[1], g[2], g[3]}; *(f32x4*)(so2 + 4) = (f32x4){g[4], g[5], g[6], g[7]}; } } }
                else if ((fr & 3) >= 2) so = out + O_SCF + (size_t)(((row - MP) >> 2) * 2 + ((fr & 3) - 2)) * DFF + j0;
                if (so) { *(f32x4*)so = (f32x4){g[0], g[1], g[2], g[3]}; *(f32x4*)(so + 4) = (f32x4){g[4], g[5], g[6], g[7]}; }
            }
        }
    }
};
struct EpiX2 {
    static constexpr bool PERM = true, AFTER_DRAIN = false;
    __device__ __forceinline__ void pre(const pg8::Unit&, int, int) const {}
    float* Y; const bf16* X1B;
    __device__ __forceinline__ void operator()(const pg8::f32x4 (&acc)[2][2][4][2], const pg8::Unit& u, int wr, int wc, int fr, int fq, int par) const {
        const int cbase = u.pn * 256 + wc * 32 + 8 * fq;
#pragma unroll
        for (int ai = 0; ai < 2; ++ai) {
            v4u xv[4][2];
#pragma unroll
            for (int m = 0; m < 4; ++m) { const bf16* xr = X1B + (size_t)(u.pm * 256 + ai * 128 + wr * 64 + m * 16 + fr) * DM + cbase;
#pragma unroll
                for (int bj = 0; bj < 2; ++bj) xv[m][bj] = *(const v4u*)(xr + 128 * bj); }
#pragma unroll
            for (int m = 0; m < 4; ++m) {
                const int row = u.pm * 256 + ai * 128 + wr * 64 + m * 16 + fr;
#pragma unroll
                for (int bj = 0; bj < 2; ++bj) { float* yp = Y + (size_t)row * DM + cbase + 128 * bj; float x[8]; unpack8(xv[m][bj], x);
                    *(f32x4*)yp = (f32x4){x[0], x[1], x[2], x[3]} + acc[ai][bj][m][0]; *(f32x4*)(yp + 4) = (f32x4){x[4], x[5], x[6], x[7]} + acc[ai][bj][m][1]; }
            }
        }
    }
};
constexpr int CW_X2C = 100000;
struct EpiX2F {
    static constexpr bool PERM = true, AFTER_DRAIN = true;
    __device__ __forceinline__ void pre(const pg8::Unit&, int, int) const {}
    float* Y; const bf16* X1B; const float* gfin; float* xbuf; unsigned* cnt;
    __device__ __forceinline__ void operator()(const pg8::f32x4 (&)[2][2][4][2], const pg8::Unit&, int, int, int, int, int) const {}
    __device__ __forceinline__ void fused(pg8::f32x4 (&acc)[2][2][4][2], const pg8::Unit& u, int wr, int wc, int fr, int fq, LAS unsigned char* lds, int wid, int lane) const {
        const int cbase = u.pn * 256 + wc * 32 + 8 * fq, tid = wid * 64 + lane;
        LAS float* P = (LAS float*)lds; LAS float* S = P + 1024; LAS unsigned* flag = (LAS unsigned*)(S + 256);
        { v4u xv[2][4][2];
#pragma unroll
          for (int ai = 0; ai < 2; ++ai)
#pragma unroll
            for (int m = 0; m < 4; ++m) { const bf16* xr = X1B + (size_t)(u.pm * 256 + ai * 128 + wr * 64 + m * 16 + fr) * DM + cbase;
#pragma unroll
                for (int bj = 0; bj < 2; ++bj) xv[ai][m][bj] = *(const v4u*)(xr + 128 * bj); }
#pragma unroll
          for (int ai = 0; ai < 2; ++ai)
#pragma unroll
            for (int m = 0; m < 4; ++m) { float ss = 0.f;
#pragma unroll
                for (int bj = 0; bj < 2; ++bj) { float x[8]; unpack8(xv[ai][m][bj], x);
#pragma unroll
                    for (int i = 0; i < 4; ++i) { acc[ai][bj][m][0][i] += x[i]; acc[ai][bj][m][1][i] += x[4 + i]; ss += acc[ai][bj][m][0][i] * acc[ai][bj][m][0][i] + acc[ai][bj][m][1][i] * acc[ai][bj][m][1][i]; } }
                ss += __shfl_xor(ss, 16); ss += __shfl_xor(ss, 32);
                if (fq == 0) P[(ai * 128 + wr * 64 + m * 16 + fr) * 4 + wc] = ss; } }
        asm volatile("s_waitcnt lgkmcnt(0)" ::: "memory"); __builtin_amdgcn_s_barrier(); asm volatile("" ::: "memory");
        if (tid < 256) { const pg8::f32x4 p4 = *(const LAS pg8::f32x4*)(P + tid * 4);
            __hip_atomic_store(xbuf + ((size_t)u.pm * 256 + tid) * 4 + u.pn, (p4[0] + p4[1]) + (p4[2] + p4[3]), __ATOMIC_RELAXED, __HIP_MEMORY_SCOPE_AGENT); }
        asm volatile("s_waitcnt vmcnt(0)" ::: "memory");
        if (lane == 0 && wid < 4) __hip_atomic_fetch_add(cnt + u.pm * 16, 1u, __ATOMIC_RELAXED, __HIP_MEMORY_SCOPE_AGENT);
        if (wid == 0) { unsigned spins = 0;
            while ((unsigned)__builtin_amdgcn_readfirstlane(__hip_atomic_load(cnt + u.pm * 16, __ATOMIC_RELAXED, __HIP_MEMORY_SCOPE_AGENT)) < 16u) { if (++spins > (1u << 20)) break; __builtin_amdgcn_s_sleep(2); }
            __builtin_amdgcn_fence(__ATOMIC_ACQUIRE, "agent"); }
        asm volatile("s_waitcnt vmcnt(0) lgkmcnt(0)" ::: "memory"); __builtin_amdgcn_s_barrier(); asm volatile("" ::: "memory");
        if (tid < 256) { const float* sl = xbuf + ((size_t)u.pm * 256 + tid) * 4; float t = 0.f;
#pragma unroll
            for (int k = 0; k < 4; ++k) t += __hip_atomic_load(sl + k, __ATOMIC_RELAXED, __HIP_MEMORY_SCOPE_AGENT);
            S[tid] = 1.f / sqrtf(t * (1.f / DM) + EPS); }
        asm volatile("s_waitcnt vmcnt(0) lgkmcnt(0)" ::: "memory"); __builtin_amdgcn_s_barrier(); asm volatile("" ::: "memory");
        pg8::f32x4 gv[2][2];
#pragma unroll
        for (int bj = 0; bj < 2; ++bj) { gv[bj][0] = *(const pg8::f32x4*)(gfin + cbase + 128 * bj); gv[bj][1] = *(const pg8::f32x4*)(gfin + cbase + 128 * bj + 4); }
#pragma unroll
        for (int ai = 0; ai < 2; ++ai)
#pragma unroll
            for (int m = 0; m < 4; ++m) { const int rl = ai * 128 + wr * 64 + m * 16 + fr; const float rs = S[rl]; float* yp = Y + (size_t)(u.pm * 256 + rl) * DM + cbase;
#pragma unroll
                for (int bj = 0; bj < 2; ++bj) { *(pg8::f32x4*)(yp + 128 * bj) = acc[ai][bj][m][0] * rs * gv[bj][0]; *(pg8::f32x4*)(yp + 128 * bj + 4) = acc[ai][bj][m][1] * rs * gv[bj][1]; } }
    }
};
struct SampleUnitOrder {
    int c, nw;
    __device__ __forceinline__ bool next(int i, pg8::Unit& u) const { const int L = i * nw + c; if (L >= 2 * (DIN / 256)) return false; u.pm = MP / 256 + L / (DIN / 256); u.pn = L % (DIN / 256); u.ko = 0; return true; }
    __device__ __forceinline__ void a_ready(const pg8::Unit&) const {}
    __device__ __forceinline__ void done(const pg8::Unit&) const {}
};
struct OneUnitOrder : pg8::StaticOrder {
    int i0;
    __device__ __forceinline__ bool next(int i, pg8::Unit& u) const { return i == 0 && pg8::StaticOrder::next(i0, u); }
};
constexpr int KSPLIT = 6, KSPLIT4 = 4;
struct EpiPart {
    static constexpr bool PERM = true, AFTER_DRAIN = false;
    __device__ __forceinline__ void pre(const pg8::Unit&, int, int) const {}
    float* PART; int kw;
    __device__ __forceinline__ void operator()(const pg8::f32x4 (&acc)[2][2][4][2], const pg8::Unit& u, int wr, int wc, int fr, int fq, int par) const {
        const int cbase = u.pn * 256 + wc * 32 + 8 * fq; float* P = PART + (size_t)(u.ko / kw) * MS * DM;
#pragma unroll
        for (int ai = 0; ai < 2; ++ai)
#pragma unroll
            for (int m = 0; m < 4; ++m) { const int rS = (u.pm - MP / 256) * 256 + ai * 128 + wr * 64 + m * 16 + fr;
#pragma unroll
                for (int bj = 0; bj < 2; ++bj) { float* pp = P + (size_t)rS * DM + cbase + 128 * bj; *(f32x4*)pp = acc[ai][bj][m][0]; *(f32x4*)(pp + 4) = acc[ai][bj][m][1]; } }
    }
};
struct SplitOrder {
    int G, c, ns, kw;
    __device__ __forceinline__ bool next(int i, pg8::Unit& u) const { const int idx = c + i * G; if (idx >= 8 * ns) return false;
        const int sl = idx >> 3, r = idx & 7; u.pm = MP / 256 + (r >> 2); u.pn = r & 3; u.ko = sl * kw; return true; }
    __device__ __forceinline__ void a_ready(const pg8::Unit&) const {}
    __device__ __forceinline__ void done(const pg8::Unit&) const {}
};
struct GatedOrder : pg8::StaticOrder {
    const unsigned* cnt; unsigned need;
    __device__ __forceinline__ void a_ready(const pg8::Unit& u) const {
        if (u.pm < MP / 256) return;
        if (threadIdx.x < 64) { unsigned spins = 0;
            while ((unsigned)__builtin_amdgcn_readfirstlane(__hip_atomic_load(cnt, __ATOMIC_RELAXED, __HIP_MEMORY_SCOPE_AGENT)) < need) { if (++spins > (1u << 20)) break; __builtin_amdgcn_s_sleep(2); }
            __builtin_amdgcn_fence(__ATOMIC_ACQUIRE, "agent");
            asm volatile("s_waitcnt vmcnt(0)" ::: "memory"); }
        asm volatile("" ::: "memory"); __builtin_amdgcn_s_barrier(); asm volatile("" ::: "memory");
    }
};
constexpr int CW_P0A = 90064;
constexpr int CW_CNT4 = 90000;
__device__ __forceinline__ void finalize_x1_sample(const Args& a, int bx, int G, int wave, int lane) {
    unsigned char* ws = a.ws; const float* PART4 = (const float*)(ws + WS_PART4); float* Y = a.out + O_Y; bf16* X1B = (bf16*)(ws + WS_X1B); float* SSP = (float*)(ws + WS_SSP);
    unsigned* cnt = (unsigned*)(ws + WS_CTL) + CW_CNT4;
    for (int r = bx + G * wave; r < MS; r += G * NWAVES) {
        const int row = MP + r; f32x4 v[4]; float ss = 0.f;
#pragma unroll
        for (int j = 0; j < 4; ++j) { v[j] = ((const GAS f32x4*)(a.in[I_XS] + (size_t)r * DM) + lane)[64 * j];
#pragma unroll
            for (int sl = 0; sl < KSPLIT4; ++sl) v[j] += ((const GAS f32x4*)(PART4 + ((size_t)sl * MS + r) * DM) + lane)[64 * j];
            ss += (v[j].x * v[j].x + v[j].y * v[j].y) + (v[j].z * v[j].z + v[j].w * v[j].w); }
        ss = wave_sum(ss);
#pragma unroll
        for (int j = 0; j < 4; ++j) { const size_t e = (size_t)row * DM + 4 * (lane + 64 * j);
            __hip_atomic_store((unsigned long long*)(Y + e), ((unsigned long long)__float_as_uint(v[j].y) << 32) | __float_as_uint(v[j].x), __ATOMIC_RELAXED, __HIP_MEMORY_SCOPE_AGENT);
            __hip_atomic_store((unsigned long long*)(Y + e + 2), ((unsigned long long)__float_as_uint(v[j].w) << 32) | __float_as_uint(v[j].z), __ATOMIC_RELAXED, __HIP_MEMORY_SCOPE_AGENT);
            __hip_atomic_store((unsigned long long*)(X1B + e), ((unsigned long long)pk2(v[j].z, v[j].w) << 32) | pk2(v[j].x, v[j].y), __ATOMIC_RELAXED, __HIP_MEMORY_SCOPE_AGENT); }
        if (lane < 8) __hip_atomic_store((unsigned long long*)(SSP + (size_t)row * 16 + 2 * lane), lane == 0 ? (unsigned long long)__float_as_uint(ss) : 0ull, __ATOMIC_RELAXED, __HIP_MEMORY_SCOPE_AGENT);
        asm volatile("s_waitcnt vmcnt(0)" ::: "memory");
        if (lane == 0) __hip_atomic_fetch_add(cnt, 1u, __ATOMIC_RELAXED, __HIP_MEMORY_SCOPE_AGENT);
    }
}

constexpr int LRU_CS = 64 * 16 + 16;
template <int MODE> __device__ __forceinline__ void lru_item(const Args& a, int item, LAS unsigned char* lds, int wid, int lane) {
    unsigned char* ws = a.ws;
    const bf16* XA = (const bf16*)(ws + WS_XA); const bf16* GAb = (const bf16*)(ws + WS_GA); const bf16* WL = (const bf16*)(ws + WS_WL);
    const float* C8 = (const float*)(ws + WS_C8); float* AGGA = (float*)(ws + WS_AGGA); float* AGGB = (float*)(ws + WS_AGGB); bf16* MIX = (bf16*)(ws + WS_MIX);
    const int seq = item >> 6, chunk = item & 63, g = wid;
    const int row0 = (MODE == 2) ? MP + item * 64 : seq * SEQ + chunk * 64;
    {
        float w[4][8], bb[8];
#pragma unroll
        for (int j = 0; j < 4; ++j) load8_f32(a.in[I_CAW] + j * DL + 8 * lane, w[j]);
        load8_f32(a.in[I_CAB] + 8 * lane, bb);
        if (MODE != 2) {
            v4u xr[11];
#pragma unroll
            for (int k = 0; k < 11; ++k) { const int t = chunk * 64 + wid * 8 - 3 + k;
                if (t >= 0) xr[k] = *(const v4u*)(XA + (size_t)(seq * SEQ + t) * DL + 8 * lane); else xr[k] = (v4u){0u, 0u, 0u, 0u}; }
#pragma unroll
            for (int it = 0; it < 8; ++it) {
                float s[8];
#pragma unroll
                for (int i = 0; i < 8; ++i) s[i] = bb[i];
#pragma unroll
                for (int j = 0; j < 4; ++j) { float x[8]; unpack8(xr[it + j], x);
#pragma unroll
                    for (int i = 0; i < 8; ++i) s[i] += w[j][i] * x[i]; }
                *(LAS v4u*)(lds + lane * LRU_CS + (wid * 8 + it) * 16) = pack8(s);
            }
        } else {
#pragma unroll 1
            for (int it = 0; it < 8; ++it) {
                const int tok = it * 8 + wid;
                float s[8];
#pragma unroll
                for (int i = 0; i < 8; ++i) s[i] = bb[i];
#pragma unroll
                for (int j = 0; j < 4; ++j) {
                    float x[8];
                    const int n = item * 16 + (tok >> 2), e = (tok & 3) + j;
                    if (e < 3) load8_f32(a.in[I_SCA] + (size_t)(n * 3 + e) * DL + 8 * lane, x); else load8_bf16(XA + (size_t)(MP + 4 * n + e - 3) * DL + 8 * lane, x);
#pragma unroll
                    for (int i = 0; i < 8; ++i) s[i] += w[j][i] * x[i];
                }
                *(LAS v4u*)(lds + lane * LRU_CS + tok * 16) = pack8(s);
            }
        }
    }
    __syncthreads();
    const int r32 = lane & 31, hi = lane >> 5;
    float hc0 = 0.f, hc1 = 0.f, At0 = 1.f, At1 = 1.f;
    if (MODE == 1) {
#pragma unroll 1
        for (int c0 = 0; c0 < chunk; c0 += 16) {
            float ca0[16], cb0[16], ca1[16], cb1[16];
#pragma unroll
            for (int u = 0; u < 16; ++u) { const int c = c0 + u; const size_t o = (size_t)(seq * 64 + (c < chunk ? c : 0)) * DL + 64 * g + r32;
                ca0[u] = AGGA[o]; cb0[u] = AGGB[o]; ca1[u] = AGGA[o + 32]; cb1[u] = AGGB[o + 32]; }
#pragma unroll
            for (int u = 0; u < 16; ++u) if (c0 + u < chunk) { hc0 = ca0[u] * hc0 + cb0[u]; hc1 = ca1[u] * hc1 + cb1[u]; }
        }
    }
#pragma unroll 1
    for (int mc = 0; mc < 4; ++mc) {
        const int mt = mc >> 1, ct = mc & 1;
        const int ch = 64 * g + 32 * ct + r32;
        float hcur = ct ? hc1 : hc0, Atc = ct ? At1 : At0;
        bf16x8 af[4];
#pragma unroll
        for (int ks = 0; ks < 4; ++ks) af[ks] = *(const LAS bf16x8*)(lds + (8 * g + 2 * ks + hi) * LRU_CS + (32 * mt + r32) * 16);
        f32x16 D[3];
        const bf16* wlp = WL + (size_t)((g * 192 + 32 * ct + r32) * 64 + 8 * hi);
#pragma unroll
        for (int o = 0; o < 3; ++o) {
            D[o] = f32x16{};
#pragma unroll
            for (int ks = 0; ks < 4; ++ks) {
                const bf16x8 bfr = *(const bf16x8*)(wlp + o * 64 * 64 + 16 * ks);
                D[o] = __builtin_amdgcn_mfma_f32_32x32x16_bf16(af[ks], bfr, D[o], 0, 0, 0);
            }
        }
        const float br = a.in[I_BR][ch], bi = a.in[I_BI][ch], c8 = C8[ch];
        float av[16], uv[16];
#pragma unroll
        for (int r = 0; r < 16; ++r) {
            const float rr = sigmoidf_(D[0][r] + br), gi = sigmoidf_(D[1][r] + bi);
            const float la = -c8 * rr; av[r] = __expf(la); uv[r] = __builtin_amdgcn_sqrtf(one_minus_exp(2.f * la)) * gi * D[2][r];
        }
        if (MODE == 2) {
#pragma unroll
            for (int k = 0; k < 4; ++k) {
                const int n = item * 16 + 8 * mt + 2 * k + hi;
                float hh = a.in[I_SLH][(size_t)n * DL + ch];
#pragma unroll
                for (int i = 0; i < 4; ++i) { hh = av[4 * k + i] * hh + uv[4 * k + i]; uv[4 * k + i] = hh; }
                a.out[O_SLH + (size_t)n * DL + ch] = hh;
            }
        } else {
#pragma unroll
            for (int k = 0; k < 4; ++k) {
                const float a0 = av[4 * k], a1 = av[4 * k + 1], a2 = av[4 * k + 2], a3 = av[4 * k + 3];
                const float GAm = (a0 * a1) * (a2 * a3), GBm = ((uv[4 * k] * a1 + uv[4 * k + 1]) * a2 + uv[4 * k + 2]) * a3 + uv[4 * k + 3];
                const float Ao = __shfl_xor(GAm, 32), Bo = __shfl_xor(GBm, 32);
                const float A1 = hi ? Ao : GAm, B1 = hi ? Bo : GBm, A2 = hi ? GAm : Ao, B2 = hi ? GBm : Bo;
                const float hin1 = hcur; hcur = A1 * hcur + B1; const float hin2 = hcur; hcur = A2 * hcur + B2; Atc *= A1 * A2;
                if (MODE == 1) { float hh = hi ? hin2 : hin1;
#pragma unroll
                    for (int i = 0; i < 4; ++i) { hh = av[4 * k + i] * hh + uv[4 * k + i]; uv[4 * k + i] = hh; } }
            }
        }
        if (MODE != 0) {
            const bf16* gap = GAb + (size_t)(row0 + 32 * mt + 4 * hi) * DL + ch; bf16* mxp = MIX + (size_t)(row0 + 32 * mt + 4 * hi) * DM + ch;
            bf16 gv[16];
#pragma unroll
            for (int r = 0; r < 16; ++r) gv[r] = gap[((r & 3) + 8 * (r >> 2)) * DL];
#pragma unroll
            for (int r = 0; r < 16; ++r) { const int ro = (r & 3) + 8 * (r >> 2); mxp[ro * DM] = (bf16)f2bf(uv[r] * gelu_tanh(bf2f(gv[r]))); }
        }
        if (ct) { hc1 = hcur; At1 = Atc; } else { hc0 = hcur; At0 = Atc; }
    }
#pragma unroll
    for (int ct = 0; ct < 2; ++ct) {
        const int ch = 64 * g + 32 * ct + r32; const float Af = ct ? At1 : At0, hf = ct ? hc1 : hc0;
        if (MODE == 0) { if (hi == 0) { AGGA[(size_t)(seq * 64 + chunk) * DL + ch] = Af; AGGB[(size_t)(seq * 64 + chunk) * DL + ch] = hf; } }
        if (MODE == 1) { if (chunk == 63 && hi == 0) a.out[O_PLH + (size_t)seq * DL + ch] = hf; }
    }
    __syncthreads();
}

constexpr int CW_LRUF = 16384;
constexpr int LRF_CS = 1024, LRF_GA = 64 * LRF_CS;
__device__ __forceinline__ void lru_fused_item(const Args& a, int item, LAS unsigned char* lds, int wid, int lane) {
    unsigned char* ws = a.ws;
    const bf16* XA = (const bf16*)(ws + WS_XA); const bf16* GAb = (const bf16*)(ws + WS_GA); const bf16* WL = (const bf16*)(ws + WS_WL);
    const float* C8 = (const float*)(ws + WS_C8); unsigned long long* AGG2 = (unsigned long long*)(ws + WS_AGGA); bf16* MIX = (bf16*)(ws + WS_MIX);
    unsigned* flags = (unsigned*)(ws + WS_CTL) + CW_LRUF;
    asm volatile("" : "+v"(lane));
    const int seq = item >> 6, chunk = item & 63, g = wid;
    const int row0 = seq * SEQ + chunk * 64;
    {
        float w[4][8], bb[8];
#pragma unroll
        for (int j = 0; j < 4; ++j) load8_f32(a.in[I_CAW] + j * DL + 8 * lane, w[j]);
        load8_f32(a.in[I_CAB] + 8 * lane, bb);
        v4u xr[11];
#pragma unroll
        for (int k = 0; k < 11; ++k) { const int t = chunk * 64 + wid * 8 - 3 + k;
            if (t >= 0) xr[k] = *(const v4u*)(XA + (size_t)(seq * SEQ + t) * DL + 8 * lane); else xr[k] = (v4u){0u, 0u, 0u, 0u}; }
#pragma unroll
        for (int it = 0; it < 8; ++it) {
            float s8[8];
#pragma unroll
            for (int i = 0; i < 8; ++i) s8[i] = bb[i];
#pragma unroll
            for (int j = 0; j < 4; ++j) { float x[8]; unpack8(xr[it + j], x);
#pragma unroll
                for (int i = 0; i < 8; ++i) s8[i] += w[j][i] * x[i]; }
            *(LAS v4u*)(lds + lane * LRF_CS + (wid * 8 + it) * 16) = pack8(s8);
        }
#pragma unroll
        for (int it = 0; it < 8; ++it) xr[it] = *(const v4u*)(GAb + (size_t)(row0 + wid * 8 + it) * DL + 8 * lane);
#pragma unroll
        for (int it = 0; it < 8; ++it) *(LAS v4u*)(lds + LRF_GA + (wid * 8 + it) * 1024 + lane * 16) = xr[it];
    }
    __syncthreads();
    int r32 = lane & 31, hi = lane >> 5;
    unsigned pk[4][16];
    float At0 = 1.f, At1 = 1.f, Bt0 = 0.f, Bt1 = 0.f;
    bf16x8 bw[2][4];
#pragma unroll
    for (int mc = 0; mc < 4; ++mc) {
        const int ct = mc >> 1, mt = mc & 1;
        if (mt == 0) {
#pragma unroll
            for (int o = 0; o < 2; ++o)
#pragma unroll
                for (int ks = 0; ks < 4; ++ks) bw[o][ks] = *(const bf16x8*)(WL + (size_t)((g * 192 + 64 * o + 32 * ct + r32) * 64 + 16 * ks + 8 * hi));
        }
        const int ch = 64 * g + 32 * ct + r32;
        bf16x8 af[4];
#pragma unroll
        for (int ks = 0; ks < 4; ++ks) af[ks] = *(const LAS bf16x8*)(lds + (8 * g + 2 * ks + hi) * LRF_CS + (32 * mt + r32) * 16);
        f32x16 D[3];
#pragma unroll
        for (int o = 0; o < 2; ++o) {
            D[o] = f32x16{};
#pragma unroll
            for (int ks = 0; ks < 4; ++ks) D[o] = __builtin_amdgcn_mfma_f32_32x32x16_bf16(af[ks], bw[o][ks], D[o], 0, 0, 0);
        }
        {
            const LAS unsigned short* xp = (const LAS unsigned short*)(lds + (8 * g + 4 * ct + (r32 >> 3)) * LRF_CS + (32 * mt + 4 * hi) * 16 + (r32 & 7) * 2);
#pragma unroll
            for (int r = 0; r < 16; ++r) D[2][r] = bf2f(xp[((r & 3) + 8 * (r >> 2)) * 8]);
        }
        const float br = a.in[I_BR][ch], bi = a.in[I_BI][ch], c8 = C8[ch];
#pragma unroll
        for (int r = 0; r < 16; ++r) {
            const float rr = sigmoidf_(D[0][r] + br), gi = sigmoidf_(D[1][r] + bi);
            const float la = -c8 * rr, oma = one_minus_exp(la); pk[2 * mt + ct][r] = pk2(oma, __builtin_amdgcn_sqrtf(oma * (2.f - oma)) * gi * D[2][r]);
        }
        float Atc = ct ? At1 : At0, Btc = ct ? Bt1 : Bt0;
#pragma unroll
        for (int k = 0; k < 4; ++k) {
            const float a0 = 1.f - bflo(pk[2 * mt + ct][4 * k]), a1 = 1.f - bflo(pk[2 * mt + ct][4 * k + 1]), a2 = 1.f - bflo(pk[2 * mt + ct][4 * k + 2]), a3 = 1.f - bflo(pk[2 * mt + ct][4 * k + 3]);
            const float GAm = (a0 * a1) * (a2 * a3), GBm = ((bfhi(pk[2 * mt + ct][4 * k]) * a1 + bfhi(pk[2 * mt + ct][4 * k + 1])) * a2 + bfhi(pk[2 * mt + ct][4 * k + 2])) * a3 + bfhi(pk[2 * mt + ct][4 * k + 3]);
            const float Ao = __shfl_xor(GAm, 32), Bo = __shfl_xor(GBm, 32);
            const float A1 = hi ? Ao : GAm, B1 = hi ? Bo : GBm, A2 = hi ? GAm : Ao, B2 = hi ? GBm : Bo;
            Btc = A1 * Btc + B1; Btc = A2 * Btc + B2; Atc *= A1 * A2;
        }
        if (ct) { At1 = Atc; Bt1 = Btc; } else { At0 = Atc; Bt0 = Btc; }
        asm volatile("" ::: "memory");
    }
    if (hi == 0) {
        __hip_atomic_store(AGG2 + (size_t)(seq * 64 + chunk) * DL + 64 * g + r32, ((unsigned long long)__float_as_uint(Bt0) << 32) | __float_as_uint(At0), __ATOMIC_RELAXED, __HIP_MEMORY_SCOPE_AGENT);
        __hip_atomic_store(AGG2 + (size_t)(seq * 64 + chunk) * DL + 64 * g + 32 + r32, ((unsigned long long)__float_as_uint(Bt1) << 32) | __float_as_uint(At1), __ATOMIC_RELAXED, __HIP_MEMORY_SCOPE_AGENT);
    }
    asm volatile("s_waitcnt vmcnt(0)" ::: "memory");
    if (lane == 0) __hip_atomic_store(flags + (size_t)((seq * 64 + chunk) * 8 + g) * 16, 1u, __ATOMIC_RELAXED, __HIP_MEMORY_SCOPE_AGENT);
    {
        const unsigned* fp = flags + (size_t)((seq * 64 + (lane < chunk ? lane : 0)) * 8 + g) * 16;
        unsigned spins = 0;
        for (;;) {
            const unsigned v = (lane < chunk) ? __hip_atomic_load(fp, __ATOMIC_RELAXED, __HIP_MEMORY_SCOPE_AGENT) : 1u;
            if (__all(v != 0u)) break;
            if (++spins > (1u << 20)) break;
            __builtin_amdgcn_s_sleep(2);
        }
        asm volatile("" ::: "memory");
    }
    float hc0, hc1;
    {
        const int cmid = chunk >> 1, cb = hi ? cmid : 0, ce = hi ? chunk : cmid;
        float A0 = 1.f, B0 = 0.f, A1 = 1.f, B1 = 0.f;
#pragma unroll 1
        for (int c0 = cb; c0 < ce; c0 += 12) {
            unsigned long long p0[12], p1[12];
#pragma unroll
            for (int u = 0; u < 12; ++u) { const int c = c0 + u; const size_t o = (size_t)(seq * 64 + (c < ce ? c : cb)) * DL + 64 * g + r32;
                p0[u] = __hip_atomic_load(AGG2 + o, __ATOMIC_RELAXED, __HIP_MEMORY_SCOPE_AGENT); p1[u] = __hip_atomic_load(AGG2 + o + 32, __ATOMIC_RELAXED, __HIP_MEMORY_SCOPE_AGENT); }
#pragma unroll
            for (int u = 0; u < 12; ++u) if (c0 + u < ce) {
                const float a0 = __uint_as_float((unsigned)p0[u]), b0 = __uint_as_float((unsigned)(p0[u] >> 32)), a1 = __uint_as_float((unsigned)p1[u]), b1 = __uint_as_float((unsigned)(p1[u] >> 32));
                B0 = a0 * B0 + b0; A0 *= a0; B1 = a1 * B1 + b1; A1 *= a1; }
        }
        const float Bl0 = __shfl_xor(B0, 32), Bl1 = __shfl_xor(B1, 32);
        const float lo0 = hi ? Bl0 : B0, lo1 = hi ? Bl1 : B1;
        const float Ah0 = __shfl_xor(A0, 32), Ah1 = __shfl_xor(A1, 32);
        const float uA0 = hi ? A0 : Ah0, uA1 = hi ? A1 : Ah1, uB0 = hi ? B0 : Bl0, uB1 = hi ? B1 : Bl1;
        hc0 = uA0 * lo0 + uB0; hc1 = uA1 * lo1 + uB1;
    }
#pragma unroll
    for (int mc = 0; mc < 4; ++mc) {
        const int mt = mc >> 1, ct = mc & 1;
        asm volatile("" : "+v"(r32), "+v"(hi));
        const int ch = 64 * g + 32 * ct + r32;
        float hcur = ct ? hc1 : hc0;
        LAS unsigned short* gy = (LAS unsigned short*)(lds + LRF_GA + (32 * mt + 4 * hi) * 1024 + (32 * ct + 64 * g + r32) * 2);
#pragma unroll
        for (int k = 0; k < 4; ++k) {
            const float a0 = 1.f - bflo(pk[mc][4 * k]), a1 = 1.f - bflo(pk[mc][4 * k + 1]), a2 = 1.f - bflo(pk[mc][4 * k + 2]), a3 = 1.f - bflo(pk[mc][4 * k + 3]);
            const float GAm = (a0 * a1) * (a2 * a3), GBm = ((bfhi(pk[mc][4 * k]) * a1 + bfhi(pk[mc][4 * k + 1])) * a2 + bfhi(pk[mc][4 * k + 2])) * a3 + bfhi(pk[mc][4 * k + 3]);
            const float Ao = __shfl_xor(GAm, 32), Bo = __shfl_xor(GBm, 32);
            const float A1 = hi ? Ao : GAm, B1 = hi ? Bo : GBm, A2 = hi ? GAm : Ao, B2 = hi ? GBm : Bo;
            const float hin1 = hcur; hcur = A1 * hcur + B1; const float hin2 = hcur; hcur = A2 * hcur + B2;
            float hh = hi ? hin2 : hin1;
#pragma unroll
            for (int i = 0; i < 4; ++i) { hh = (1.f - bflo(pk[mc][4 * k + i])) * hh + bfhi(pk[mc][4 * k + i]); pk[mc][4 * k + i] = __float_as_uint(hh); }
        }
#pragma unroll
        for (int r = 0; r < 16; ++r) { const int ro = (r & 3) + 8 * (r >> 2); gy[ro * 512] = (unsigned short)(pk2(__uint_as_float(pk[mc][r]) * gelu_tanh(bf2f(gy[ro * 512])), 0.f) & 0xffffu); }
        if (ct) hc1 = hcur; else hc0 = hcur;
        asm volatile("" ::: "memory");
    }
    __syncthreads();
    {
        const int tid_ = wid * 64 + lane;
#pragma unroll
        for (int i = 0; i < 8; ++i) { const int pc = tid_ + NTHR * i, tok = pc >> 6, c16 = pc & 63;
            *(v4u*)(MIX + (size_t)(row0 + tok) * DM + c16 * 8) = *(const LAS v4u*)(lds + LRF_GA + tok * 1024 + c16 * 16); }
    }
    if (chunk == 63 && hi == 0) { a.out[O_PLH + (size_t)seq * DL + 64 * g + r32] = hc0; a.out[O_PLH + (size_t)seq * DL + 64 * g + 32 + r32] = hc1; }
    __syncthreads();
}

constexpr int NK = 384, KCS = NK * 16 + 16, VDS = NK * 64 + 64, ATT_K = 0, ATT_V = 8 * KCS, ATT_WS = ATT_V + 2 * VDS;
static_assert(ATT_WS + NWAVES * 256 <= RING_BYTES, "attention LDS");
__device__ __forceinline__ s16x4 vtr(const LAS unsigned char* p) { typedef short v4i16_t __attribute__((ext_vector_type(4))); return __builtin_bit_cast(s16x4, __builtin_amdgcn_ds_read_tr16_b64_v4i16((LAS v4i16_t*)p)); }

__device__ __forceinline__ void attn_prompt_unit(const Args& a, int unit, LAS unsigned char* lds, int tid, int wid, int lane) {
    unsigned char* ws = a.ws;
    const bf16* Qb = (const bf16*)(ws + WS_Q); const bf16* Kb = (const bf16*)(ws + WS_K); const bf16* Vb = (const bf16*)(ws + WS_V);
    bf16* OP = (bf16*)(ws + WS_OP); float* LSE = (float*)(ws + WS_LSE);
    const int u16 = unit & 15, p = (unit >> 4) % 3, bh = unit / 48, b = bh >> 3, h = bh & 7;
    const int ld = 2 * p, d = 1 << ld;
    const int lnb = 4 - ld, blk = u16 & ((1 << lnb) - 1), r = u16 >> lnb;
    const int j0 = 256 * blk - 128;
    const int kk_min = (blk == 0) ? 128 : 0;
    const size_t rowb = (size_t)b * SEQ;
#pragma unroll
    for (int i = 0; i < 6; ++i) {
        const int piece = tid + NTHR * i, kk = piece >> 3, c = piece & 7;
        if (kk >= kk_min) {
            const size_t row = rowb + (size_t)(r + d * (j0 + kk));
            const v4u kv = *(const v4u*)(Kb + row * 512 + h * 64 + c * 8), vv = *(const v4u*)(Vb + row * 512 + h * 64 + c * 8);
            *(LAS v4u*)(lds + ATT_K + c * KCS + kk * 16) = kv;
            *(LAS v4u*)(lds + ATT_V + (c >> 2) * VDS + kk * 64 + (c & 3) * 16) = vv;
        }
    }
    const int r32 = lane & 31, hi = lane >> 5;
    bf16x8 qr[4];
    { const size_t qrow = rowb + (size_t)(r + d * (256 * blk + 32 * wid + r32));
#pragma unroll
      for (int ks = 0; ks < 4; ++ks) qr[ks] = *(const bf16x8*)(Qb + qrow * 512 + h * 64 + 16 * ks + 8 * hi); }
    __syncthreads();
    const int kt0 = (blk == 0 && wid < 4) ? 4 - wid : 0;
    f32x16 pt[5];
#pragma unroll
    for (int kt = 0; kt < 5; ++kt) {
        if (kt >= kt0) {
            const int T = wid + kt; f32x16 acc = f32x16{};
#pragma unroll
            for (int ks = 0; ks < 4; ++ks) { const bf16x8 kf = *(const LAS bf16x8*)(lds + ATT_K + (2 * ks + hi) * KCS + (32 * T + r32) * 16);
                acc = __builtin_amdgcn_mfma_f32_32x32x16_bf16(kf, qr[ks], acc, 0, 0, 0); }
            if (kt == 0) {
#pragma unroll
                for (int rg = 0; rg < 16; ++rg) if (crow(rg, hi) < r32) acc[rg] = -INFINITY; }
            if (kt == 4) {
#pragma unroll
                for (int rg = 0; rg < 16; ++rg) if (crow(rg, hi) > r32) acc[rg] = -INFINITY; }
            pt[kt] = acc;
        } else {
#pragma unroll
            for (int rg = 0; rg < 16; ++rg) pt[kt][rg] = -INFINITY;
        }
    }
    float mx = -INFINITY;
#pragma unroll
    for (int kt = 0; kt < 5; ++kt)
#pragma unroll
        for (int rg = 0; rg < 16; ++rg) mx = fmaxf(mx, pt[kt][rg]);
    mx = fmaxf(mx, __shfl_xor(mx, 32));
    float lsum = 0.f;
#pragma unroll
    for (int kt = 0; kt < 5; ++kt)
#pragma unroll
        for (int rg = 0; rg < 16; ++rg) { const float e = __builtin_amdgcn_exp2f(pt[kt][rg] - mx); pt[kt][rg] = e; lsum += e; }
    lsum += __shfl_xor(lsum, 32);
    f32x16 o[2]; o[0] = f32x16{}; o[1] = f32x16{};
    const LAS unsigned char* vb = lds + ATT_V + ((lane >> 4) & 1) * 32 + (lane & 3) * 8 + (4 * hi + ((lane & 15) >> 2)) * 64;
#pragma unroll
    for (int kt = 0; kt < 5; ++kt) {
        if (kt >= kt0) {
            const int T = wid + kt;
#pragma unroll
            for (int s = 0; s < 2; ++s) {
                v4u pw; pw.x = pg8::cvt_pk_bf16(pt[kt][8 * s], pt[kt][8 * s + 1]); pw.y = pg8::cvt_pk_bf16(pt[kt][8 * s + 2], pt[kt][8 * s + 3]);
                pw.z = pg8::cvt_pk_bf16(pt[kt][8 * s + 4], pt[kt][8 * s + 5]); pw.w = pg8::cvt_pk_bf16(pt[kt][8 * s + 6], pt[kt][8 * s + 7]);
                const bf16x8 pa = __builtin_bit_cast(bf16x8, pw);
#pragma unroll
                for (int d0 = 0; d0 < 2; ++d0) {
                    const LAS unsigned char* vp = vb + d0 * VDS + (32 * T + 16 * s) * 64;
                    const s16x4 lo = vtr(vp), hh = vtr(vp + 512);
                    const bf16x8 vf = (bf16x8){lo[0], lo[1], lo[2], lo[3], hh[0], hh[1], hh[2], hh[3]};
                    o[d0] = __builtin_amdgcn_mfma_f32_32x32x16_bf16(pa, vf, o[d0], 0, 0, 0);
                }
            }
        }
    }
    LAS float* wsf = (LAS float*)(lds + ATT_WS) + wid * 64;
    if (hi == 0) wsf[r32] = __builtin_amdgcn_rcpf(lsum);
    const size_t qrow_l = rowb + (size_t)(r + d * (256 * blk + 32 * wid + r32));
    if (hi == 0) LSE[((size_t)p * MP + qrow_l) * 8 + h] = mx + __builtin_amdgcn_logf(lsum);
    LDS_WAIT(); asm volatile("" ::: "memory");
#pragma unroll
    for (int rg = 0; rg < 16; ++rg) {
        const int qi = crow(rg, hi); const float rl = wsf[qi];
        const size_t orow = rowb + (size_t)(r + d * (256 * blk + 32 * wid + qi));
        bf16* op = OP + ((size_t)p * MP + orow) * 512 + h * 64 + r32;
        { const unsigned w2 = pk2(o[0][rg] * rl, o[1][rg] * rl); op[0] = (bf16)(w2 & 0xffffu); op[32] = (bf16)(w2 >> 16); }
    }
    __syncthreads();
}

constexpr int AP_K = 0, AP_KCS = NK * 16, AP_V = 8 * AP_KCS, AP_VDS = NK * 64, AP_VBUF = 2 * AP_VDS, AP_WS = AP_V + 2 * AP_VBUF;
static_assert(AP_WS + NWAVES * 256 <= LDSCTL_OFF, "pipelined attention LDS");
struct APUnit { int b, h, p, d, r, blk; };
__device__ __forceinline__ APUnit ap_decode(int unit) { APUnit u; const int u16 = unit & 15; u.p = (unit >> 4) % 3; const int bh = unit / 48; u.b = bh >> 3; u.h = bh & 7;
    const int ld = 2 * u.p; u.d = 1 << ld; const int lnb = 4 - ld; u.blk = u16 & ((1 << lnb) - 1); u.r = u16 >> lnb; return u; }
__device__ __forceinline__ void ap_issue_k(const APUnit& u, const bf16* Kb, LAS unsigned char* lds, int wid, int lane) {
#pragma unroll
    for (int i = 0; i < 6; ++i) { const int j = wid + 8 * i, c = j & 7, kb = j >> 3;
        if (u.blk == 0 && kb < 2) continue;
        const size_t row = (size_t)u.b * SEQ + (size_t)(u.r + u.d * (256 * u.blk - 128 + 64 * kb + lane));
        __builtin_amdgcn_global_load_lds((const unsigned*)(Kb + row * 512 + u.h * 64 + c * 8), (LAS unsigned*)(lds + AP_K + c * AP_KCS + kb * 1024), 16, 0, 0); }
}
__device__ __forceinline__ void ap_issue_v(const APUnit& u, const bf16* Vb, LAS unsigned char* lds, int vbuf, int wid, int lane) {
#pragma unroll
    for (int i = 0; i < 6; ++i) { const int j = wid + 8 * i, dh = j & 1, kb16 = j >> 1;
        if (u.blk == 0 && kb16 < 8) continue;
        const size_t row = (size_t)u.b * SEQ + (size_t)(u.r + u.d * (256 * u.blk - 128 + 16 * kb16 + (lane >> 2)));
        __builtin_amdgcn_global_load_lds((const unsigned*)(Vb + row * 512 + u.h * 64 + dh * 32 + (lane & 3) * 8), (LAS unsigned*)(lds + AP_V + vbuf * AP_VBUF + dh * AP_VDS + kb16 * 1024), 16, 0, 0); }
}
__device__ __forceinline__ void ap_load_q(const APUnit& u, const bf16* Qb, bf16x8 (&qr)[4], int wid, int lane) {
    const int r32 = lane & 31, hi = lane >> 5;
    const size_t qrow = (size_t)u.b * SEQ + (size_t)(u.r + u.d * (256 * u.blk + 32 * wid + r32));
#pragma unroll
    for (int ks = 0; ks < 4; ++ks) qr[ks] = *(const bf16x8*)(Qb + qrow * 512 + u.h * 64 + 16 * ks + 8 * hi);
}
__device__ __forceinline__ void attn_prompt_phase(const Args& a, LAS unsigned char* lds, int bx, int G, int n_units, int tid, int wid, int lane) {
    unsigned char* ws = a.ws;
    const bf16* Qb = (const bf16*)(ws + WS_Q); const bf16* Kb = (const bf16*)(ws + WS_K); const bf16* Vb = (const bf16*)(ws + WS_V);
    bf16* OP = (bf16*)(ws + WS_OP); float* LSE = (float*)(ws + WS_LSE);
    const int r32 = lane & 31, hi = lane >> 5;
    if (bx >= n_units) return;
    APUnit cur = ap_decode(bx);
    bf16x8 qn[4];
    ap_issue_k(cur, Kb, lds, wid, lane); ap_issue_v(cur, Vb, lds, 0, wid, lane); ap_load_q(cur, Qb, qn, wid, lane);
    int vb_i = 0;
#pragma unroll 1
    for (int unit = bx; unit < n_units; unit += G, vb_i ^= 1) {
        const bool has_next = unit + G < n_units;
        APUnit nxt = cur; if (has_next) nxt = ap_decode(unit + G);
        asm volatile("s_waitcnt vmcnt(0)" ::: "memory"); __syncthreads();
        if (has_next) ap_issue_v(nxt, Vb, lds, vb_i ^ 1, wid, lane);
        bf16x8 qr[4];
#pragma unroll
        for (int ks = 0; ks < 4; ++ks) qr[ks] = qn[ks];
        const int kt0 = (cur.blk == 0 && wid < 4) ? 4 - wid : 0;
        f32x16 pt[5];
#pragma unroll
        for (int kt = 0; kt < 5; ++kt) {
            if (kt >= kt0) {
                const int T = wid + kt; f32x16 acc = f32x16{};
#pragma unroll
                for (int ks = 0; ks < 4; ++ks) { const bf16x8 kf = *(const LAS bf16x8*)(lds + AP_K + (2 * ks + hi) * AP_KCS + (32 * T + r32) * 16);
                    acc = __builtin_amdgcn_mfma_f32_32x32x16_bf16(kf, qr[ks], acc, 0, 0, 0); }
                if (kt == 0) {
#pragma unroll
                    for (int rg = 0; rg < 16; ++rg) if (crow(rg, hi) < r32) acc[rg] = -INFINITY; }
                if (kt == 4) {
#pragma unroll
                    for (int rg = 0; rg < 16; ++rg) if (crow(rg, hi) > r32) acc[rg] = -INFINITY; }
                pt[kt] = acc;
            } else {
#pragma unroll
                for (int rg = 0; rg < 16; ++rg) pt[kt][rg] = -INFINITY;
            }
        }
        asm volatile("s_waitcnt lgkmcnt(0)" ::: "memory"); __syncthreads();
        if (has_next) { ap_issue_k(nxt, Kb, lds, wid, lane); ap_load_q(nxt, Qb, qn, wid, lane); }
        float mx = -INFINITY;
#pragma unroll
        for (int kt = 0; kt < 5; ++kt)
#pragma unroll
            for (int rg = 0; rg < 16; ++rg) mx = fmaxf(mx, pt[kt][rg]);
        mx = fmaxf(mx, __shfl_xor(mx, 32));
        float lsum = 0.f;
#pragma unroll
        for (int kt = 0; kt < 5; ++kt)
#pragma unroll
            for (int rg = 0; rg < 16; ++rg) { const float e = __builtin_amdgcn_exp2f(pt[kt][rg] - mx); pt[kt][rg] = e; lsum += e; }
        lsum += __shfl_xor(lsum, 32);
        f32x16 o[2]; o[0] = f32x16{}; o[1] = f32x16{};
        const LAS unsigned char* vb = lds + AP_V + vb_i * AP_VBUF + ((lane >> 4) & 1) * 32 + (lane & 3) * 8 + (4 * hi + ((lane & 15) >> 2)) * 64;
#pragma unroll
        for (int kt = 0; kt < 5; ++kt) {
            if (kt >= kt0) {
                const int T = wid + kt;
#pragma unroll
                for (int s2 = 0; s2 < 2; ++s2) {
                    v4u pw; pw.x = pg8::cvt_pk_bf16(pt[kt][8 * s2], pt[kt][8 * s2 + 1]); pw.y = pg8::cvt_pk_bf16(pt[kt][8 * s2 + 2], pt[kt][8 * s2 + 3]);
                    pw.z = pg8::cvt_pk_bf16(pt[kt][8 * s2 + 4], pt[kt][8 * s2 + 5]); pw.w = pg8::cvt_pk_bf16(pt[kt][8 * s2 + 6], pt[kt][8 * s2 + 7]);
                    const bf16x8 pa = __builtin_bit_cast(bf16x8, pw);
#pragma unroll
                    for (int d0 = 0; d0 < 2; ++d0) {
                        const LAS unsigned char* vp = vb + d0 * AP_VDS + (32 * T + 16 * s2) * 64;
                        const s16x4 lo = vtr(vp), hh = vtr(vp + 512);
                        const bf16x8 vf = (bf16x8){lo[0], lo[1], lo[2], lo[3], hh[0], hh[1], hh[2], hh[3]};
                        o[d0] = __builtin_amdgcn_mfma_f32_32x32x16_bf16(pa, vf, o[d0], 0, 0, 0);
                    }
                }
            }
        }
        LAS float* wsf = (LAS float*)(lds + AP_WS) + wid * 64;
        if (hi == 0) wsf[r32] = __builtin_amdgcn_rcpf(lsum);
        const size_t rowb = (size_t)cur.b * SEQ;
        const size_t qrow_l = rowb + (size_t)(cur.r + cur.d * (256 * cur.blk + 32 * wid + r32));
        if (hi == 0) LSE[((size_t)cur.p * MP + qrow_l) * 8 + cur.h] = mx + __builtin_amdgcn_logf(lsum);
        LDS_WAIT(); asm volatile("" ::: "memory");
#pragma unroll
        for (int rg = 0; rg < 16; ++rg) {
            const int qi = crow(rg, hi); const float rl = wsf[qi];
            const size_t orow = rowb + (size_t)(cur.r + cur.d * (256 * cur.blk + 32 * wid + qi));
            bf16* op = OP + ((size_t)cur.p * MP + orow) * 512 + cur.h * 64 + r32;
            { const unsigned w2 = pk2(o[0][rg] * rl, o[1][rg] * rl); op[0] = (bf16)(w2 & 0xffffu); op[32] = (bf16)(w2 >> 16); }
        }
        cur = nxt;
    }
    asm volatile("s_waitcnt vmcnt(0) lgkmcnt(0)" ::: "memory"); __syncthreads();
}

__device__ __forceinline__ void attn_sample_item(const Args& a, int item, LAS unsigned char* lds, int tid, int wid, int lane) {
    unsigned char* ws = a.ws;
    const float* QS = (const float*)(ws + WS_QS); bf16* MIX = (bf16*)(ws + WS_MIX);
    const float* CK = a.in[I_CK]; const float* CV = a.in[I_CV];
    asm volatile("" : "+v"(lane));
    const int n = item >> 3, h = item & 7, sub = lane & 15, grp = lane >> 4;
    f32x4 q[4];
#pragma unroll
    for (int s = 0; s < 4; ++s) q[s] = *(const f32x4*)(QS + (size_t)(4 * n + s) * 512 + h * 64 + 4 * sub);
    float m[4], l[4]; f32x4 O[4];
#pragma unroll
    for (int s = 0; s < 4; ++s) { m[s] = -1e30f; l[s] = 0.f; O[s] = (f32x4){0.f, 0.f, 0.f, 0.f}; }
#define SA_ROW(t_) (((t_) < 16) ? 1536 + (t_) * 32 + wid * 4 + grp : 16 * ((((t_) - 16) * 32 + wid * 4 + grp) >> 2) + (grp & 3))
#define SA_OFF(idx_) ((((size_t)n * 2048 + (idx_)) * 8 + h) * 64 + 4 * sub)
    const f32x4 qo = grp == 0 ? q[0] : grp == 1 ? q[1] : grp == 2 ? q[2] : q[3];
    const float cown = (wid & 3) == 0 ? 2.f : 1.f;
    float mo = -1e30f, lo = 0.f; f32x4 Oo = (f32x4){0.f, 0.f, 0.f, 0.f};
    LAS unsigned char* ring = lds + wid * 16384;
#define SA_DMA(j_) do { const int t_ = (j_) < 12 ? (j_) : (j_) + 4; const size_t o_ = SA_OFF(SA_ROW(t_)); \
        __builtin_amdgcn_global_load_lds((const unsigned*)(CK + o_), (LAS unsigned*)(ring + ((j_) & 7) * 2048), 16, 0, 2); \
        __builtin_amdgcn_global_load_lds((const unsigned*)(CV + o_), (LAS unsigned*)(ring + ((j_) & 7) * 2048 + 1024), 16, 0, 2); } while (0)
#pragma unroll
    for (int j = 0; j < 8; ++j) SA_DMA(j);
#define SA_GEN(NU, kv, vv, idxs) do { float d[NU][4]; int c[NU][4]; \
        _Pragma("unroll") for (int u = 0; u < NU; ++u) { const int idx = idxs[u]; \
            _Pragma("unroll") for (int s = 0; s < 4; ++s) { \
                float dt = (q[s][0] * kv[u][0] + q[s][1] * kv[u][1]) + (q[s][2] * kv[u][2] + q[s][3] * kv[u][3]); \
                dt += dpp_f(dt, 0xB1); dt += dpp_f(dt, 0x4E); dt += dpp_f(dt, 0x141); dt += dpp_f(dt, 0x140); \
                int cc; \
                if (idx < 2048) cc = (idx >= 1920 + s ? 1 : 0) + ((idx >= 1536 && (idx & 3) == s) ? 1 : 0) + ((idx & 15) == s ? 1 : 0); \
                else { const int sp = idx - 2048; cc = (s >= sp ? 1 : 0) + (s == sp ? 2 : 0); } \
                if (idx < 0) cc = 0; \
                d[u][s] = dt; c[u][s] = cc; } } \
        _Pragma("unroll") for (int s = 0; s < 4; ++s) { float mn = m[s]; \
            _Pragma("unroll") for (int u = 0; u < NU; ++u) mn = c[u][s] > 0 ? fmaxf(mn, d[u][s]) : mn; \
            const float sc = __builtin_amdgcn_exp2f(m[s] - mn); l[s] *= sc; O[s] = O[s] * sc; m[s] = mn; \
            _Pragma("unroll") for (int u = 0; u < NU; ++u) { const float pe = (float)c[u][s] * __builtin_amdgcn_exp2f(fminf(d[u][s] - mn, 0.f)); l[s] += pe; O[s] = O[s] + vv[u] * pe; } } } while (0)
    {
        f32x4 kv[4], vv[4]; int idxs[4];
#pragma unroll
        for (int u = 0; u < 4; ++u) { idxs[u] = SA_ROW(12 + u); const size_t o_ = SA_OFF(idxs[u]); kv[u] = *(const f32x4*)(CK + o_); vv[u] = *(const f32x4*)(CV + o_); }
        f32x4 kn[1], vn[1]; int idn[1];
        { const size_t o_ = (size_t)(n * 4 + grp) * 512 + h * 64 + 4 * sub; kn[0] = *(const f32x4*)(a.out + O_SWK + o_); vn[0] = *(const f32x4*)(a.out + O_SWV + o_); idn[0] = wid == 0 ? 2048 + grp : -1; }
        SA_GEN(4, kv, vv, idxs);
        asm volatile("" ::: "memory");
        SA_GEN(1, kn, vn, idn);
    }
#pragma unroll 1
    for (int b = 0; b < 6; ++b) {
        f32x4 kv[4], vv[4];
#pragma unroll
        for (int u = 0; u < 4; ++u) { const int j = 4 * b + u;
            asm volatile("s_waitcnt vmcnt(14)" ::: "memory");
            kv[u] = *(const LAS f32x4*)(ring + (j & 7) * 2048 + lane * 16); vv[u] = *(const LAS f32x4*)(ring + (j & 7) * 2048 + 1024 + lane * 16);
            asm volatile("s_waitcnt lgkmcnt(0)" ::: "memory");
            SA_DMA(j + 8 < 24 ? j + 8 : 23); }
        const float cm = b < 3 ? cown : 1.f;
        float d[4];
#pragma unroll
        for (int u = 0; u < 4; ++u) { float dt = (qo[0] * kv[u][0] + qo[1] * kv[u][1]) + (qo[2] * kv[u][2] + qo[3] * kv[u][3]);
            dt += dpp_f(dt, 0xB1); dt += dpp_f(dt, 0x4E); dt += dpp_f(dt, 0x141); dt += dpp_f(dt, 0x140); d[u] = dt; }
        const float mn = fmaxf(fmaxf(mo, fmaxf(d[0], d[1])), fmaxf(d[2], d[3]));
        const float sc = __builtin_amdgcn_exp2f(mo - mn); lo *= sc; Oo = Oo * sc; mo = mn;
#pragma unroll
        for (int u = 0; u < 4; ++u) { const float pe = cm * __builtin_amdgcn_exp2f(d[u] - mn); lo += pe; Oo = Oo + vv[u] * pe; }
    }
    asm volatile("s_waitcnt vmcnt(0)" ::: "memory");
#undef SA_DMA
#define SA_LD4(x)
#undef SA_LD4
#pragma unroll
    for (int s = 0; s < 4; ++s) if (grp == s) { const float mn = fmaxf(m[s], mo), sa = __builtin_amdgcn_exp2f(m[s] - mn), sb = __builtin_amdgcn_exp2f(mo - mn); l[s] = l[s] * sa + lo * sb; O[s] = O[s] * sa + Oo * sb; m[s] = mn; }
#undef SA_GEN
#undef SA_ROW
#undef SA_OFF
#pragma unroll
    for (int s = 0; s < 4; ++s)
#pragma unroll
        for (int off = 16; off <= 32; off <<= 1) {
            const float mo = __shfl_xor(m[s], off), lo = __shfl_xor(l[s], off);
            f32x4 Oo; Oo[0] = __shfl_xor(O[s][0], off); Oo[1] = __shfl_xor(O[s][1], off); Oo[2] = __shfl_xor(O[s][2], off); Oo[3] = __shfl_xor(O[s][3], off);
            const float mn = fmaxf(m[s], mo); const float sa = (m[s] == mn) ? 1.f : __builtin_amdgcn_exp2f(m[s] - mn), sb = (mo == mn) ? 1.f : __builtin_amdgcn_exp2f(mo - mn);
            l[s] = l[s] * sa + lo * sb; O[s] = O[s] * sa + Oo * sb; m[s] = mn;
        }
    LAS float* red = (LAS float*)(lds + 131072);
    if (grp == 0) {
#pragma unroll
        for (int s = 0; s < 4; ++s) { LAS float* rp = red + (wid * 4 + s) * 68; *(LAS f32x4*)(rp + 4 * sub) = O[s]; if (sub == 0) { rp[64] = m[s]; rp[65] = l[s]; } }
    }
    __syncthreads();
    if (tid < 256) { const int s = tid >> 6, dim = tid & 63; float mm = -1e30f;
#pragma unroll
        for (int w = 0; w < 8; ++w) mm = fmaxf(mm, red[(w * 4 + s) * 68 + 64]);
        float L = 0.f, Ov = 0.f;
#pragma unroll
        for (int w = 0; w < 8; ++w) { const LAS float* rp = red + (w * 4 + s) * 68; const float mw = rp[64]; const float f = __builtin_amdgcn_exp2f(mw - mm); L += rp[65] * f; Ov += rp[dim] * f; }
        MIX[(size_t)(MP + 4 * n + s) * DM + 512 + h * 64 + dim] = (bf16)f2bf(Ov / L); }
    __syncthreads();
}

__device__ __forceinline__ void combine_item(const Args& a, int item, int tid) {
    unsigned char* ws = a.ws;
    const bf16* OP = (const bf16*)(ws + WS_OP); const float* LSE = (const float*)(ws + WS_LSE); bf16* MIX = (bf16*)(ws + WS_MIX);
#pragma unroll 1
    for (int i0 = 0; i0 < 8; i0 += 4) {
        float l[4][3]; v4u xw[4][3];
#pragma unroll
        for (int i = 0; i < 4; ++i) { const int e = tid + NTHR * (i0 + i), row = item * 64 + (e >> 6), hc = e & 63, h = hc >> 3;
#pragma unroll
            for (int p = 0; p < 3; ++p) { l[i][p] = LSE[((size_t)p * MP + row) * 8 + h]; xw[i][p] = *(const v4u*)(OP + ((size_t)p * MP + row) * 512 + hc * 8); } }
#pragma unroll
        for (int i = 0; i < 4; ++i) { const int e = tid + NTHR * (i0 + i), row = item * 64 + (e >> 6), hc = e & 63;
            const float mx = fmaxf(l[i][0], fmaxf(l[i][1], l[i][2])); float w0 = __builtin_amdgcn_exp2f(l[i][0] - mx), w1 = __builtin_amdgcn_exp2f(l[i][1] - mx), w2 = __builtin_amdgcn_exp2f(l[i][2] - mx);
            const float inv = __builtin_amdgcn_rcpf(w0 + w1 + w2); w0 *= inv; w1 *= inv; w2 *= inv;
            float x0[8], x1[8], x2[8], y[8]; unpack8(xw[i][0], x0); unpack8(xw[i][1], x1); unpack8(xw[i][2], x2);
#pragma unroll
            for (int k = 0; k < 8; ++k) y[k] = w0 * x0[k] + w1 * x1[k] + w2 * x2[k];
            *(v4u*)(MIX + (size_t)row * DM + 512 + hc * 8) = pack8(y); }
    }
}

__device__ __forceinline__ void ffn_fixup_phase(const Args& a, int gt, int NGT) {
    unsigned char* ws = a.ws;
    const float* HEADU = (const float*)(ws + WS_HEADU); const float* HEADP = (const float*)(ws + WS_HEADP); const float* TAIL = (const float*)(ws + WS_TAIL); bf16* Hb = (bf16*)(ws + WS_H);
    const float* cw = a.in[I_CFW]; const float* cb = a.in[I_CFB];
    for (int e = gt; e < (MP / 256) * 2 * (DFF / 8); e += NGT) {
        const int pm = e / (2 * (DFF / 8)), rem = e % (2 * (DFF / 8)), j = rem / (DFF / 8), c = (rem % (DFF / 8)) * 8;
        if ((pm & 15) == 0) continue;
        float p2[8], p1[8], cur[8], up[8], w0[8], w1[8], w2[8], bb[8], y[8];
        load8_f32(TAIL + (size_t)((pm - 1) * 2 + j) * DFF + c, p2);
        if (j == 0) load8_f32(TAIL + (size_t)((pm - 1) * 2 + 1) * DFF + c, p1); else load8_f32(HEADU + (size_t)(pm * 2) * DFF + c, p1);
        load8_f32(HEADU + (size_t)(pm * 2 + j) * DFF + c, cur); load8_f32(HEADP + (size_t)(pm * 2 + j) * DFF + c, up);
        load8_f32(cw + c, w0); load8_f32(cw + DFF + c, w1); load8_f32(cw + 2 * DFF + c, w2); load8_f32(cb + c, bb);
#pragma unroll
        for (int i = 0; i < 8; ++i) { const float uc = bb[i] + w0[i] * p2[i] + w1[i] * p1[i] + w2[i] * cur[i]; y[i] = gelu_tanh(uc) * up[i]; }
        *(v4u*)(Hb + (size_t)(pm * 256 + j) * DFF + c) = pack8(y);
    }
}
__device__ __forceinline__ void final_norm_phase(const Args& a, int gw, int NGW, int lane, bool prompt_too) {
    float* Y = a.out + O_Y; const float* PART = (const float*)(a.ws + WS_PART); const GAS f32x4* gf = (const GAS f32x4*)a.in[I_GFIN] + lane;
    f32x4 g[4];
#pragma unroll
    for (int j = 0; j < 4; ++j) g[j] = gf[64 * j];
#pragma unroll 1
    for (int m0 = gw; prompt_too && m0 < MP; m0 += 4 * NGW) {
        f32x4 v[4][4];
#pragma unroll
        for (int q = 0; q < 4; ++q) { const int m = m0 + q * NGW; if (m < MP) { const GAS f32x4* yr = (const GAS f32x4*)(Y + (size_t)m * DM) + lane;
#pragma unroll
                for (int j = 0; j < 4; ++j) v[q][j] = yr[64 * j]; } }
#pragma unroll
        for (int q = 0; q < 4; ++q) { const int m = m0 + q * NGW; if (m < MP) { float ss = 0.f;
#pragma unroll
                for (int j = 0; j < 4; ++j) ss += (v[q][j].x * v[q][j].x + v[q][j].y * v[q][j].y) + (v[q][j].z * v[q][j].z + v[q][j].w * v[q][j].w);
                const float rs = 1.f / sqrtf(wave_sum(ss) * (1.f / DM) + EPS); GAS f32x4* yr = (GAS f32x4*)(Y + (size_t)m * DM) + lane;
#pragma unroll
                for (int j = 0; j < 4; ++j) yr[64 * j] = v[q][j] * rs * g[j]; } }
    }
    for (int r = gw; r < MS; r += NGW) {
        GAS f32x4* yr = (GAS f32x4*)(Y + (size_t)(MP + r) * DM) + lane; f32x4 v[4]; float ss = 0.f;
#pragma unroll
        for (int j = 0; j < 4; ++j) { v[j] = yr[64 * j];
#pragma unroll
            for (int sl = 0; sl < KSPLIT; ++sl) v[j] += ((const GAS f32x4*)(PART + ((size_t)sl * MS + r) * DM) + lane)[64 * j];
            ss += (v[j].x * v[j].x + v[j].y * v[j].y) + (v[j].z * v[j].z + v[j].w * v[j].w); }
        const float rs = 1.f / sqrtf(wave_sum(ss) * (1.f / DM) + EPS);
#pragma unroll
        for (int j = 0; j < 4; ++j) yr[64 * j] = v[j] * rs * g[j];
    }
}

__global__ void __launch_bounds__(NTHR, 2) hymba_fwd(Args args) {
    extern __shared__ __attribute__((aligned(16))) unsigned char lds_raw[];
    LAS unsigned char* lds = (LAS unsigned char*)lds_raw;
    volatile LAS unsigned* MISC = (volatile LAS unsigned*)(lds + MISC_OFF);
    const int tid = threadIdx.x, lane = tid & 63, wave = __builtin_amdgcn_readfirstlane(tid >> 6);
    const int G = gridDim.x, bx = blockIdx.x; const int vcu = (G % 8 == 0) ? (bx % 8) * (G / 8) + bx / 8 : bx;
    unsigned char* ws = args.ws;
    unsigned* ctl = (unsigned*)(ws + WS_CTL);
    for (int u = tid; u < (LDS_BYTES - LDSCTL_OFF) / 4; u += NTHR) ((LAS unsigned*)(lds + LDSCTL_OFF))[u] = 0u;
    __syncthreads();
    XcdBarrier bar; bar.bar = ctl + CW_BAR + args.li * XCD_BAR_WORDS; bar.x = 0; bar.st = nullptr;
    if (N_LAUNCH == 1) bar = xcd_barrier_post(ctl + CW_BAR + args.li * XCD_BAR_WORDS, MISC + 8);
    const int lo = args.ph_lo, hi = args.ph_hi;
#ifndef REP_MASK
#define REP_MASK 0
#endif
#define REPS(k) for (int rep_ = 0; rep_ < 1 + ((REP_MASK >> (k)) & 1); ++rep_)
#ifndef STAG1
#define STAG1 0
#endif
#ifndef STAG4
#define STAG4 0
#endif
#ifndef STAG7
#define STAG7 0
#endif
#ifndef STAG_G
#define STAG_G 3
#endif
#define STAGGER(ticks) do { if ((ticks) > 0) { const int g_ = (bx / 8) % STAG_G; if (g_) { const unsigned long long t0_ = rt(); while (rt() - t0_ < (unsigned long long)(g_ * (ticks))) __builtin_amdgcn_s_sleep(8); } } } while (0)
#ifndef IT_MASK
#define IT_MASK 63
#endif
#ifndef PH_MASK
#define PH_MASK 0x1ff
#endif
#define IN(k) (((PH_MASK >> (k)) & 1) && lo <= (k) && (k) < hi)
#define SEAM(k) do { if (N_LAUNCH == 1 && IN(k) && IN((k) + 1)) xcd_barrier(bar); } while (0)

    constexpr int NP1S = 2 * (DIN / 256);
    if (IN(0)) REPS(0) {
        const int ns = (G >= 4 * NP1S && N_LAUNCH == 1) ? NP1S : 0;
        p0_prologue(args, lds, tid, wave, lane, vcu, G, 0);
        if (ns) {
            __builtin_amdgcn_fence(__ATOMIC_RELEASE, "agent"); __syncthreads();
            if (tid == 0) __hip_atomic_fetch_add(ctl + CW_P0A, 1u, __ATOMIC_RELAXED, __HIP_MEMORY_SCOPE_AGENT);
            if (bx < ns) {
                if (tid < 64) { unsigned spins = 0;
                    while ((unsigned)__builtin_amdgcn_readfirstlane(__hip_atomic_load(ctl + CW_P0A, __ATOMIC_RELAXED, __HIP_MEMORY_SCOPE_AGENT)) < (unsigned)G) { if (++spins > (1u << 22)) break; __builtin_amdgcn_s_sleep(2); } }
                __syncthreads(); __builtin_amdgcn_fence(__ATOMIC_ACQUIRE, "agent");
            }
        } else if (N_LAUNCH == 1) xcd_barrier(bar);
        if (bx >= ns) p0_prologue(args, lds, tid, wave, lane, bx - ns, G - ns, 1);
        if (ns == 0 || bx < ns) {
            if (ns == 0) __syncthreads();
            pg8::Gemm g{(const bf16*)(ws + WS_XN), (const bf16*)(ws + WS_WIN), M, DIN, DM, DM}; SampleUnitOrder S{bx, ns ? ns : G};
            EpiZ E{(const float*)(ws + WS_RS1), (const float*)(ws + WS_ROPE), (bf16*)(ws + WS_XA), (bf16*)(ws + WS_GA), (bf16*)(ws + WS_Q), (bf16*)(ws + WS_K), (bf16*)(ws + WS_V), (float*)(ws + WS_QS), args.out, (LAS float*)(lds + MISC_OFF + 256)};
            pg8::gemm_phase<EpiZ, SampleUnitOrder, true, true>(lds, g, S, E);
        }
        SEAM(0);
    }

    if (IN(1)) REPS(1) {
        STAGGER(STAG1);
        pg8::Gemm g{(const bf16*)(ws + WS_XN), (const bf16*)(ws + WS_WIN), MP, DIN, DM, DM}; pg8::StaticOrder S; S.init(MP, DIN, G, bx);
        EpiZ E{(const float*)(ws + WS_RS1), (const float*)(ws + WS_ROPE), (bf16*)(ws + WS_XA), (bf16*)(ws + WS_GA), (bf16*)(ws + WS_Q), (bf16*)(ws + WS_K), (bf16*)(ws + WS_V), (float*)(ws + WS_QS), args.out, (LAS float*)(lds + MISC_OFF + 256)};
        pg8::gemm_phase<EpiZ, pg8::StaticOrder, true, true>(lds, g, S, E);
        SEAM(1);
    }
    if (IN(2)) REPS(2) {
        constexpr int NA = NB * NH * 48, NSA = NS * NH, NL = NB * 64;
        if (args.pad & 4) for (int it = bx; it < NL; it += G) lru_fused_item(args, it, lds, wave, lane);
        if (bx & 1) { if (args.pad & 2) for (int it = bx; it < NSA; it += G) attn_sample_item(args, it, lds, tid, wave, lane); }
        if (args.pad & 1) attn_prompt_phase(args, lds, bx, G, NA, tid, wave, lane);
        if (!(bx & 1)) { if (args.pad & 2) for (int it = bx; it < NSA; it += G) attn_sample_item(args, it, lds, tid, wave, lane); }
        SEAM(2);
    }
    if (IN(3)) REPS(3) {
        constexpr int NLS = MS / 64, NC = MP / 64;
        if (bx < NLS && G > NLS) lru_item<2>(args, bx, lds, wave, lane);
        else if (G > NLS) { for (int it = bx - NLS; it < NC; it += G - NLS) combine_item(args, it, tid); }
        else for (int it = bx; it < NLS + NC; it += G) { if (it < NLS) lru_item<2>(args, it, lds, wave, lane); else combine_item(args, it - NLS, tid); }
        SEAM(3);
    }
    if (IN(4)) REPS(4) {
        STAGGER(STAG4);
        { pg8::Gemm g{(const bf16*)(ws + WS_MIX), (const bf16*)(ws + WS_WOUT), MP, DM, DM, DM}; pg8::StaticOrder S; S.init(MP, DM, G, bx);
          EpiX1 E{args.in[I_XP], args.in[I_XS], args.out + O_Y, (bf16*)(ws + WS_X1B), (float*)(ws + WS_SSP)};
          pg8::gemm_phase<EpiX1, pg8::StaticOrder, true, true>(lds, g, S, E); }
        { pg8::Gemm g{(const bf16*)(ws + WS_MIX), (const bf16*)(ws + WS_WOUT), M, DM, DM / KSPLIT4, DM}; SplitOrder S{G, bx, KSPLIT4, DM / KSPLIT4};
          EpiPart E{(float*)(ws + WS_PART4), DM / KSPLIT4};
          pg8::gemm_phase<EpiPart, SplitOrder, true, true>(lds, g, S, E); }
        { const int nsk = 8 * KSPLIT4;
          __syncthreads();
          if (G > 2 * nsk) { if (bx >= nsk) ffn_weights(args, lds, wave, lane, (bx - nsk) * NWAVES + wave, (G - nsk) * NWAVES, 1); }
          else ffn_weights(args, lds, wave, lane, bx * NWAVES + wave, G * NWAVES, 1);
          __syncthreads(); }
        SEAM(4);
    }
    if (IN(5)) REPS(5) {
        finalize_x1_sample(args, bx, G, wave, lane);
        pg8::Gemm g{(const bf16*)(ws + WS_X1B), (const bf16*)(ws + WS_WGU), M, 2 * DFF, DM, DM}; GatedOrder S; S.init(M, 2 * DFF, G, bx); S.cnt = (const unsigned*)(ws + WS_CTL) + CW_CNT4; S.need = MS;
        EpiGU E{(const float*)(ws + WS_SSP), (bf16*)(ws + WS_H), args.in[I_CFW], args.in[I_CFB], args.in[I_SCF], args.out, (float*)(ws + WS_HEADU), (float*)(ws + WS_HEADP), (float*)(ws + WS_TAIL), (LAS float*)(lds + MISC_OFF + 256), (LAS float*)(lds + RING_BYTES)};
        pg8::gemm_phase<EpiGU, GatedOrder, true, true>(lds, g, S, E);
        { const int ntail = (M / 256 * (2 * DFF / 256)) % G;
          __syncthreads();
          if (ntail > 0 && G > 2 * ntail) { if (bx >= ntail) ffn_weights(args, lds, wave, lane, (bx - ntail) * NWAVES + wave, (G - ntail) * NWAVES, 2); }
          else ffn_weights(args, lds, wave, lane, bx * NWAVES + wave, G * NWAVES, 2);
          __syncthreads(); }
        SEAM(5);
    }
    if (IN(6)) REPS(6) {
        if (G == 256) {
            if (bx < 8 * KSPLIT) { pg8::Gemm g{(const bf16*)(ws + WS_H), (const bf16*)(ws + WS_WDN), M, DM, DFF / KSPLIT, DFF}; SplitOrder S{G, bx, KSPLIT, DFF / KSPLIT};
                EpiPart E{(float*)(ws + WS_PART), DFF / KSPLIT};
                pg8::gemm_phase<EpiPart, SplitOrder, true, true>(lds, g, S, E); }
            else ffn_fixup_phase(args, (bx - 8 * KSPLIT) * NTHR + tid, (G - 8 * KSPLIT) * NTHR);
        } else ffn_fixup_phase(args, vcu * NTHR + tid, G * NTHR);
        SEAM(6);
    }
    if (IN(7)) {
        STAGGER(STAG7);
        if (G == 256) {
            final_norm_phase(args, vcu * NWAVES + wave, G * NWAVES, lane, false);
            pg8::Gemm g{(const bf16*)(ws + WS_H), (const bf16*)(ws + WS_WDN), MP, DM, DFF, DFF};
            EpiX2F E{args.out + O_Y, (const bf16*)(ws + WS_X1B), args.in[I_GFIN], (float*)(ws + WS_XBUF), (unsigned*)(ws + WS_CTL) + CW_X2C};
            { OneUnitOrder S; S.init(MP, DM, G, bx); S.i0 = 0; pg8::gemm_phase<EpiX2F, OneUnitOrder, false, true>(lds, g, S, E); }
            __syncthreads();
            { OneUnitOrder S; S.init(MP, DM, G, bx); S.i0 = 1; pg8::gemm_phase<EpiX2F, OneUnitOrder, false, true>(lds, g, S, E); }
            __syncthreads();
        } else {
            pg8::Gemm g{(const bf16*)(ws + WS_H), (const bf16*)(ws + WS_WDN), MP, DM, DFF, DFF}; pg8::StaticOrder S; S.init(MP, DM, G, bx);
            EpiX2 E{args.out + O_Y, (const bf16*)(ws + WS_X1B)};
            pg8::gemm_phase<EpiX2, pg8::StaticOrder, true, true>(lds, g, S, E);
        }
        if (G != 256) { pg8::Gemm g{(const bf16*)(ws + WS_H), (const bf16*)(ws + WS_WDN), M, DM, DFF / KSPLIT, DFF}; SplitOrder S{G, bx, KSPLIT, DFF / KSPLIT};
          EpiPart E{(float*)(ws + WS_PART), DFF / KSPLIT};
          pg8::gemm_phase<EpiPart, SplitOrder, true, true>(lds, g, S, E); }
        if (G != 256) SEAM(7);
    }
    if (IN(8) && G != 256) final_norm_phase(args, vcu * NWAVES + wave, G * NWAVES, lane, true);
#undef IN
#undef SEAM
}

extern "C" void kernel_launch(void* const* d_in, const int* in_sizes, int n_in, void* d_out, int out_size, void* d_ws, size_t ws_size, hipStream_t stream) {
    static int grid = 0;
    if (grid == 0) {
        if (n_in != 24 || out_size != (int)O_END || ws_size < WS_END) { fprintf(stderr, "kernel_launch: unexpected shapes (n_in %d, out %d, ws %zu)\n", n_in, out_size, ws_size); grid = -1; return; }
        int dev = 0, cus = 0, per_cu = 0;
        if (hipGetDevice(&dev) != hipSuccess || hipDeviceGetAttribute(&cus, hipDeviceAttributeMultiprocessorCount, dev) != hipSuccess) { grid = -1; return; }
        if (hipFuncSetAttribute((const void*)hymba_fwd, hipFuncAttributeMaxDynamicSharedMemorySize, LDS_BYTES) != hipSuccess) { fprintf(stderr, "kernel_launch: hipFuncSetAttribute failed\n"); grid = -1; return; }
        if (hipOccupancyMaxActiveBlocksPerMultiprocessor(&per_cu, (const void*)hymba_fwd, NTHR, LDS_BYTES) != hipSuccess || per_cu < 1) fprintf(stderr, "kernel_launch: occupancy query reports %d blocks per CU\n", per_cu);
        (void)hipGetLastError();
        grid = cus;
    }
    if (grid < 0) return;
    if (hipMemsetAsync((char*)d_ws + WS_CTL, 0, CTL_ZERO_BYTES, stream) != hipSuccess) return;
    Args a{};
    for (int i = 0; i < 24; ++i) a.in[i] = (const float*)d_in[i];
    a.out = (float*)d_out; a.ws = (unsigned char*)d_ws; a.pad = 7;
#if defined(PROBE_PH)
    a.ph_lo = 0; a.ph_hi = PROBE_PH + 1; a.li = 0; hipLaunchKernelGGL(hymba_fwd, dim3(grid), dim3(NTHR), LDS_BYTES, stream, a);
    a.ph_lo = PROBE_PH; a.ph_hi = NPH; a.li = 1;
#if defined(PROBE_ITEMS)
    a.pad = PROBE_ITEMS; a.ph_hi = PROBE_PH + 1; hipLaunchKernelGGL(hymba_fwd, dim3(grid), dim3(NTHR), LDS_BYTES, stream, a); a.pad = 7; a.ph_lo = PROBE_PH + 1; a.ph_hi = NPH; a.li = 2;
#endif
    hipLaunchKernelGGL(hymba_fwd, dim3(grid), dim3(NTHR), LDS_BYTES, stream, a);
    return;
#endif
    if (N_LAUNCH == 1) { a.ph_lo = 0; a.ph_hi = NPH; hipLaunchKernelGGL(hymba_fwd, dim3(grid), dim3(NTHR), LDS_BYTES, stream, a); }
    else for (int k = 0; k < NPH; ++k) { a.ph_lo = k; a.ph_hi = k + 1; hipLaunchKernelGGL(hymba_fwd, dim3(grid), dim3(NTHR), LDS_BYTES, stream, a); }
}
```
